# Optimizing an MI355X kernel written in HIP

```python
import jax
import jax.numpy as jnp
from jax import lax
import numpy as np

D_MODEL = 1024
BATCH = 2
SEQ = 8192
DEPTH = 4
DEC_BATCH = 32
DEC_SEQ = 4
PAST_LEN = 8192
PAGE_SIZE = 128

D_LRU = D_MODEL // 4
N_LRU_BLOCKS = 4
LRU_BLOCK = D_LRU // N_LRU_BLOCKS
CONV_W = 4
LRU_C = 8.0
HGRN_DK = 64
HGRN_DV = 64
D_HGRN = D_MODEL // 4
N_HGRN = D_HGRN // HGRN_DK
HGRN_CHUNK = 64
ATT_DH = 64
D_ATT = D_MODEL // 2
N_ATT = D_ATT // ATT_DH
DILATED = ((128, 1), (512, 4), (2048, 16))
MAX_WINDOW = 2048
Q_BLOCK = 128
N_MEM = 256
N_XHEADS = 4
XHEAD_DIM = D_MODEL // N_XHEADS
D_FF = 2816
GROUP_COLS = (D_LRU, D_LRU, D_HGRN, D_HGRN, D_HGRN, D_HGRN, D_ATT, D_ATT, D_ATT)
D_IN = 2 * D_LRU + 4 * D_HGRN + 3 * D_ATT
EPS = 1e-6
F32 = jnp.float32

kernel_name = 'hymba_lru_hgrn2_dilated_swa_decoder_step'


def rmsnorm(x, g):
    xf = x.astype(F32)
    y = xf * lax.rsqrt(jnp.mean(xf * xf, axis=-1, keepdims=True) + EPS)
    return (y * g.astype(F32)).astype(x.dtype)


def swiglu(x, w_gate, w_up, w_down):
    return (jax.nn.silu(x @ w_gate) * (x @ w_up)) @ w_down


def causal_conv(x, buf, w, b):
    T = x.shape[1]
    xp = jnp.concatenate([buf.astype(x.dtype), x], axis=1)
    y = b.astype(x.dtype)
    for tap in range(CONV_W):
        y = y + w[tap].astype(x.dtype) * xp[:, tap:tap + T]
    return y, xp[:, -(CONV_W - 1):]


def rg_lru(x, h0, w_a, b_a, w_x, b_x, lam):
    B, T, _ = x.shape
    xf = x.astype(F32)
    xb = xf.reshape(B, T, N_LRU_BLOCKS, LRU_BLOCK)
    r = jax.nn.sigmoid(jnp.einsum('btnc,ncd->btnd', xb, w_a.astype(F32)).reshape(B, T, D_LRU) + b_a.astype(F32))
    i = jax.nn.sigmoid(jnp.einsum('btnc,ncd->btnd', xb, w_x.astype(F32)).reshape(B, T, D_LRU) + b_x.astype(F32))
    log_a = -LRU_C * r * jax.nn.softplus(-lam.astype(F32))
    a = jnp.exp(log_a)
    u = jnp.sqrt(-jnp.expm1(2.0 * log_a)) * (i * xf)

    def combine(lhs, rhs):
        a1, b1 = lhs
        a2, b2 = rhs
        return a1 * a2, a2 * b1 + b2

    a_cum, u_cum = lax.associative_scan(combine, (a, u), axis=1)
    h = a_cum * h0.astype(F32)[:, None] + u_cum
    return h.astype(x.dtype), h[:, -1].astype(h0.dtype)


def hgrn2(q, f_pre, v, g, s0, lb, norm_g):
    B, T, _ = q.shape
    H, DK, DV = N_HGRN, HGRN_DK, HGRN_DV
    lb = lb.astype(F32).reshape(H, DK)
    f = lb + (1.0 - lb) * jax.nn.sigmoid(f_pre.astype(F32).reshape(B, T, H, DK))
    log_f = jnp.log(f)
    k = 1.0 - f
    qf = q.astype(F32).reshape(B, T, H, DK)
    vf = v.astype(F32).reshape(B, T, H, DV)
    C = HGRN_CHUNK if T % HGRN_CHUNK == 0 else T
    N = T // C

    def to_chunks(z):
        return z.reshape(B, N, C, H, z.shape[-1]).transpose(1, 0, 3, 2, 4)

    causal = jnp.tril(jnp.ones((C, C), dtype=bool))

    def chunk_step(S, inp):
        qc, kc, vc, gc = inp
        cum = jnp.cumsum(gc, axis=2)
        rel = jnp.where(causal[None, None, :, :, None],
                        cum[:, :, :, None, :] - cum[:, :, None, :, :], -jnp.inf)
        scores = jnp.einsum('bhtd,bhsd,bhtsd->bhts', qc, kc, jnp.exp(rel))
        o = (jnp.einsum('bhts,bhsv->bhtv', scores, vc)
             + jnp.einsum('bhtd,bhdv->bhtv', qc * jnp.exp(cum), S))
        last = cum[:, :, -1]
        S = (jnp.exp(last)[..., None] * S
             + jnp.einsum('bhsd,bhsv->bhdv', kc * jnp.exp(last[:, :, None] - cum), vc))
        return S, o

    s_fin, o = lax.scan(chunk_step, s0.astype(F32),
                        (to_chunks(qf), to_chunks(k), to_chunks(vf), to_chunks(log_f)))
    o = o.transpose(1, 0, 3, 2, 4).reshape(B, T, H, DV)
    o = rmsnorm(o, norm_g).reshape(B, T, H * DV) * jax.nn.silu(g.astype(F32))
    return o.astype(q.dtype), s_fin.astype(s0.dtype)


def dilated_attention(q, k_all, v_all, q_idx):
    slopes = jnp.asarray(2.0 ** (-8.0 * np.arange(1, N_ATT + 1) / N_ATT), dtype=F32)
    scale = ATT_DH ** -0.5
    lses = []
    outs = []
    for window, dil in DILATED:
        n_keys = window // dil + 1
        offs = jnp.arange(n_keys, dtype=jnp.int32) * dil
        idx = q_idx[:, None] - offs[None, :]
        valid = idx >= 0
        idx = jnp.maximum(idx, 0)
        kg = k_all[:, idx]
        vg = v_all[:, idx]
        s = (jnp.einsum('bthd,btnhd->bthn', q, kg).astype(F32) * scale
             - slopes[:, None] * offs.astype(F32)[None, :])
        s = jnp.where(valid[None, :, None, :], s, -jnp.inf)
        m = jnp.max(s, axis=-1, keepdims=True)
        p = jnp.exp(s - m)
        den = jnp.sum(p, axis=-1)
        o = jnp.einsum('bthn,btnhd->bthd', p, vg.astype(F32)) / den[..., None]
        lses.append(m[..., 0] + jnp.log(den))
        outs.append(o)
    w = jax.nn.softmax(jnp.stack(lses, axis=-1), axis=-1)
    return jnp.einsum('bthg,gbthd->bthd', w, jnp.stack(outs, axis=0))


def dilated_attention_blocked(q, k, v):
    B, T, H, D = q.shape
    nb = T // Q_BLOCK
    qb = q.reshape(B, nb, Q_BLOCK, H, D).transpose(1, 0, 2, 3, 4)
    idx = jnp.arange(T, dtype=jnp.int32).reshape(nb, Q_BLOCK)
    ob = lax.map(lambda a: dilated_attention(a[0], k, v, a[1]), (qb, idx))
    return ob.transpose(1, 0, 2, 3, 4).reshape(B, T, H, D)


def cross_attend(h, mem_k, mem_v, wq, wo):
    B, T, _ = h.shape
    q = (h @ wq).reshape(B, T, N_XHEADS, XHEAD_DIM)
    s = jnp.einsum('bthd,bmhd->bhtm', q, mem_k).astype(F32) * (XHEAD_DIM ** -0.5)
    p = jax.nn.softmax(s, axis=-1)
    o = jnp.einsum('bhtm,bmhd->bthd', p.astype(h.dtype), mem_v)
    return o.reshape(B, T, D_MODEL) @ wo


def trunk_layer(x, lp, lru_h, lru_conv, hgrn_s, swa_k_buf, swa_v_buf, mem_k, mem_v):
    B, T, _ = x.shape
    x = x + 0.5 * swiglu(rmsnorm(x, lp['n_ffn1']), lp['ffn1_wg'], lp['ffn1_wu'], lp['ffn1_wd'])
    h = rmsnorm(x, lp['n_mix'])
    z = h @ lp['w_in']
    xa, ga, qb, fb, ib, gb, qc, kc, vc = jnp.split(z, np.cumsum(GROUP_COLS)[:-1].tolist(), axis=-1)
    xa, conv_new = causal_conv(xa, lru_conv, lp['lru_conv_w'], lp['lru_conv_b'])
    ya, h_last = rg_lru(xa, lru_h, lp['lru_wa'], lp['lru_ba'], lp['lru_wx'], lp['lru_bx'], lp['lru_lambda'])
    ya = rmsnorm(ya * jax.nn.gelu(ga), lp['gn_a'])
    yb, s_new = hgrn2(qb, fb, ib, gb, hgrn_s, lp['lb'], lp['hgrn_norm'])
    q = qc.reshape(B, T, N_ATT, ATT_DH)
    k = kc.reshape(B, T, N_ATT, ATT_DH)
    v = vc.reshape(B, T, N_ATT, ATT_DH)
    if swa_k_buf is None:
        yc = dilated_attention_blocked(q, k, v)
        keep = min(MAX_WINDOW, T)
        k_new = k[:, T - keep:]
        v_new = v[:, T - keep:]
    else:
        W = swa_k_buf.shape[1]
        k_all = jnp.concatenate([swa_k_buf.astype(k.dtype), k], axis=1)
        v_all = jnp.concatenate([swa_v_buf.astype(v.dtype), v], axis=1)
        yc = dilated_attention(q, k_all, v_all, W + jnp.arange(T, dtype=jnp.int32))
        k_new = k_all[:, T:]
        v_new = v_all[:, T:]
    yc = rmsnorm(yc.reshape(B, T, D_ATT).astype(x.dtype), lp['gn_c'])
    x = x + jnp.concatenate([ya, yb, yc], axis=-1) @ lp['w_out']
    x = x + cross_attend(rmsnorm(x, lp['n_cross']), mem_k, mem_v, lp['x_wq'], lp['x_wo'])
    x = x + 0.5 * swiglu(rmsnorm(x, lp['n_ffn2']), lp['ffn2_wg'], lp['ffn2_wu'], lp['ffn2_wd'])
    return x, h_last, conv_new, s_new, k_new, v_new


def setup_inputs(seed: int = 0) -> dict:
    key = jax.random.key(seed)
    keys = list(jax.random.split(key, 64))

    def nrm(shape, scale):
        return scale * jax.random.normal(keys.pop(), shape, jnp.float32)

    def gain(shape):
        return 1.0 + 0.02 * jax.random.normal(keys.pop(), shape, jnp.float32)

    w_buf = min(MAX_WINDOW, PAST_LEN)
    u = jax.random.uniform(keys.pop(), (DEPTH, D_LRU), jnp.float32, minval=0.9, maxval=0.999)
    sig = u ** (1.0 / LRU_C)
    lru_lambda = jnp.log(sig) - jnp.log1p(-sig)
    d_in_s = D_MODEL ** -0.5
    return {
        'x_prompt': nrm((BATCH, SEQ, D_MODEL), 1.0),
        'x_sample': nrm((DEC_BATCH, DEC_SEQ, D_MODEL), 1.0),
        'state_lru_h': nrm((DEPTH, DEC_BATCH, D_LRU), 0.5),
        'state_lru_conv': nrm((DEPTH, DEC_BATCH, CONV_W - 1, D_LRU), 1.0),
        'state_hgrn': nrm((DEPTH, DEC_BATCH, N_HGRN, HGRN_DK, HGRN_DV), 0.5),
        'cache_swa_k': nrm((DEPTH, DEC_BATCH, w_buf, N_ATT, ATT_DH), 1.0),
        'cache_swa_v': nrm((DEPTH, DEC_BATCH, w_buf, N_ATT, ATT_DH), 1.0),
        'cache_mem_k': nrm((DEPTH, DEC_BATCH, N_MEM, N_XHEADS, XHEAD_DIM), 1.0),
        'cache_mem_v': nrm((DEPTH, DEC_BATCH, N_MEM, N_XHEADS, XHEAD_DIM), 1.0),
        'mem_prompt': nrm((BATCH, N_MEM, D_MODEL), 1.0),
        'n_ffn1': gain((DEPTH, D_MODEL)),
        'ffn1_wg': nrm((DEPTH, D_MODEL, D_FF), d_in_s),
        'ffn1_wu': nrm((DEPTH, D_MODEL, D_FF), d_in_s),
        'ffn1_wd': nrm((DEPTH, D_FF, D_MODEL), D_FF ** -0.5),
        'n_mix': gain((DEPTH, D_MODEL)),
        'w_in': nrm((DEPTH, D_MODEL, D_IN), d_in_s),
        'lru_conv_w': nrm((DEPTH, CONV_W, D_LRU), CONV_W ** -0.5),
        'lru_conv_b': nrm((DEPTH, D_LRU), 0.01),
        'lru_wa': nrm((DEPTH, N_LRU_BLOCKS, LRU_BLOCK, LRU_BLOCK), LRU_BLOCK ** -0.5),
        'lru_ba': nrm((DEPTH, D_LRU), 0.01),
        'lru_wx': nrm((DEPTH, N_LRU_BLOCKS, LRU_BLOCK, LRU_BLOCK), LRU_BLOCK ** -0.5),
        'lru_bx': nrm((DEPTH, D_LRU), 0.01),
        'lru_lambda': lru_lambda,
        'hgrn_lb': nrm((DEPTH, D_HGRN), 0.1),
        'hgrn_norm': gain((DEPTH, HGRN_DV)),
        'gn_a': gain((DEPTH, D_LRU)),
        'gn_c': gain((DEPTH, D_ATT)),
        'w_out': nrm((DEPTH, D_MODEL, D_MODEL), d_in_s),
        'n_cross': gain((DEPTH, D_MODEL)),
        'x_wq': nrm((DEPTH, D_MODEL, D_MODEL), d_in_s),
        'x_wk': nrm((DEPTH, D_MODEL, D_MODEL), d_in_s),
        'x_wv': nrm((DEPTH, D_MODEL, D_MODEL), d_in_s),
        'x_wo': nrm((DEPTH, D_MODEL, D_MODEL), d_in_s),
        'n_ffn2': gain((DEPTH, D_MODEL)),
        'ffn2_wg': nrm((DEPTH, D_MODEL, D_FF), d_in_s),
        'ffn2_wu': nrm((DEPTH, D_MODEL, D_FF), d_in_s),
        'ffn2_wd': nrm((DEPTH, D_FF, D_MODEL), D_FF ** -0.5),
        'n_final': gain((D_MODEL,)),
    }


def reference(x_prompt, x_sample, state_lru_h, state_lru_conv, state_hgrn, cache_swa_k, cache_swa_v,
              cache_mem_k, cache_mem_v, mem_prompt, n_ffn1, ffn1_wg, ffn1_wu, ffn1_wd, n_mix, w_in,
              lru_conv_w, lru_conv_b, lru_wa, lru_ba, lru_wx, lru_bx, lru_lambda, hgrn_lb, hgrn_norm,
              gn_a, gn_c, w_out, n_cross, x_wq, x_wk, x_wv, x_wo, n_ffn2, ffn2_wg, ffn2_wu, ffn2_wd,
              n_final):
    lb_all = lax.cumsum(jax.nn.softmax(hgrn_lb.astype(F32), axis=0), axis=0)
    lb_all = lb_all - lb_all[0]
    B = x_prompt.shape[0]
    dt = x_prompt.dtype
    xp = x_prompt
    xs = x_sample
    p_h, p_c, p_s, p_k, p_v, p_mk, p_mv = [], [], [], [], [], [], []
    s_h, s_c, s_s, s_k, s_v = [], [], [], [], []
    for l in range(DEPTH):
        lp = {
            'n_ffn1': n_ffn1[l], 'ffn1_wg': ffn1_wg[l], 'ffn1_wu': ffn1_wu[l], 'ffn1_wd': ffn1_wd[l],
            'n_mix': n_mix[l], 'w_in': w_in[l],
            'lru_conv_w': lru_conv_w[l], 'lru_conv_b': lru_conv_b[l],
            'lru_wa': lru_wa[l], 'lru_ba': lru_ba[l], 'lru_wx': lru_wx[l], 'lru_bx': lru_bx[l],
            'lru_lambda': lru_lambda[l], 'lb': lb_all[l], 'hgrn_norm': hgrn_norm[l],
            'gn_a': gn_a[l], 'gn_c': gn_c[l], 'w_out': w_out[l],
            'n_cross': n_cross[l], 'x_wq': x_wq[l], 'x_wo': x_wo[l],
            'n_ffn2': n_ffn2[l], 'ffn2_wg': ffn2_wg[l], 'ffn2_wu': ffn2_wu[l], 'ffn2_wd': ffn2_wd[l],
        }
        mk = (mem_prompt @ x_wk[l]).reshape(B, N_MEM, N_XHEADS, XHEAD_DIM)
        mv = (mem_prompt @ x_wv[l]).reshape(B, N_MEM, N_XHEADS, XHEAD_DIM)
        xp, ph, pc, ps, pk, pv = trunk_layer(
            xp, lp, jnp.zeros((B, D_LRU), dt), jnp.zeros((B, CONV_W - 1, D_LRU), dt),
            jnp.zeros((B, N_HGRN, HGRN_DK, HGRN_DV), dt), None, None, mk, mv)
        xs, sh, sc, ss, sk, sv = trunk_layer(
            xs, lp, state_lru_h[l], state_lru_conv[l], state_hgrn[l],
            cache_swa_k[l], cache_swa_v[l], cache_mem_k[l], cache_mem_v[l])
        p_h.append(ph); p_c.append(pc); p_s.append(ps); p_k.append(pk); p_v.append(pv)
        p_mk.append(mk); p_mv.append(mv)
        s_h.append(sh); s_c.append(sc); s_s.append(ss); s_k.append(sk); s_v.append(sv)
    y_prompt = rmsnorm(xp, n_final)
    y_sample = rmsnorm(xs, n_final)
    return (y_prompt, y_sample,
            jnp.stack(p_h), jnp.stack(p_c), jnp.stack(p_s), jnp.stack(p_k), jnp.stack(p_v),
            jnp.stack(p_mk), jnp.stack(p_mv),
            jnp.stack(s_h), jnp.stack(s_c), jnp.stack(s_s), jnp.stack(s_k), jnp.stack(s_v))
```

```cpp
#include <hip/hip_runtime.h>
#include <cstdio>
#include <cstdint>
namespace pg8 {
#define PG8_LAS __attribute__((address_space(3)))
typedef unsigned short bf16_t;
typedef short bf16x8 __attribute__((ext_vector_type(8)));
typedef float f32x4 __attribute__((ext_vector_type(4)));
typedef unsigned u32x4 __attribute__((ext_vector_type(4)));
constexpr int BM = 256, BK = 64, HALF = 128, HTB = HALF * BK * 2  , STAGE_BYTES = 8 * HTB, NXCD = 8, WGM = 8;

__host__ __device__ __forceinline__ int lds_byte(int r, int c) { const int st = (r >> 4) * 2 + (c >> 5), rr = r & 15, cc = c & 31, ob = rr * 64 + cc * 2; return st * 1024 + (ob ^ (((ob >> 9) & 1) << 5)); }
__host__ __device__ __forceinline__ void stage_rc(int b, int& R, int& C) { const int st = b / 1024, sb = b % 1024, swz = sb ^ (((sb >> 9) & 1) << 5); R = (st >> 1) * 16 + swz / 64; C = (st & 1) * 32 + (swz % 64) / 2; }
__host__ __device__ __forceinline__ int perm32(int rho) { const int n = rho >> 4, i = rho & 15; return 8 * (i >> 2) + 4 * n + (i & 3); }

struct Unit { int pm, pn; };
struct Gemm { const bf16_t* A; const bf16_t* Bt; int lda, ldb, K; int acs; int bbs, bps;
    __device__ __forceinline__ const char* aptr(const Unit& u) const { return (const char*)(A + (size_t)u.pm * 256 * lda + (size_t)u.pn * acs); }
    __device__ __forceinline__ const char* bptr(const Unit& u) const { return (const char*)(Bt + (size_t)(u.pm >> 5) * bbs + (size_t)u.pn * bps); } };

struct StaticOrder {
    int nM, nN, nwg, G, c;
    __host__ __device__ void init(int M, int N, int G_, int c_) { nM = M / BM; nN = N / BM; nwg = nM * nN; G = G_; c = c_; }
    __host__ __device__ bool next(int i, Unit& u) const {
        const long L = (long)i * G + c; if (L >= nwg) return false;
        int wgid = (int)L; { const int q = nwg / NXCD, r = nwg % NXCD, xcd = wgid % NXCD, off = wgid / NXCD; wgid = (xcd < r ? xcd * (q + 1) : r * (q + 1) + (xcd - r) * q) + off; }
        const int nig = WGM * nN, gid = wgid / nig, fm = gid * WGM, gsz = (nM - fm) < WGM ? (nM - fm) : WGM;
        u.pm = fm + ((wgid % nig) % gsz); u.pn = (wgid % nig) / gsz; return true;
    }
    __device__ __forceinline__ void a_ready(const Unit&) const {}
    __device__ __forceinline__ void done(const Unit&) const {}
};

__device__ __forceinline__ unsigned cvt_pk_bf16(float lo, float hi) { unsigned r; asm volatile("v_cvt_pk_bf16_f32 %0, %1, %2" : "=v"(r) : "v"(lo), "v"(hi)); return r; }
typedef float f32x2 __attribute__((ext_vector_type(2)));
template <class Epi, class Sched, bool ALIGN_EPI = false, bool SP2 = false>
__device__ __forceinline__ void gemm_phase(PG8_LAS unsigned char* lds, const Gemm g, const Sched& S, const Epi& E, int wave_in  ) {
    int wv_ = wave_in; asm volatile("" : "+s"(wv_));
    int lane_ = (int)__builtin_amdgcn_mbcnt_hi(~0u, __builtin_amdgcn_mbcnt_lo(~0u, 0u)); asm volatile("" : "+v"(lane_)); const int lane = lane_;
    const int wid = wv_, tid = wid * 64 + lane, wr = wid >> 2, wc = wid & 3, fr = lane & 15, fq = lane >> 4;
    int K_ = g.K; asm volatile("" : "+s"(K_)); const int K = K_, nt = K / BK, lda = g.lda, ldb = g.ldb;
    unsigned voffA[2], voffB[2];
#pragma unroll
    for (int i = 0; i < 2; ++i) { int R, C; stage_rc(tid * 16 + i * 8192, R, C); const int Rb = Epi::PERM ? ((R & ~31) + perm32(R & 31)) : R;
        voffA[i] = (unsigned)(R * lda + C) * 2u; voffB[i] = (unsigned)(Rb * ldb + C) * 2u; }
    const size_t kstep = (size_t)(BK * 2);
    const size_t hstepA = (size_t)HALF * lda * 2, hstepB = (size_t)HALF * ldb * 2;
    const unsigned ldsw = (unsigned)wid * 1024u;
    const int aoff = lds_byte(wr * 64 + fr, fq * 8), boff = lds_byte(wc * 32 + fr, fq * 8);
#define PG8_SA(b, h) (((b) * 2 + (h)) * HTB)
#define PG8_SB(b, h) ((4 + (b) * 2 + (h)) * HTB)
#define PG8_STAGE(bufoff, gbase, voff) do { _Pragma("unroll") for (int _i = 0; _i < 2; ++_i) \
        __builtin_amdgcn_global_load_lds((const unsigned*)((const char*)(gbase) + (voff)[_i]), (PG8_LAS unsigned*)(lds + (bufoff) + ldsw + _i * 8192), 16, 0, 0); } while (0)
#define PG8_LDA(dst, b, h) do { _Pragma("unroll") for (int m = 0; m < 4; ++m) _Pragma("unroll") for (int k = 0; k < 2; ++k) dst[m][k] = *(const PG8_LAS bf16x8*)(lds + PG8_SA(b, h) + aoff + m * 2048 + k * 1024); } while (0)
#define PG8_LDB(dst, b, h) do { _Pragma("unroll") for (int n = 0; n < 2; ++n) _Pragma("unroll") for (int k = 0; k < 2; ++k) dst[n][k] = *(const PG8_LAS bf16x8*)(lds + PG8_SB(b, h) + boff + n * 2048 + k * 1024); } while (0)
#define PG8_MMA(ai, bj, At, Bt) do { __builtin_amdgcn_s_setprio(1); _Pragma("unroll") for (int m = 0; m < 4; ++m) _Pragma("unroll") for (int n = 0; n < 2; ++n) _Pragma("unroll") for (int k = 0; k < 2; ++k) \
        acc[ai][bj][m][n] = __builtin_amdgcn_mfma_f32_16x16x32_bf16(Bt[n][k], At[m][k], acc[ai][bj][m][n], 0, 0, 0); __builtin_amdgcn_s_setprio(0); } while (0)
#define PG8_WAIT_V(n) asm volatile("s_waitcnt vmcnt(" #n ")" ::: "memory")
#define PG8_WAIT_L(n) asm volatile("s_waitcnt lgkmcnt(" #n ")" ::: "memory")
#define PG8_BAR __builtin_amdgcn_s_barrier()
#define PG8_SCHED __builtin_amdgcn_sched_barrier(0)
    Unit cur, nxt; int ui = 0;
    if (!S.next(0, cur)) return;
    f32x4 acc[2][2][4][2];
#pragma unroll
    for (int a = 0; a < 2; ++a)
#pragma unroll
        for (int b = 0; b < 2; ++b)
#pragma unroll
            for (int m = 0; m < 4; ++m)
#pragma unroll
                for (int n = 0; n < 2; ++n) acc[a][b][m][n] = (f32x4){0.f, 0.f, 0.f, 0.f};
    bf16x8 At[4][2], B0[2][2], B1[2][2];
    const char* cA = g.aptr(cur); const char* cB = g.bptr(cur);
    S.a_ready(cur);
    if constexpr (SP2) {
        PG8_STAGE(PG8_SB(0, 0), cB, voffB); PG8_STAGE(PG8_SB(0, 1), cB + hstepB, voffB); PG8_STAGE(PG8_SA(0, 0), cA, voffA); PG8_STAGE(PG8_SA(0, 1), cA + hstepA, voffA);
        if (wr == 1) PG8_BAR;
        PG8_WAIT_V(2); PG8_BAR;
        PG8_STAGE(PG8_SB(1, 0), cB + kstep, voffB); PG8_STAGE(PG8_SA(1, 0), cA + kstep, voffA); PG8_STAGE(PG8_SB(1, 1), cB + hstepB + kstep, voffB);
        PG8_WAIT_V(6); PG8_BAR;
    } else {
        PG8_STAGE(PG8_SB(0, 0), cB, voffB); PG8_STAGE(PG8_SA(0, 0), cA, voffA); PG8_STAGE(PG8_SB(0, 1), cB + hstepB, voffB); PG8_STAGE(PG8_SA(0, 1), cA + hstepA, voffA);
        if (wr == 1) PG8_BAR;
        PG8_WAIT_V(4); PG8_BAR;
        PG8_STAGE(PG8_SB(1, 0), cB + kstep, voffB); PG8_STAGE(PG8_SA(1, 0), cA + kstep, voffA); PG8_STAGE(PG8_SB(1, 1), cB + hstepB + kstep, voffB);
        PG8_WAIT_V(6); PG8_BAR;
    }
    for (;;) {
        const bool has_next = S.next(ui + 1, nxt);
        const char* nA = has_next ? g.aptr(nxt) : cA; const char* nB = has_next ? g.bptr(nxt) : cB;
        for (int t = 0; t < nt; t += 2) {
            const bool last = (t == nt - 2);
            const char* a1 = cA + (size_t)(t + 1) * kstep;
            const char* a2 = last ? nA : cA + (size_t)(t + 2) * kstep; const char* b2 = last ? nB : cB + (size_t)(t + 2) * kstep;
            const char* a3 = a2 + kstep; const char* b3 = b2 + kstep;
            if (last && has_next) S.a_ready(nxt);
            if constexpr (SP2) {
            PG8_LDB(B0, 0, 0); PG8_LDB(B1, 0, 1); PG8_SCHED; PG8_LDA(At, 0, 0); PG8_STAGE(PG8_SA(1, 1), a1 + hstepA, voffA);
            PG8_WAIT_V(8); PG8_WAIT_L(0); PG8_BAR; PG8_MMA(0, 0, At, B0); PG8_MMA(0, 1, At, B1); PG8_BAR; PG8_SCHED;
            PG8_LDA(At, 0, 1); PG8_STAGE(PG8_SB(0, 0), b2, voffB); PG8_STAGE(PG8_SB(0, 1), b2 + hstepB, voffB); PG8_STAGE(PG8_SA(0, 0), a2, voffA);
            PG8_WAIT_V(8); PG8_WAIT_L(0); PG8_BAR; PG8_MMA(1, 0, At, B0); PG8_MMA(1, 1, At, B1); PG8_BAR; PG8_SCHED;
            PG8_LDB(B0, 1, 0); PG8_LDB(B1, 1, 1); PG8_SCHED; PG8_LDA(At, 1, 0); PG8_STAGE(PG8_SA(0, 1), a2 + hstepA, voffA);
            PG8_WAIT_V(8); PG8_WAIT_L(0); PG8_BAR; PG8_MMA(0, 0, At, B0); PG8_MMA(0, 1, At, B1); PG8_BAR; PG8_SCHED;
            PG8_LDA(At, 1, 1); PG8_STAGE(PG8_SB(1, 0), b3, voffB); PG8_STAGE(PG8_SB(1, 1), b3 + hstepB, voffB); PG8_STAGE(PG8_SA(1, 0), a3, voffA);
            PG8_WAIT_V(8); PG8_WAIT_L(0); PG8_BAR; PG8_MMA(1, 0, At, B0); PG8_MMA(1, 1, At, B1); PG8_BAR; PG8_SCHED;
            } else {
            PG8_LDB(B0, 0, 0); PG8_SCHED; PG8_LDA(At, 0, 0); PG8_STAGE(PG8_SA(1, 1), a1 + hstepA, voffA);
            PG8_WAIT_L(8); PG8_BAR; PG8_WAIT_L(0); PG8_MMA(0, 0, At, B0); PG8_BAR; PG8_SCHED;
            PG8_LDB(B1, 0, 1); PG8_STAGE(PG8_SB(0, 0), b2, voffB);
            PG8_BAR; PG8_WAIT_L(0); PG8_MMA(0, 1, At, B1); PG8_BAR;
            PG8_LDA(At, 0, 1); PG8_STAGE(PG8_SA(0, 0), a2, voffA);
            PG8_BAR; PG8_WAIT_L(0); PG8_MMA(1, 0, At, B0); PG8_BAR; PG8_SCHED;
            PG8_STAGE(PG8_SB(0, 1), b2 + hstepB, voffB);
            PG8_WAIT_V(6); PG8_BAR; PG8_MMA(1, 1, At, B1); PG8_BAR;
            PG8_LDB(B0, 1, 0); PG8_SCHED; PG8_LDA(At, 1, 0); PG8_STAGE(PG8_SA(0, 1), a2 + hstepA, voffA);
            PG8_WAIT_L(8); PG8_BAR; PG8_WAIT_L(0); PG8_MMA(0, 0, At, B0); PG8_BAR; PG8_SCHED;
            PG8_LDB(B1, 1, 1); PG8_STAGE(PG8_SB(1, 0), b3, voffB);
            PG8_BAR; PG8_WAIT_L(0); PG8_MMA(0, 1, At, B1); PG8_BAR;
            PG8_LDA(At, 1, 1); PG8_STAGE(PG8_SA(1, 0), a3, voffA);
            PG8_BAR; PG8_WAIT_L(0); PG8_MMA(1, 0, At, B0); PG8_BAR; PG8_SCHED;
            PG8_STAGE(PG8_SB(1, 1), b3 + hstepB, voffB);
            PG8_WAIT_V(6); PG8_BAR; PG8_MMA(1, 1, At, B1); PG8_BAR;
            }
        }
        if constexpr (ALIGN_EPI) { if (wr == 0) PG8_BAR; }
        if constexpr (!Epi::AFTER_DRAIN) { int l2 = (int)__builtin_amdgcn_mbcnt_hi(~0u, __builtin_amdgcn_mbcnt_lo(~0u, 0u)); asm volatile("" : "+v"(l2)); const int fr2 = l2 & 15, fq2 = l2 >> 4; E(acc, cur, wr, wc, fr2, fq2); S.done(cur); }
        if (!has_next) break;
#pragma unroll
        for (int a = 0; a < 2; ++a)
#pragma unroll
            for (int b = 0; b < 2; ++b)
#pragma unroll
                for (int m = 0; m < 4; ++m)
#pragma unroll
                    for (int n = 0; n < 2; ++n) acc[a][b][m][n] = (f32x4){0.f, 0.f, 0.f, 0.f};
        cur = nxt; cA = nA; cB = nB; ++ui;
        if constexpr (ALIGN_EPI) { if (wr == 1) PG8_BAR; }
    }
    PG8_WAIT_V(0);
    if constexpr (!ALIGN_EPI) { if (wr == 0) PG8_BAR; }
    PG8_BAR;
    if constexpr (Epi::AFTER_DRAIN) { E.fused(acc, cur, wr, wc, fr, fq, lds, wid, lane); S.done(cur); }
#undef PG8_SA
#undef PG8_SB
#undef PG8_STAGE
#undef PG8_LDA
#undef PG8_LDB
#undef PG8_MMA
#undef PG8_WAIT_V
#undef PG8_WAIT_L
#undef PG8_BAR
#undef PG8_SCHED
}
}
#define GAS __attribute__((address_space(1)))
#define LAS __attribute__((address_space(3)))
#define XB_TMO      128
#define XB_XCNT(j)  (256  + 64 * (j))
#define XB_XSUB(j)  (1280 + 64 * (j))
#define XB_XGEN(j)  (2304 + 64 * (j))
#define XB_TOP      3328
#define XB_TOPGEN   3392
#define XCD_BAR_WORDS 3456
#define XB_SPIN_CAP (1u << 18)

__device__ __forceinline__ unsigned xb_ld(unsigned* p)              { return __hip_atomic_load(p, __ATOMIC_RELAXED, __HIP_MEMORY_SCOPE_AGENT); }
__device__ __forceinline__ unsigned xb_add(unsigned* p, unsigned v) { return __hip_atomic_fetch_add(p, v, __ATOMIC_RELAXED, __HIP_MEMORY_SCOPE_AGENT); }
__device__ __forceinline__ unsigned xb_xcc_id() { return (unsigned)__builtin_amdgcn_s_getreg((3 << 11) | 20) & 0xFu; }
#define XB_SPIN(cond, bar) do { unsigned _sp = 0; while (cond) { __builtin_amdgcn_s_sleep(1); \
    if ((++_sp & 255u) == 0u) { if (xb_ld(&(bar)[XB_TMO])) break; if (_sp > XB_SPIN_CAP) { atomicAdd(&(bar)[XB_TMO], 1u); break; } } } } while (0)

struct XcdBarrier {
    unsigned* bar; unsigned x;
    volatile LAS unsigned* st;
};

__device__ __forceinline__ XcdBarrier xcd_barrier_post(unsigned* bar, volatile LAS unsigned* st) {
    XcdBarrier b; b.bar = bar; b.x = xb_xcc_id(); b.st = st;
    if (threadIdx.x == 0) (void)xb_add(&bar[XB_XCNT(b.x)], 1u);
    return b;
}
__device__ __forceinline__ void xcd_barrier_complete(unsigned* bar, unsigned x, unsigned& nloc, unsigned& nx) {
    const unsigned G = gridDim.x * gridDim.y * gridDim.z;
    unsigned sum, cnt, mine, sp = 0u;
    for (;;) {
        sum = 0u; cnt = 0u; mine = 0u;
#pragma unroll
        for (unsigned j = 0; j < 16; ++j) { const unsigned c = xb_ld(&bar[XB_XCNT(j)]); sum += c; cnt += (c > 0u) ? 1u : 0u; mine = (j == x) ? c : mine; }
        if (sum == G) break;
        __builtin_amdgcn_s_sleep(1);
        if ((++sp & 255u) == 0u) { if (xb_ld(&bar[XB_TMO])) break; if (sp > XB_SPIN_CAP) { atomicAdd(&bar[XB_TMO], 1u); break; } }
    }
    nloc = mine > 0u ? mine : 1u; nx = cnt > 0u ? cnt : 1u;
}

__device__ __forceinline__ void xcd_barrier(const XcdBarrier& b) {
    asm volatile("s_waitcnt vmcnt(0)" ::: "memory");
    __syncthreads();
    if (threadIdx.x == 0) {
        unsigned* bar = b.bar;
        __builtin_amdgcn_s_waitcnt(0);
        unsigned nloc = b.st[0], nx = b.st[1];
        if (nloc == 0u) { xcd_barrier_complete(bar, b.x, nloc, nx); b.st[0] = nloc; b.st[1] = nx; }
        const unsigned old = xb_add(&bar[XB_XSUB(b.x)], 1u);
        const unsigned gen = old / nloc;
        if (old + 1u == (gen + 1u) * nloc) {
            __builtin_amdgcn_fence(__ATOMIC_RELEASE, "agent");
            asm volatile("s_waitcnt vmcnt(0)" ::: "memory");
            const unsigned og = xb_add(&bar[XB_TOP], 1u);
            const unsigned tg = og / nx;
            if (og + 1u == (tg + 1u) * nx) xb_add(&bar[XB_TOPGEN], 1u);
            else XB_SPIN(xb_ld(&bar[XB_TOPGEN]) == tg, bar);
            __builtin_amdgcn_fence(__ATOMIC_ACQUIRE, "agent");
            xb_add(&bar[XB_XGEN(b.x)], 1u);
            asm volatile("s_waitcnt vmcnt(0)" ::: "memory");
        } else {
            XB_SPIN(xb_ld(&bar[XB_XGEN(b.x)]) == gen, bar);
            __builtin_amdgcn_fence(__ATOMIC_ACQUIRE, "agent");
            asm volatile("s_waitcnt vmcnt(0)" ::: "memory");
        }
    }
    __syncthreads();
}

using pg8::bf16_t; using pg8::f32x4; using pg8::u32x4; using pg8::bf16x8; using pg8::Unit;
typedef GAS unsigned gu32;
typedef float f32x2v __attribute__((ext_vector_type(2)));
typedef unsigned u32x2v __attribute__((ext_vector_type(2)));
constexpr int NB = 2, SEQ = 8192, D = 1024, M = NB * SEQ, NL = 4;
constexpr int SBATCH = 32, STOK = 4, MS = SBATCH * STOK, MT = M + MS;
constexpr int FF = 2816, DIN = 3072, WINDOW = 2048;
constexpr float EPS = 1e-6f, LOG2E = 1.4426950408889634f;
constexpr int NWAVES = 8, NTHR = 512;

constexpr size_t O_YP = 0, O_YS = O_YP + (size_t)M * D, O_PLH = O_YS + (size_t)MS * D, O_PLC = O_PLH + NL * NB * 256, O_PHG = O_PLC + NL * NB * 3 * 256,
    O_PSK = O_PHG + (size_t)NL * NB * 4 * 4096, O_PSV = O_PSK + (size_t)NL * NB * 2048 * 512, O_PMK = O_PSV + (size_t)NL * NB * 2048 * 512,
    O_PMV = O_PMK + (size_t)NL * NB * 256 * 1024, O_SLH = O_PMV + (size_t)NL * NB * 256 * 1024, O_SLC = O_SLH + NL * 32 * 256, O_SHG = O_SLC + NL * 32 * 3 * 256,
    O_SSK = O_SHG + (size_t)NL * 32 * 4 * 4096, O_SSV = O_SSK + (size_t)NL * 32 * 2048 * 512, O_END = O_SSV + (size_t)NL * 32 * 2048 * 512;
static_assert(O_END == 308682752ull, "output size");

enum { I_XP = 0, I_XS, I_SLH, I_SLC, I_SHG, I_CSK, I_CSV, I_CMK, I_CMV, I_MEMP, I_NF1, I_F1G, I_F1U, I_F1D, I_NMIX, I_WIN, I_CONVW, I_CONVB, I_LWA, I_LBA, I_LWX, I_LBX,
       I_LAM, I_HLB, I_HNORM, I_GNA, I_GNC, I_WOUT, I_NCROSS, I_XWQ, I_XWK, I_XWV, I_XWO, I_NF2, I_F2G, I_F2U, I_F2D, I_NFIN, N_IN };
static_assert(N_IN == 38, "inputs");

constexpr size_t al4k(size_t x) { return (x + 4095) & ~(size_t)4095; }
constexpr size_t SZ_UP = (size_t)2 * FF * D, SZ_DN = (size_t)D * FF, SZ_IN = (size_t)DIN * D, SZ_SQ = (size_t)D * D;
constexpr size_t LW_1U = 0, LW_1D = LW_1U + SZ_UP, LW_IN = LW_1D + SZ_DN, LW_OUT = LW_IN + SZ_IN, LW_Q = LW_OUT + SZ_SQ, LW_O = LW_Q + SZ_SQ, LW_2U = LW_O + SZ_SQ,
    LW_2D = LW_2U + SZ_UP, LW_SZ = LW_2D + SZ_DN;
constexpr size_t WS_CTL = 0, CTL_BYTES = 1u << 20;
constexpr size_t WS_W = CTL_BYTES;
constexpr size_t WS_WKV = al4k(WS_W + NL * LW_SZ * 2);
constexpr size_t WS_XB = al4k(WS_WKV + 8 * SZ_SQ * 2);
constexpr size_t WS_SSQ = al4k(WS_XB + (size_t)MT * D * 2);
constexpr size_t WS_SSQS = al4k(WS_SSQ + (size_t)M * 16 * 4);
constexpr size_t WS_ACT = al4k(WS_SSQS + (size_t)MS * 64 * 4);
constexpr size_t WS_ZF = al4k(WS_ACT + (size_t)MT * FF * 2);
constexpr size_t WS_ZS = al4k(WS_ZF + (size_t)M * 1536 * 4);
constexpr size_t WS_QA = al4k(WS_ZS + (size_t)MS * 3072 * 4);
constexpr size_t WS_KA = al4k(WS_QA + (size_t)M * 512 * 2);
constexpr size_t WS_VA = al4k(WS_KA + (size_t)M * 512 * 2);
constexpr size_t WS_ACUM = al4k(WS_VA + (size_t)M * 512 * 2);
constexpr size_t WS_HLOC = al4k(WS_ACUM + (size_t)M * 256 * 4);
constexpr size_t WS_CA = al4k(WS_HLOC + (size_t)M * 256 * 4);
constexpr size_t WS_CH = al4k(WS_CA + 2 * 128 * 256 * 4);
constexpr size_t WS_HIN = al4k(WS_CH + 2 * 128 * 256 * 4);
constexpr size_t WS_HKV = al4k(WS_HIN + 2 * 128 * 256 * 4);
constexpr size_t WS_HDEC = al4k(WS_HKV + (size_t)1024 * 4096 * 4);
constexpr size_t WS_HSP = al4k(WS_HDEC + 1024 * 64 * 4);
constexpr size_t WS_YC = al4k(WS_HSP + (size_t)1024 * 4096 * 4);
constexpr size_t WS_Y = al4k(WS_YC + (size_t)MT * 512 * 4);
constexpr size_t WS_QX = al4k(WS_Y + (size_t)MT * D * 2);
constexpr size_t WS_QSS = al4k(WS_QX + (size_t)MT * D * 2);
constexpr size_t WS_PB = al4k(WS_QSS + (size_t)M * 16 * 4);
constexpr size_t WS_LS = al4k(WS_PB + (size_t)M * D * 2);
constexpr size_t WS_OB = al4k(WS_LS + (size_t)M * 16 * 4);
constexpr size_t WS_MEMB = al4k(WS_OB + (size_t)MT * D * 2);
constexpr size_t WS_MEMK = al4k(WS_MEMB + 512 * D * 2);
constexpr size_t WS_MEMVT = al4k(WS_MEMK + (size_t)NL * 2 * 256 * 1024 * 2);
constexpr size_t WS_KMAX = al4k(WS_MEMVT + (size_t)NL * 2 * 256 * 1024 * 2);
constexpr size_t WS_END = al4k(WS_KMAX + NL * 2 * 4 * 8 * 4);
constexpr size_t WS_SHADOW = WS_END, WS_TOTAL = WS_SHADOW + O_SSK * 4;
constexpr size_t QKV_STRIDE = (WS_KA - WS_QA) / 2, PSKV_STRIDE = O_PSV - O_PSK;
static_assert(WS_VA - WS_KA == WS_KA - WS_QA, "q k v equally spaced");
constexpr int CW_BAR = 4096;

constexpr int RING_BYTES = 131072, LDSCTL_OFF = RING_BYTES, LDS_BYTES = 147456;

__device__ __forceinline__ float wave_sum(float v) {
#pragma unroll
    for (int o = 1; o < 64; o <<= 1) v += __shfl_xor(v, o);
    return v;
}
__device__ __forceinline__ float wave_max(float v) {
#pragma unroll
    for (int o = 1; o < 64; o <<= 1) v = fmaxf(v, __shfl_xor(v, o));
    return v;
}
__device__ __forceinline__ unsigned f2bf(float f) { unsigned u = __builtin_bit_cast(unsigned, f); return (u + 0x7fffu + ((u >> 16) & 1u)) >> 16; }
__device__ __forceinline__ unsigned pk2(float lo, float hi) { return f2bf(lo) | (f2bf(hi) << 16); }
__device__ __forceinline__ float bf2f(unsigned short h) { return __builtin_bit_cast(float, (unsigned)h << 16); }
__device__ __forceinline__ u32x4 pack8(f32x4 a, f32x4 b) { u32x4 w; w.x = pk2(a[0], a[1]); w.y = pk2(a[2], a[3]); w.z = pk2(b[0], b[1]); w.w = pk2(b[2], b[3]); return w; }
__device__ __forceinline__ float fast_exp2(float x) { return __builtin_amdgcn_exp2f(x); }
__device__ __forceinline__ float fast_rcp(float x) { return __builtin_amdgcn_rcpf(x); }
__device__ __forceinline__ float fexp(float x) { return __builtin_amdgcn_exp2f(x * LOG2E); }
__device__ __forceinline__ float flog2(float x) { return __builtin_amdgcn_logf(x); }
__device__ __forceinline__ float fsqrt(float x) { return __builtin_amdgcn_sqrtf(x); }
__device__ __forceinline__ float frsq(float x) { return __builtin_amdgcn_rsqf(x); }
__device__ __forceinline__ float sigmoidf_(float x) { return fast_rcp(1.f + fast_exp2(-x * LOG2E)); }
__device__ __forceinline__ float siluf_(float x) { return x * sigmoidf_(x); }
__device__ __forceinline__ float gelu_tanh(float x) {
    const float u = 0.7978845608028654f * (x + 0.044715f * x * x * x);
    return x * sigmoidf_(2.f * u);
}
__device__ __forceinline__ float sum4(f32x4 a) { return (a[0] + a[1]) + (a[2] + a[3]); }
__device__ __forceinline__ float sq4(f32x4 a) { return (a[0] * a[0] + a[1] * a[1]) + (a[2] * a[2] + a[3] * a[3]); }
__device__ __forceinline__ float rstd16(const float* ssq, int row) {
    const f32x4* p = (const f32x4*)(ssq + (size_t)row * 16);
    const f32x4 a = p[0], b = p[1], c = p[2], d = p[3];
    const float s = (sum4(a) + sum4(b)) + (sum4(c) + sum4(d));
    return frsq(s * (1.0f / D) + EPS);
}
__device__ __forceinline__ float rstd64(const float* ssq, int row) {
    const f32x4* p = (const f32x4*)(ssq + (size_t)row * 64);
    float s = 0.f;
#pragma unroll
    for (int i = 0; i < 16; ++i) s += sum4(p[i]);
    return frsq(s * (1.0f / D) + EPS);
}

#define EPI_FOR_ROWS _Pragma("unroll") for (int ai = 0; ai < 2; ++ai) _Pragma("unroll") for (int m = 0; m < 4; ++m)
#define EPI_FENCE asm volatile("" ::: "memory")

struct EpiUp {
    static constexpr bool PERM = true, AFTER_DRAIN = false;
    bf16_t* act; const float* ssq;
    __device__ __forceinline__ void operator()(const f32x4 (&acc)[2][2][4][2], const Unit& u, int wr, int wc, int fr, int fq) const {
        const int col0 = u.pn * 128 + wc * 32 + 8 * fq;
        EPI_FOR_ROWS { EPI_FENCE; const int row = u.pm * 256 + ai * 128 + wr * 64 + m * 16 + fr; const float rs = rstd16(ssq, row);
            f32x4 o[2];
#pragma unroll
            for (int n = 0; n < 2; ++n) { const f32x4 g = acc[ai][0][m][n] * rs, up = acc[ai][1][m][n] * rs;
#pragma unroll
                for (int e = 0; e < 4; ++e) o[n][e] = siluf_(g[e]) * up[e]; }
            *(u32x4*)(act + (size_t)row * FF + col0) = pack8(o[0], o[1]); }
    }
};
struct EpiResid {
    static constexpr bool PERM = true, AFTER_DRAIN = false;
    const float* xin; float* xout; bf16_t* xb; float* ssq; float alpha;
    __device__ __forceinline__ void operator()(const f32x4 (&acc)[2][2][4][2], const Unit& u, int wr, int wc, int fr, int fq) const {
        EPI_FOR_ROWS { EPI_FENCE; const int row = u.pm * 256 + ai * 128 + wr * 64 + m * 16 + fr; float s = 0.f;
#pragma unroll
            for (int bj = 0; bj < 2; ++bj) { const size_t off = (size_t)row * D + u.pn * 256 + bj * 128 + wc * 32 + 8 * fq;
                const f32x4 x0 = *(const f32x4*)(xin + off), x1 = *(const f32x4*)(xin + off + 4);
                const f32x4 v0 = x0 + acc[ai][bj][m][0] * alpha, v1 = x1 + acc[ai][bj][m][1] * alpha;
                *(f32x4*)(xout + off) = v0; *(f32x4*)(xout + off + 4) = v1; *(u32x4*)(xb + off) = pack8(v0, v1);
                s += sq4(v0) + sq4(v1); }
            s += __shfl_xor(s, 16); s += __shfl_xor(s, 32);
            if (fq == 0) ssq[(size_t)row * 16 + u.pn * 4 + wc] = s; }
    }
};
struct EpiZ {
    static constexpr bool PERM = true, AFTER_DRAIN = false;
    float* zf; bf16_t* qa; float* psk; const float* ssq;
    __device__ __forceinline__ void operator()(const f32x4 (&acc)[2][2][4][2], const Unit& u, int wr, int wc, int fr, int fq) const {
        EPI_FOR_ROWS { EPI_FENCE; const int row = u.pm * 256 + ai * 128 + wr * 64 + m * 16 + fr; const float rs = rstd16(ssq, row);
#pragma unroll
            for (int bj = 0; bj < 2; ++bj) { const int cc = bj * 128 + wc * 32 + 8 * fq;
                const f32x4 v0 = acc[ai][bj][m][0] * rs, v1 = acc[ai][bj][m][1] * rs;
                if (u.pn < 6) { float* p = zf + (size_t)row * 1536 + u.pn * 256 + cc; *(f32x4*)p = v0; *(f32x4*)(p + 4) = v1; }
                else { const int g = (u.pn - 6) >> 1, c512 = ((u.pn - 6) & 1) * 256 + cc, h = c512 >> 6, d = c512 & 63, b = row >> 13, t = row & 8191;
                    bf16_t* dst = qa + (size_t)g * QKV_STRIDE + ((size_t)(b * 8 + h) * SEQ + t) * 64 + d;
                    *(u32x4*)dst = pack8(v0, v1);
                    if (g >= 1 && t >= SEQ - WINDOW) { float* o = psk + (size_t)(g - 1) * PSKV_STRIDE + ((size_t)(b * WINDOW + (t - (SEQ - WINDOW))) * 8 + h) * 64 + d; *(f32x4*)o = v0; *(f32x4*)(o + 4) = v1; } } } }
    }
};
struct EpiQx {
    static constexpr bool PERM = true, AFTER_DRAIN = false;
    bf16_t* qx; float* qss; const float* ssq;
    __device__ __forceinline__ void operator()(const f32x4 (&acc)[2][2][4][2], const Unit& u, int wr, int wc, int fr, int fq) const {
        EPI_FOR_ROWS { EPI_FENCE; const int row = u.pm * 256 + ai * 128 + wr * 64 + m * 16 + fr; const float rs = rstd16(ssq, row); float s = 0.f;
#pragma unroll
            for (int bj = 0; bj < 2; ++bj) { const size_t off = (size_t)row * D + u.pn * 256 + bj * 128 + wc * 32 + 8 * fq;
                const f32x4 v0 = acc[ai][bj][m][0] * rs, v1 = acc[ai][bj][m][1] * rs;
                const u32x4 w = pack8(v0, v1); *(u32x4*)(qx + off) = w;
                s += sq4(v0) + sq4(v1); }
            s += __shfl_xor(s, 16); s += __shfl_xor(s, 32);
            if (fq == 0) qss[(size_t)row * 16 + u.pn * 4 + wc] = s; }
    }
};
struct EpiS {
    static constexpr bool PERM = true, AFTER_DRAIN = false;
    bf16_t* pb; float* ls; const float* qss; const float* kmaxp;
    __device__ __forceinline__ void operator()(const f32x4 (&acc)[2][2][4][2], const Unit& u, int wr, int wc, int fr, int fq) const {
        const int b = u.pm >> 5, h = u.pn; const float* kp = kmaxp + (b * 4 + h) * 8;
        float k2 = 0.f;
#pragma unroll
        for (int c = 0; c < 4; ++c) k2 += fmaxf(kp[c], kp[4 + c]);
        const float sc = LOG2E * (1.0f / 16.0f);
        EPI_FOR_ROWS { EPI_FENCE; const int row = u.pm * 256 + ai * 128 + wr * 64 + m * 16 + fr;
            const f32x4 q4 = *(const f32x4*)(qss + (size_t)row * 16 + h * 4); const float bound = fsqrt(sum4(q4) * k2) * sc; float s = 0.f;
#pragma unroll
            for (int bj = 0; bj < 2; ++bj) { const size_t off = (size_t)row * D + h * 256 + bj * 128 + wc * 32 + 8 * fq; f32x4 p0, p1;
#pragma unroll
                for (int e = 0; e < 4; ++e) { p0[e] = fast_exp2(acc[ai][bj][m][0][e] * sc - bound); p1[e] = fast_exp2(acc[ai][bj][m][1][e] * sc - bound); }
                const u32x4 w = pack8(p0, p1); *(u32x4*)(pb + off) = w;
                s += (bf2f(w.x & 0xffff) + bf2f(w.x >> 16)) + (bf2f(w.y & 0xffff) + bf2f(w.y >> 16)) + (bf2f(w.z & 0xffff) + bf2f(w.z >> 16)) + (bf2f(w.w & 0xffff) + bf2f(w.w >> 16)); }
            s += __shfl_xor(s, 16); s += __shfl_xor(s, 32);
            if (fq == 0) ls[(size_t)row * 16 + h * 4 + wc] = s; }
    }
};
struct EpiPV {
    static constexpr bool PERM = true, AFTER_DRAIN = false;
    bf16_t* ob; const float* ls;
    __device__ __forceinline__ void operator()(const f32x4 (&acc)[2][2][4][2], const Unit& u, int wr, int wc, int fr, int fq) const {
        EPI_FOR_ROWS { EPI_FENCE; const int row = u.pm * 256 + ai * 128 + wr * 64 + m * 16 + fr;
            const f32x4 l4 = *(const f32x4*)(ls + (size_t)row * 16 + u.pn * 4); const float inv = 1.0f / sum4(l4);
#pragma unroll
            for (int bj = 0; bj < 2; ++bj) { const size_t off = (size_t)row * D + u.pn * 256 + bj * 128 + wc * 32 + 8 * fq;
                *(u32x4*)(ob + off) = pack8(acc[ai][bj][m][0] * inv, acc[ai][bj][m][1] * inv); } }
    }
};
struct EpiMem {
    static constexpr bool PERM = true, AFTER_DRAIN = false;
    float* out_k; float* out_v; bf16_t* memk; bf16_t* memvt; float* kmaxp;
    __device__ __forceinline__ void operator()(const f32x4 (&acc)[2][2][4][2], const Unit& u, int wr, int wc, int fr, int fq) const {
        const int l = u.pn >> 3, kv = (u.pn >> 2) & 1, h = u.pn & 3, b = u.pm; float rmax = 0.f;
        EPI_FOR_ROWS { EPI_FENCE; const int mrow = ai * 128 + wr * 64 + m * 16 + fr; float s = 0.f;
#pragma unroll
            for (int bj = 0; bj < 2; ++bj) { const int c = h * 256 + bj * 128 + wc * 32 + 8 * fq; const f32x4 v0 = acc[ai][bj][m][0], v1 = acc[ai][bj][m][1];
                float* o = (kv ? out_v : out_k) + ((size_t)((l * 2 + b) * 256 + mrow)) * 1024 + c; *(f32x4*)o = v0; *(f32x4*)(o + 4) = v1;
                if (kv == 0) { *(u32x4*)(memk + ((size_t)((l * 2 + b) * 256 + mrow)) * 1024 + c) = pack8(v0, v1); s += sq4(v0) + sq4(v1); }
                else { bf16_t* t = memvt + ((size_t)(l * 2 + b) * 1024 + c) * 256 + mrow;
#pragma unroll
                    for (int e = 0; e < 4; ++e) { t[(size_t)e * 256] = (bf16_t)f2bf(v0[e]); t[(size_t)(4 + e) * 256] = (bf16_t)f2bf(v1[e]); } } }
            s += __shfl_xor(s, 16); s += __shfl_xor(s, 32); rmax = fmaxf(rmax, s); }
        if (kv == 0) {
#pragma unroll
            for (int o = 1; o < 16; o <<= 1) rmax = fmaxf(rmax, __shfl_xor(rmax, o));
            if ((threadIdx.x & 63) == 0) kmaxp[((l * 2 + b) * 4 + h) * 8 + wr * 4 + wc] = rmax; }
    }
};

struct Args { const float* in[N_IN]; float* out; unsigned char* ws; int ph_lo, ph_hi; };
struct Frame {
    LAS unsigned char* lds; int tid, lane, wave, G, wg;
};

__device__ __forceinline__ void tr_item(const float* W, int K, int N, bf16_t* WT, int item, const float* gain, int mode, LAS float* scr, int lane) {
    const int nblk = N / 32, kb = item / nblk, nb = item % nblk, k0 = 64 * kb, n0 = 32 * nb;
#pragma unroll 8
    for (int i = 0; i < 32; ++i) { const int kk = 2 * i + (lane >> 5); float v = W[(size_t)(k0 + kk) * N + n0 + (lane & 31)]; if (gain) v *= gain[k0 + kk]; scr[kk * 33 + (lane & 31)] = v; }
    asm volatile("s_waitcnt lgkmcnt(0)" ::: "memory");
    const int c = lane & 7;
#pragma unroll
    for (int j = 0; j < 4; ++j) { const int n = (lane >> 3) + 8 * j; const LAS float* s = scr + (8 * c) * 33 + n;
        u32x4 o; o.x = pk2(s[0 * 33], s[1 * 33]); o.y = pk2(s[2 * 33], s[3 * 33]); o.z = pk2(s[4 * 33], s[5 * 33]); o.w = pk2(s[6 * 33], s[7 * 33]);
        const int ng = n0 + n; const int drow = mode == 0 ? ng : ((ng >> 7) * 256 + (mode == 2 ? 128 : 0) + (ng & 127));
        *(u32x4*)(WT + (size_t)drow * K + k0 + 8 * c) = o; }
    asm volatile("s_waitcnt lgkmcnt(0)" ::: "memory");
}
__device__ __forceinline__ void row_init(const float* xrow, bf16_t* orow, float* slots, int nslots, int lane) {
    const f32x4* xr = (const f32x4*)xrow + lane; f32x4 v[4]; float s = 0.f;
#pragma unroll
    for (int j = 0; j < 4; ++j) { v[j] = xr[64 * j]; s += sq4(v[j]); }
    s = wave_sum(s);
    u32x2v* o8 = (u32x2v*)orow + lane;
#pragma unroll
    for (int j = 0; j < 4; ++j) { u32x2v w; w.x = pk2(v[j][0], v[j][1]); w.y = pk2(v[j][2], v[j][3]); o8[64 * j] = w; }
    if (slots && lane < nslots) slots[lane] = (lane == 0) ? s : 0.f;
}

__device__ __forceinline__ void p0_prologue(const Frame& F, const Args& a) {
    unsigned char* ws = a.ws;
    LAS float* scr = (LAS float*)(F.lds + F.wave * 16384);
    const int gw = F.wg * NWAVES + F.wave, NGW = F.G * NWAVES;
    constexpr int I_UP = (D / 64) * (FF / 32), I_DN = (FF / 64) * (D / 32), I_INP = (D / 64) * (DIN / 32), I_SQ = (D / 64) * (D / 32);
    constexpr int PER_L = 6 * I_UP + I_INP + 5 * I_SQ;
    static_assert(I_UP == 1408 && I_DN == 1408 && I_INP == 1536 && I_SQ == 512 && PER_L == 12544, "items");
    for (int it = gw; it < NL * PER_L; it += NGW) {
        const int l = it / PER_L; int r = it % PER_L;
        bf16_t* LWb = (bf16_t*)(ws + WS_W) + (size_t)l * LW_SZ; bf16_t* KV = (bf16_t*)(ws + WS_WKV) + (size_t)l * 2 * SZ_SQ;
        const size_t oUP = (size_t)l * D * FF, oDN = (size_t)l * FF * D, oSQ = (size_t)l * D * D;
        if (r < I_UP) { tr_item(a.in[I_F1G] + oUP, D, FF, LWb + LW_1U, r, a.in[I_NF1] + l * D, 1, scr, F.lane); continue; } r -= I_UP;
        if (r < I_UP) { tr_item(a.in[I_F1U] + oUP, D, FF, LWb + LW_1U, r, a.in[I_NF1] + l * D, 2, scr, F.lane); continue; } r -= I_UP;
        if (r < I_DN) { tr_item(a.in[I_F1D] + oDN, FF, D, LWb + LW_1D, r, nullptr, 0, scr, F.lane); continue; } r -= I_DN;
        if (r < I_INP) { tr_item(a.in[I_WIN] + (size_t)l * D * DIN, D, DIN, LWb + LW_IN, r, a.in[I_NMIX] + l * D, 0, scr, F.lane); continue; } r -= I_INP;
        if (r < I_SQ) { tr_item(a.in[I_WOUT] + oSQ, D, D, LWb + LW_OUT, r, nullptr, 0, scr, F.lane); continue; } r -= I_SQ;
        if (r < I_SQ) { tr_item(a.in[I_XWQ] + oSQ, D, D, LWb + LW_Q, r, a.in[I_NCROSS] + l * D, 0, scr, F.lane); continue; } r -= I_SQ;
        if (r < I_SQ) { tr_item(a.in[I_XWK] + oSQ, D, D, KV, r, nullptr, 0, scr, F.lane); continue; } r -= I_SQ;
        if (r < I_SQ) { tr_item(a.in[I_XWV] + oSQ, D, D, KV + SZ_SQ, r, nullptr, 0, scr, F.lane); continue; } r -= I_SQ;
        if (r < I_SQ) { tr_item(a.in[I_XWO] + oSQ, D, D, LWb + LW_O, r, nullptr, 0, scr, F.lane); continue; } r -= I_SQ;
        if (r < I_UP) { tr_item(a.in[I_F2G] + oUP, D, FF, LWb + LW_2U, r, a.in[I_NF2] + l * D, 1, scr, F.lane); continue; } r -= I_UP;
        if (r < I_UP) { tr_item(a.in[I_F2U] + oUP, D, FF, LWb + LW_2U, r, a.in[I_NF2] + l * D, 2, scr, F.lane); continue; } r -= I_UP;
        tr_item(a.in[I_F2D] + oDN, FF, D, LWb + LW_2D, r, nullptr, 0, scr, F.lane);
    }
    bf16_t* XB = (bf16_t*)(ws + WS_XB); float* SSQ = (float*)(ws + WS_SSQ); float* SSQS = (float*)(ws + WS_SSQS); bf16_t* MEMB = (bf16_t*)(ws + WS_MEMB);
    for (int m = gw; m < MT + 512; m += NGW) {
        if (m < M) row_init(a.in[I_XP] + (size_t)m * D, XB + (size_t)m * D, SSQ + (size_t)m * 16, 16, F.lane);
        else if (m < MT) row_init(a.in[I_XS] + (size_t)(m - M) * D, XB + (size_t)m * D, SSQS + (size_t)(m - M) * 64, 64, F.lane);
        else row_init(a.in[I_MEMP] + (size_t)(m - MT) * D, MEMB + (size_t)(m - MT) * D, nullptr, 0, F.lane);
    }
}
__device__ __forceinline__ void p1_cache_copy(const Frame& F, const Args& a) {
    constexpr int HALFP = (WINDOW - STOK) * 128 / 2;
#pragma unroll 1
    for (int kv = 0; kv < 2; ++kv) {
        const f32x4* src = (const f32x4*)a.in[kv ? I_CSV : I_CSK]; f32x4* dst = (f32x4*)(a.out + (kv ? O_SSV : O_SSK));
#pragma unroll 1
        for (int pp = F.wg; pp < NL * SBATCH * 2; pp += F.G) {
            const int p = pp >> 1, hf = pp & 1;
            const f32x4* s = src + (size_t)p * (WINDOW * 128) + STOK * 128 + (size_t)hf * HALFP; f32x4* d = dst + (size_t)p * (WINDOW * 128) + (size_t)hf * HALFP;
#pragma unroll 8
            for (int e = F.tid; e < HALFP; e += NTHR) { const f32x4 v = __builtin_nontemporal_load(s + e); __builtin_nontemporal_store(v, d + e); }
        }
    }
}

template <int NBT> __device__ __forceinline__ void slab_mma(const bf16_t* A, int lda, const bf16_t* B0, const bf16_t* B1, int ldb, int K, int wave, int lane, f32x4& acc0, f32x4& acc1) {
    const int fr = lane & 15, g = lane >> 4;
    const bf16_t* ap = A + (size_t)(16 * wave + fr) * lda + 8 * g;
    const bf16_t* b0 = B0 + (size_t)fr * ldb + 8 * g; const bf16_t* b1 = B1 + (size_t)fr * ldb + 8 * g;
    acc0 = (f32x4){0.f, 0.f, 0.f, 0.f}; acc1 = (f32x4){0.f, 0.f, 0.f, 0.f};
#pragma unroll 8
    for (int k0 = 0; k0 < K; k0 += 32) {
        const bf16x8 af = *(const bf16x8*)(ap + k0); const bf16x8 bf0 = *(const bf16x8*)(b0 + k0);
        acc0 = __builtin_amdgcn_mfma_f32_16x16x32_bf16(bf0, af, acc0, 0, 0, 0);
        if (NBT == 2) { const bf16x8 bf1 = *(const bf16x8*)(b1 + k0); acc1 = __builtin_amdgcn_mfma_f32_16x16x32_bf16(bf1, af, acc1, 0, 0, 0); }
    }
}

__device__ __forceinline__ void phase_ffn_up(const Frame& F, unsigned char* ws, const bf16_t* Wu) {
    bf16_t* XB = (bf16_t*)(ws + WS_XB); bf16_t* ACT = (bf16_t*)(ws + WS_ACT); const float* SSQ = (const float*)(ws + WS_SSQ); const float* SSQS = (const float*)(ws + WS_SSQS);
    pg8::Gemm g{XB, Wu, D, D, D, 0, 0, 256 * D}; pg8::StaticOrder S; S.init(M, 2 * FF, F.G, F.wg);
    EpiUp E{ACT, SSQ};
    pg8::gemm_phase<EpiUp, pg8::StaticOrder, true, true>(F.lds, g, S, E, F.wave);
    int lane = F.lane; asm volatile("" : "+v"(lane));
    for (int s = F.G - 1 - F.wg; s < FF / 16; s += F.G) {
        const int n0 = 16 * s; const bf16_t* B0 = Wu + (size_t)((n0 >> 7) * 256 + (n0 & 127)) * D;
        f32x4 ag, au; slab_mma<2>(XB + (size_t)M * D, D, B0, B0 + (size_t)128 * D, D, D, F.wave, lane, ag, au);
        const int row = 16 * F.wave + (lane & 15); const float rs = rstd64(SSQS, row);
        u32x2v w; w.x = pk2(siluf_(ag[0] * rs) * (au[0] * rs), siluf_(ag[1] * rs) * (au[1] * rs)); w.y = pk2(siluf_(ag[2] * rs) * (au[2] * rs), siluf_(ag[3] * rs) * (au[3] * rs));
        *(u32x2v*)(ACT + (size_t)(M + row) * FF + n0 + 4 * (lane >> 4)) = w;
    }
}
__device__ __forceinline__ void phase_resid(const Frame& F, unsigned char* ws, const bf16_t* A, int K, const bf16_t* W, const float* xin, float* xout, const float* xsin, float* xsout, float alpha) {
    bf16_t* XB = (bf16_t*)(ws + WS_XB); float* SSQ = (float*)(ws + WS_SSQ); float* SSQS = (float*)(ws + WS_SSQS);
    pg8::Gemm g{A, W, K, K, K, 0, 0, 256 * K}; pg8::StaticOrder S; S.init(M, D, F.G, F.wg);
    EpiResid E{xin, xout, XB, SSQ, alpha};
    pg8::gemm_phase<EpiResid, pg8::StaticOrder, false, true>(F.lds, g, S, E, F.wave);
    int lane = F.lane; asm volatile("" : "+v"(lane));
    for (int s = F.G - 1 - F.wg; s < D / 16; s += F.G) {
        const int n0 = 16 * s; f32x4 ac, dum; slab_mma<1>(A + (size_t)M * K, K, W + (size_t)n0 * K, W, K, K, F.wave, lane, ac, dum);
        const int row = 16 * F.wave + (lane & 15), c = n0 + 4 * (lane >> 4);
        const f32x4 v = *(const f32x4*)(xsin + (size_t)row * D + c) + ac * alpha;
        *(f32x4*)(xsout + (size_t)row * D + c) = v;
        u32x2v w; w.x = pk2(v[0], v[1]); w.y = pk2(v[2], v[3]); *(u32x2v*)(XB + (size_t)(M + row) * D + c) = w;
        float q = sq4(v); q += __shfl_xor(q, 16); q += __shfl_xor(q, 32);
        if ((lane >> 4) == 0) SSQS[(size_t)row * 64 + s] = q;
    }
}
__device__ __forceinline__ void phase_win(const Frame& F, unsigned char* ws, const bf16_t* W, float* psk) {
    bf16_t* XB = (bf16_t*)(ws + WS_XB); const float* SSQ = (const float*)(ws + WS_SSQ); const float* SSQS = (const float*)(ws + WS_SSQS); float* ZS = (float*)(ws + WS_ZS);
    pg8::Gemm g{XB, W, D, D, D, 0, 0, 256 * D}; pg8::StaticOrder S; S.init(M, DIN, F.G, F.wg);
    EpiZ E{(float*)(ws + WS_ZF), (bf16_t*)(ws + WS_QA), psk, SSQ};
    pg8::gemm_phase<EpiZ, pg8::StaticOrder, true, true>(F.lds, g, S, E, F.wave);
    int lane = F.lane; asm volatile("" : "+v"(lane));
    for (int s = F.G - 1 - F.wg; s < DIN / 16; s += F.G) {
        const int n0 = 16 * s; f32x4 ac, dum; slab_mma<1>(XB + (size_t)M * D, D, W + (size_t)n0 * D, W, D, D, F.wave, lane, ac, dum);
        const int row = 16 * F.wave + (lane & 15); const float rs = rstd64(SSQS, row);
        *(f32x4*)(ZS + (size_t)row * DIN + n0 + 4 * (lane >> 4)) = ac * rs;
    }
}

constexpr int CW_DBG = 8192;
#ifdef DBG
constexpr int N_CH = 9;
__device__ __forceinline__ void dbg_acc(gu32* ctl, int c, float num, float den, int lane) {
    num = wave_sum(num); den = wave_sum(den);
    if (lane == 0) { atomicAdd((float*)(ctl + CW_DBG + 2 * c), num); atomicAdd((float*)(ctl + CW_DBG + 2 * c + 1), den); }
}
template <class FA> __device__ __forceinline__ float ndot(FA fa, const float* W, int K, size_t ldw, int lane) {
    float s = 0.f; for (int k = lane; k < K; k += 64) s += fa(k) * W[(size_t)k * ldw]; return wave_sum(s);
}
__device__ __forceinline__ void dbg_finish(const Frame& F, const Args& a, gu32* ctl) {
    const size_t ooff[N_CH] = {O_YS, O_PLH, O_PLC, O_PHG, O_PSK, O_PSV, O_SLH, O_SLC, O_SHG};
    const size_t osz[N_CH] = {(size_t)MS * D, NL * NB * 256, NL * NB * 768, (size_t)NL * NB * 16384, (size_t)NL * NB * 2048 * 512, (size_t)NL * NB * 2048 * 512, NL * 32 * 256, NL * 32 * 768, (size_t)NL * 32 * 16384};
    const size_t gt = (size_t)F.wg * NTHR + F.tid, NT = (size_t)F.G * NTHR;
    for (size_t e = gt; e < (size_t)M * D; e += NT) a.out[O_YP + e] = 0.f;
    for (int c = 0; c < N_CH; ++c) {
        const float num = __hip_atomic_load((float*)(ctl + CW_DBG + 2 * c), __ATOMIC_RELAXED, __HIP_MEMORY_SCOPE_AGENT), den = __hip_atomic_load((float*)(ctl + CW_DBG + 2 * c + 1), __ATOMIC_RELAXED, __HIP_MEMORY_SCOPE_AGENT);
        size_t n = 0; if (den > 0.f) { float r = 1e4f * fsqrt(num / den); if (!(r < 90000.f)) r = 90000.f; n = 1 + (size_t)(r + 0.5f); }
        size_t cap = osz[c] < 99999 ? osz[c] : 99999; if (n > cap) n = cap;
        for (size_t e = n + gt; e < osz[c]; e += NT) a.out[ooff[c] + e] = 0.f;
    }
    for (int p = F.wg * NTHR + F.tid; p < 2 * NL * SBATCH * 4 * 128; p += F.G * NTHR) { const int kv = p / (NL * SBATCH * 512), r = p % (NL * SBATCH * 512), pr = r / 512, e = r % 512;
        ((f32x4*)(a.out + (kv ? O_SSV : O_SSK)))[(size_t)pr * (WINDOW * 128) + (WINDOW - STOK) * 128 + e] = (f32x4){0.f, 0.f, 0.f, 0.f}; }
}
#endif

constexpr int ZC_XA = 0, ZC_GA = 256, ZC_QB = 512, ZC_FB = 768, ZC_VB = 1024, ZC_GB = 1280, ZC_QC = 1536, ZC_KC = 2048, ZC_VC = 2560;
constexpr float LN2 = 0.6931471805599453f;
#define WG_SYNC() __syncthreads()

__device__ __forceinline__ float hgrn_lb(const float* lbp, int l, int c) {
    const float v0 = lbp[c], v1 = lbp[256 + c], v2 = lbp[512 + c], v3 = lbp[768 + c];
    const float mx = fmaxf(fmaxf(v0, v1), fmaxf(v2, v3));
    const float e0 = fexp(v0 - mx), e1 = fexp(v1 - mx), e2 = fexp(v2 - mx), e3 = fexp(v3 - mx);
    const float inv = 1.0f / ((e0 + e1) + (e2 + e3));
    float s = 0.f; if (l >= 1) s += e1; if (l >= 2) s += e2; if (l >= 3) s += e3;
    return s * inv;
}

struct LruW { const float* convw; const float* convb; const float* wa; const float* ba; const float* wx; const float* bx; const float* lam; const float* gna; };
template <int MODE> __device__ __forceinline__ void lru_seq(const Frame& F, const LruW& W, const float* z, int zld, int T, const float* buf3  , const float* h0  ,
                                                            bf16_t* Y  , float* out_h, float* out_conv, gu32* ctl, int dch) {
    LAS float* xc = (LAS float*)F.lds;
    LAS float* red = xc + 1024;
    const int c = F.tid, n = (c >> 6) & 3, j = c & 63; const bool act = c < 256;
    float xm3 = 0.f, xm2 = 0.f, xm1 = 0.f, h = 0.f;
    float w0 = 0.f, w1 = 0.f, w2 = 0.f, w3 = 0.f, cb = 0.f, ba = 0.f, bx = 0.f, sp = 0.f, gn = 0.f;
    if (act) { if (buf3) { xm3 = buf3[c]; xm2 = buf3[256 + c]; xm1 = buf3[512 + c]; } if (h0) h = h0[c];
        w0 = W.convw[c]; w1 = W.convw[256 + c]; w2 = W.convw[512 + c]; w3 = W.convw[768 + c]; cb = W.convb[c]; ba = W.ba[c]; bx = W.bx[c]; gn = W.gna[c];
        sp = 0.6931471805599453f * flog2(1.f + fexp(-W.lam[c])); }
    float dn = 0.f, dd = 0.f;
    for (int t0 = 0; t0 < T; t0 += 4) {
        float xv[4], xcv[4];
        if (act) {
#pragma unroll
            for (int t = 0; t < 4; ++t) xv[t] = z[(size_t)(t0 + t) * zld + ZC_XA + c];
            xcv[0] = cb + w0 * xm3 + w1 * xm2 + w2 * xm1 + w3 * xv[0];
            xcv[1] = cb + w0 * xm2 + w1 * xm1 + w2 * xv[0] + w3 * xv[1];
            xcv[2] = cb + w0 * xm1 + w1 * xv[0] + w2 * xv[1] + w3 * xv[2];
            xcv[3] = cb + w0 * xv[0] + w1 * xv[1] + w2 * xv[2] + w3 * xv[3];
            xm3 = xv[1]; xm2 = xv[2]; xm1 = xv[3];
#pragma unroll
            for (int t = 0; t < 4; ++t) xc[t * 256 + c] = xcv[t];
        }
        WG_SYNC();
        float y[4] = {0.f, 0.f, 0.f, 0.f};
        if (act) {
            float ra[4] = {0.f, 0.f, 0.f, 0.f}, ri[4] = {0.f, 0.f, 0.f, 0.f};
            for (int k = 0; k < 64; ++k) { const float wa = W.wa[(size_t)(n * 64 + k) * 64 + j], wx = W.wx[(size_t)(n * 64 + k) * 64 + j];
#pragma unroll
                for (int t = 0; t < 4; ++t) { const float x = xc[t * 256 + n * 64 + k]; ra[t] += x * wa; ri[t] += x * wx; } }
#pragma unroll
            for (int t = 0; t < 4; ++t) { const float r = sigmoidf_(ra[t] + ba), ig = sigmoidf_(ri[t] + bx);
                const float la = -8.0f * r * sp, av = fexp(la), u = fsqrt(1.f - fexp(2.f * la)) * (ig * xcv[t]);
                h = av * h + u; const float ga = z[(size_t)(t0 + t) * zld + ZC_GA + c]; y[t] = h * gelu_tanh(ga); }
        }
#pragma unroll
        for (int t = 0; t < 4; ++t) { const float s = wave_sum(y[t] * y[t]); if (F.lane == 0 && F.wave < 4) red[t * 4 + F.wave] = s; }
        WG_SYNC();
        if (act) {
#pragma unroll
            for (int t = 0; t < 4; ++t) { const float tot = (red[t * 4] + red[t * 4 + 1]) + (red[t * 4 + 2] + red[t * 4 + 3]); const float o = y[t] * frsq(tot * (1.f / 256.f) + EPS) * gn;
                if (MODE == 0) Y[(size_t)(t0 + t) * D + c] = (bf16_t)f2bf(o);
                else { const float got = bf2f(Y[(size_t)(t0 + t) * D + c]); dn += (got - o) * (got - o); dd += o * o; } }
        }
        WG_SYNC();
    }
    if (MODE == 0 && act) { out_h[c] = h; out_conv[c] = xm3; out_conv[256 + c] = xm2; out_conv[512 + c] = xm1; }
#ifdef DBG
    if (MODE == 1) dbg_acc(ctl, dch, dn, dd, F.lane);
#endif
}

template <int MODE> __device__ __forceinline__ void hgrn_seq(const Frame& F, const float* lbp, const float* hnorm, int l, int hh, const float* z, int zld, int T, const float* s0  ,
                                                             bf16_t* Y, float* out_s, gu32* ctl, int dch) {
    LAS float* red = (LAS float*)F.lds + 2048;
    const int v = F.lane, d0 = F.wave * 8;
    float S[8], lb[8];
#pragma unroll
    for (int i = 0; i < 8; ++i) { S[i] = s0 ? s0[(size_t)(d0 + i) * 64 + v] : 0.f; lb[i] = hgrn_lb(lbp, l, hh * 64 + d0 + i); }
    const float ng = hnorm[v]; float dn = 0.f, dd = 0.f;
    for (int t = 0; t < T; ++t) {
        const float* zr = z + (size_t)t * zld; const float vv = zr[ZC_VB + hh * 64 + v]; float op = 0.f;
#pragma unroll
        for (int i = 0; i < 8; ++i) { const float fp = zr[ZC_FB + hh * 64 + d0 + i], q = zr[ZC_QB + hh * 64 + d0 + i];
            const float f = lb[i] + (1.f - lb[i]) * sigmoidf_(fp);
            S[i] = f * S[i] + (1.f - f) * vv; op += q * S[i]; }
        red[F.wave * 64 + v] = op;
        WG_SYNC();
        float o = 0.f;
#pragma unroll
        for (int w = 0; w < 8; ++w) o += red[w * 64 + v];
        const float ss = wave_sum(o * o); const float gg = zr[ZC_GB + hh * 64 + v];
        const float y = o * frsq(ss * (1.f / 64.f) + EPS) * ng * siluf_(gg);
        if (F.wave == 0) { if (MODE == 0) Y[(size_t)t * D + 256 + hh * 64 + v] = (bf16_t)f2bf(y);
            else { const float got = bf2f(Y[(size_t)t * D + 256 + hh * 64 + v]); dn += (got - y) * (got - y); dd += y * y; } }
        WG_SYNC();
    }
    if (MODE == 0) {
#pragma unroll
        for (int i = 0; i < 8; ++i) out_s[(size_t)(d0 + i) * 64 + v] = S[i]; }
#ifdef DBG
    if (MODE == 1 && F.wave == 0) dbg_acc(ctl, dch, dn, dd, F.lane);
#endif
}

template <class KV> __device__ __forceinline__ void attn_naive(const KV& kv, const float (&q)[16], int qpos, int h, int lane, float (&o)[16]) {
    const int slot = lane >> 2; const float slope = fast_exp2(-(float)(h + 1)) * LOG2E, sc = 0.125f * LOG2E;
    float m = -1e30f, lsum = 0.f;
#pragma unroll
    for (int i = 0; i < 16; ++i) o[i] = 0.f;
#pragma unroll 1
    for (int pat = 0; pat < 3; ++pat) { const int dil = pat == 0 ? 1 : (pat == 1 ? 4 : 16);
#pragma unroll 1
        for (int j0 = 0; j0 < 129; j0 += 16) { const int jj = j0 + slot; const int kp = qpos - jj * dil; const bool valid = jj <= 128 && kp >= 0;
            float kf[16], vf[16]; kv(valid ? kp : qpos, lane & 3, kf, vf);
            float s = 0.f;
#pragma unroll
            for (int i = 0; i < 16; ++i) s += q[i] * kf[i];
            s += __shfl_xor(s, 1); s += __shfl_xor(s, 2);
            s = valid ? s * sc - slope * (float)(jj * dil) : -INFINITY;
            float mx = s;
#pragma unroll
            for (int of = 4; of < 64; of <<= 1) mx = fmaxf(mx, __shfl_xor(mx, of));
            const float mn = fmaxf(m, mx), alpha = fast_exp2(m - mn), p = fast_exp2(s - mn); m = mn;
            lsum = lsum * alpha + p;
#pragma unroll
            for (int i = 0; i < 16; ++i) o[i] = o[i] * alpha + p * vf[i]; } }
#pragma unroll
    for (int of = 4; of < 64; of <<= 1) { lsum += __shfl_xor(lsum, of);
#pragma unroll
        for (int i = 0; i < 16; ++i) o[i] += __shfl_xor(o[i], of); }
    const float inv = 1.f / lsum;
#pragma unroll
    for (int i = 0; i < 16; ++i) o[i] *= inv;
}
struct KVDecode {
    const float* ck; const float* cv; const float* zs; int h;
    __device__ __forceinline__ void operator()(int kp, int part, float (&kf)[16], float (&vf)[16]) const {
        const float* kr; const float* vr;
        if (kp < WINDOW) { kr = ck + ((size_t)kp * 8 + h) * 64; vr = cv + ((size_t)kp * 8 + h) * 64; } else { kr = zs + (size_t)(kp - WINDOW) * DIN + ZC_KC + h * 64; vr = zs + (size_t)(kp - WINDOW) * DIN + ZC_VC + h * 64; }
#pragma unroll
        for (int i = 0; i < 4; ++i) { const f32x4 a = *(const f32x4*)(kr + part * 16 + 4 * i), b = *(const f32x4*)(vr + part * 16 + 4 * i);
#pragma unroll
            for (int e = 0; e < 4; ++e) { kf[4 * i + e] = a[e]; vf[4 * i + e] = b[e]; } }
    }
};
struct KVPrompt {
    const bf16_t* k; const bf16_t* v;
    __device__ __forceinline__ void operator()(int kp, int part, float (&kf)[16], float (&vf)[16]) const {
#pragma unroll
        for (int i = 0; i < 16; ++i) { kf[i] = bf2f(k[(size_t)kp * 64 + part * 16 + i]); vf[i] = bf2f(v[(size_t)kp * 64 + part * 16 + i]); }
    }
};

__device__ __forceinline__ void lru_local(const Frame& F, unsigned char* ws, const LruW& W, int task, float* out_conv  ) {
    const float* ZF = (const float*)(ws + WS_ZF); float* ACUM = (float*)(ws + WS_ACUM); float* HLOC = (float*)(ws + WS_HLOC);
    const int b = task >> 7, ck = task & 127, t0 = ck * 64, row0 = b * SEQ + t0;
    LAS float* xc = (LAS float*)F.lds;
    LAS float* exch = xc + 64 * 256;
    for (int idx = F.tid; idx < 64 * 64; idx += NTHR) { const int t = idx >> 6, c4 = (idx & 63) * 4;
        f32x4 acc = *(const f32x4*)(W.convb + c4);
#pragma unroll
        for (int tap = 0; tap < 4; ++tap) { const int tt = t0 + t - 3 + tap; if (tt >= 0) acc += *(const f32x4*)(W.convw + tap * 256 + c4) * *(const f32x4*)(ZF + (size_t)(b * SEQ + tt) * 1536 + ZC_XA + c4); }
        *(LAS f32x4*)(xc + t * 256 + c4) = acc; }
    WG_SYNC();
    const int c = F.tid & 255, th = F.tid >> 8, n = c >> 6, j = c & 63;
    float ra[32], ri[32];
#pragma unroll
    for (int t = 0; t < 32; ++t) { ra[t] = 0.f; ri[t] = 0.f; }
#pragma unroll 1
    for (int k4 = 0; k4 < 16; ++k4) {
        float wa[4], wx[4];
#pragma unroll
        for (int e = 0; e < 4; ++e) { wa[e] = W.wa[(size_t)(n * 64 + 4 * k4 + e) * 64 + j]; wx[e] = W.wx[(size_t)(n * 64 + 4 * k4 + e) * 64 + j]; }
#pragma unroll
        for (int t = 0; t < 32; ++t) { const f32x4 x = *(const LAS f32x4*)(xc + (th * 32 + t) * 256 + n * 64 + 4 * k4);
            ra[t] += (x[0] * wa[0] + x[1] * wa[1]) + (x[2] * wa[2] + x[3] * wa[3]); ri[t] += (x[0] * wx[0] + x[1] * wx[1]) + (x[2] * wx[2] + x[3] * wx[3]); }
    }
    const float ba = W.ba[c], bx = W.bx[c], sp = 0.6931471805599453f * flog2(1.f + fexp(-W.lam[c]));
#pragma unroll
    for (int t = 0; t < 32; ++t) { const float r = sigmoidf_(ra[t] + ba), ig = sigmoidf_(ri[t] + bx);
        const float la = -8.0f * r * sp; ra[t] = fexp(la); ri[t] = fsqrt(1.f - fexp(2.f * la)) * (ig * xc[(th * 32 + t) * 256 + c]); }
    float A = 1.f, H = 0.f;
    if (th == 0) {
#pragma unroll
        for (int t = 0; t < 32; ++t) { H = ra[t] * H + ri[t]; A *= ra[t]; ACUM[(size_t)(row0 + t) * 256 + c] = A; HLOC[(size_t)(row0 + t) * 256 + c] = H; }
        exch[2 * c] = A; exch[2 * c + 1] = H; }
    WG_SYNC();
    if (th == 1) { A = exch[2 * c]; H = exch[2 * c + 1];
#pragma unroll
        for (int t = 0; t < 32; ++t) { H = ra[t] * H + ri[t]; A *= ra[t]; ACUM[(size_t)(row0 + 32 + t) * 256 + c] = A; HLOC[(size_t)(row0 + 32 + t) * 256 + c] = H; }
        ((float*)(ws + WS_CA))[(size_t)task * 256 + c] = A; ((float*)(ws + WS_CH))[(size_t)task * 256 + c] = H;
        if (ck == 127) {
#pragma unroll
            for (int q = 0; q < 3; ++q) out_conv[(b * 3 + q) * 256 + c] = ZF[(size_t)(row0 + 61 + q) * 1536 + ZC_XA + c]; } }
    WG_SYNC();
}

constexpr int HS = 68;
__device__ __forceinline__ void hgrn_cum(const Frame& F, const float* ZF, const float* lbp, int l, int b, int hh, int ck, LAS float* gt  , float (&cum8)[8], float (&kk8)[8], float& tot) {
    const int d = F.tid & 63, tg = F.tid >> 6; const float lb = hgrn_lb(lbp, l, hh * 64 + d); float run = 0.f;
#pragma unroll
    for (int i = 0; i < 8; ++i) { const float fp = ZF[(size_t)(b * SEQ + ck * 64 + tg * 8 + i) * 1536 + ZC_FB + hh * 64 + d]; const float f = lb + (1.f - lb) * sigmoidf_(fp);
        run += flog2(f); cum8[i] = run; kk8[i] = 1.f - f; }
    gt[tg * 64 + d] = run;
    WG_SYNC();
    float pre = 0.f; tot = 0.f;
#pragma unroll
    for (int g = 0; g < 8; ++g) { const float x = gt[g * 64 + d]; if (g < tg) pre += x; tot += x; }
#pragma unroll
    for (int i = 0; i < 8; ++i) cum8[i] += pre;
}
__device__ __forceinline__ void hgrn_local(const Frame& F, unsigned char* ws, const float* lbp, int l, int task) {
    const float* ZF = (const float*)(ws + WS_ZF);
    const int ck = task & 127, hh = (task >> 7) & 3, b = task >> 9;
    LAS float* kp = (LAS float*)F.lds; LAS float* vv = kp + 64 * HS; LAS float* gt = vv + 64 * HS;
    float cum8[8], kk8[8], tot; hgrn_cum(F, ZF, lbp, l, b, hh, ck, gt, cum8, kk8, tot);
    const int d = F.tid & 63, tg = F.tid >> 6;
#pragma unroll
    for (int i = 0; i < 8; ++i) { kp[(tg * 8 + i) * HS + d] = kk8[i] * fast_exp2(tot - cum8[i]); vv[(tg * 8 + i) * HS + d] = ZF[(size_t)(b * SEQ + ck * 64 + tg * 8 + i) * 1536 + ZC_VB + hh * 64 + d]; }
    if (tg == 0) ((float*)(ws + WS_HDEC))[(size_t)task * 64 + d] = fast_exp2(tot);
    WG_SYNC();
    const int dd0 = 2 * (F.tid >> 4), v0 = 4 * (F.tid & 15); f32x4 a0 = {0.f, 0.f, 0.f, 0.f}, a1 = {0.f, 0.f, 0.f, 0.f};
#pragma unroll 8
    for (int s = 0; s < 64; ++s) { const f32x2v kx = *(const LAS f32x2v*)(kp + s * HS + dd0); const f32x4 vx = *(const LAS f32x4*)(vv + s * HS + v0); a0 += vx * kx[0]; a1 += vx * kx[1]; }
    float* KV = (float*)(ws + WS_HKV) + (size_t)task * 4096;
    *(f32x4*)(KV + dd0 * 64 + v0) = a0; *(f32x4*)(KV + (dd0 + 1) * 64 + v0) = a1;
    WG_SYNC();
}
__device__ __forceinline__ void hgrn_out(const Frame& F, unsigned char* ws, const float* lbp, const float* hnorm, int l, int task) {
    const float* ZF = (const float*)(ws + WS_ZF); bf16_t* Y = (bf16_t*)(ws + WS_Y);
    const int ck = task & 127, hh = (task >> 7) & 3, b = task >> 9, row0 = b * SEQ + ck * 64;
    LAS float* q = (LAS float*)F.lds; LAS float* k = q + 64 * HS; LAS float* cu = k + 64 * HS; LAS float* vv = cu + 64 * HS; LAS float* sc = vv + 64 * HS; LAS float* sp = sc + 64 * HS; LAS float* gt = sp + 64 * HS;
    float cum8[8], kk8[8], tot; hgrn_cum(F, ZF, lbp, l, b, hh, ck, gt, cum8, kk8, tot);
    const int d = F.tid & 63, tg = F.tid >> 6;
#pragma unroll
    for (int i = 0; i < 8; ++i) { const int t = tg * 8 + i; const float* zr = ZF + (size_t)(row0 + t) * 1536;
        q[t * HS + d] = zr[ZC_QB + hh * 64 + d]; k[t * HS + d] = kk8[i]; cu[t * HS + d] = cum8[i]; vv[t * HS + d] = zr[ZC_VB + hh * 64 + d]; }
    { const float* SP = (const float*)(ws + WS_HSP) + (size_t)task * 4096;
#pragma unroll
      for (int i = 0; i < 2; ++i) { const int idx = F.tid + NTHR * i, r = idx >> 4, c4 = (idx & 15) * 4; *(LAS f32x4*)(sp + r * HS + c4) = *(const f32x4*)(SP + r * 64 + c4); } }
    WG_SYNC();
    { const int t = F.tid >> 3, sg = F.tid & 7;
#pragma unroll 1
      for (int i = 0; i < 8; ++i) { const int s = sg + 8 * i; float acc = 0.f;
          if (s <= t) {
#pragma unroll 4
              for (int d4 = 0; d4 < 16; ++d4) { const f32x4 qv = *(const LAS f32x4*)(q + t * HS + 4 * d4), ct = *(const LAS f32x4*)(cu + t * HS + 4 * d4), kv = *(const LAS f32x4*)(k + s * HS + 4 * d4), cs = *(const LAS f32x4*)(cu + s * HS + 4 * d4);
#pragma unroll
                  for (int e = 0; e < 4; ++e) acc += qv[e] * kv[e] * fast_exp2(ct[e] - cs[e]); } }
          sc[t * HS + s] = acc; } }
    WG_SYNC();
    { const int t = F.tid >> 3, vg = F.tid & 7, v0 = 8 * vg; f32x4 a0 = {0.f, 0.f, 0.f, 0.f}, a1 = {0.f, 0.f, 0.f, 0.f};
#pragma unroll 1
      for (int s = 0; s <= t; ++s) { const float w = sc[t * HS + s]; a0 += *(const LAS f32x4*)(vv + s * HS + v0) * w; a1 += *(const LAS f32x4*)(vv + s * HS + v0 + 4) * w; }
#pragma unroll 4
      for (int dd = 0; dd < 64; ++dd) { const float w = q[t * HS + dd] * fast_exp2(cu[t * HS + dd]); a0 += *(const LAS f32x4*)(sp + dd * HS + v0) * w; a1 += *(const LAS f32x4*)(sp + dd * HS + v0 + 4) * w; }
      float ss = sq4(a0) + sq4(a1); ss += __shfl_xor(ss, 1); ss += __shfl_xor(ss, 2); ss += __shfl_xor(ss, 4);
      const float rs = frsq(ss * (1.f / 64.f) + EPS); const float* zr = ZF + (size_t)(row0 + t) * 1536 + ZC_GB + hh * 64 + v0;
      const f32x4 g0 = *(const f32x4*)zr, g1 = *(const f32x4*)(zr + 4), n0 = *(const f32x4*)(hnorm + v0), n1 = *(const f32x4*)(hnorm + v0 + 4);
#pragma unroll
      for (int e = 0; e < 4; ++e) { a0[e] = a0[e] * rs * n0[e] * siluf_(g0[e]); a1[e] = a1[e] * rs * n1[e] * siluf_(g1[e]); }
      *(u32x4*)(Y + (size_t)(row0 + t) * D + 256 + hh * 64 + v0) = pack8(a0, a1); }
    WG_SYNC();
}

typedef short s16x4 __attribute__((ext_vector_type(4)));
typedef short v4i16_t __attribute__((ext_vector_type(4)));
constexpr int VROW = 144;
constexpr int ATT_WAVE_LDS = 2 * 2 * 16 * VROW;
__device__ __forceinline__ void attn_wave_task(const Frame& F, unsigned char* ws, int b, int h, int P, int r, LAS unsigned char* wl) {
    const bf16_t* QA = (const bf16_t*)(ws + WS_QA) + (size_t)(b * 8 + h) * SEQ * 64; const bf16_t* KA = (const bf16_t*)(ws + WS_KA) + (size_t)(b * 8 + h) * SEQ * 64; const bf16_t* VA = (const bf16_t*)(ws + WS_VA) + (size_t)(b * 8 + h) * SEQ * 64;
    const int lane = F.lane, qi = lane & 15, g = lane >> 4, base = 256 * P;
    const float sc = 0.125f * LOG2E, slope = fast_exp2(-(float)(h + 1)) * LOG2E;
    bf16x8 qf[2];
    { const bf16_t* qp = QA + (size_t)(base + r + 16 * qi) * 64 + 8 * g; qf[0] = *(const bf16x8*)qp; qf[1] = *(const bf16x8*)(qp + 32); }
    f32x4 O[4];
#pragma unroll
    for (int i = 0; i < 4; ++i) O[i] = (f32x4){0.f, 0.f, 0.f, 0.f};
    float m = -1e30f, lsum = 0.f;
    auto step_geom = [&](int st, int& dil, int& res, int& a0, int& aq0, int& aqs) {
        if (st < 5) { dil = 16; res = r; a0 = 16 * P - 128 + 32 * st; aq0 = 16 * P; aqs = 1; }
        else if (st < 11) { dil = 4; res = r & 3; a0 = 64 * P - 128 + 32 * (st - 5); aq0 = 64 * P + (r >> 2); aqs = 4; }
        else { dil = 1; res = 0; a0 = 256 * P - 128 + 32 * (st - 11); aq0 = 256 * P + r; aqs = 16; } };
    bf16x8 kreg[4]; u32x4 vreg[4];
    auto prefetch = [&](int st) { int dil, res, a0, aq0, aqs; step_geom(st, dil, res, a0, aq0, aqs);
#pragma unroll
        for (int tt = 0; tt < 2; ++tt) { int pk = dil * (a0 + 16 * tt + qi) + res; pk = pk < 0 ? 0 : (pk > SEQ - 1 ? SEQ - 1 : pk);
            const bf16_t* kp = KA + (size_t)pk * 64 + 8 * g; kreg[2 * tt] = *(const bf16x8*)kp; kreg[2 * tt + 1] = *(const bf16x8*)(kp + 32);
            int pv = dil * (a0 + 16 * tt + (lane >> 2)) + res; pv = pv < 0 ? 0 : (pv > SEQ - 1 ? SEQ - 1 : pv);
            const bf16_t* vp = VA + (size_t)pv * 64 + 16 * (lane & 3); vreg[2 * tt] = *(const u32x4*)vp; vreg[2 * tt + 1] = *(const u32x4*)(vp + 8); } };
    prefetch(0);
#pragma unroll 1
    for (int st = 0; st < 23; ++st) {
        int dil, res, a0, aq0, aqs; step_geom(st, dil, res, a0, aq0, aqs);
        LAS unsigned char* vb = wl + (st & 1) * (2 * 16 * VROW);
        bf16x8 kc[4];
#pragma unroll
        for (int i = 0; i < 4; ++i) kc[i] = kreg[i];
#pragma unroll
        for (int tt = 0; tt < 2; ++tt) { LAS unsigned char* p = vb + tt * (16 * VROW) + (lane >> 2) * VROW + 32 * (lane & 3); *(LAS u32x4*)p = vreg[2 * tt]; *(LAS u32x4*)(p + 16) = vreg[2 * tt + 1]; }
        if (st + 1 < 23) prefetch(st + 1);
        f32x4 s0 = {0.f, 0.f, 0.f, 0.f}, s1 = {0.f, 0.f, 0.f, 0.f};
        s0 = __builtin_amdgcn_mfma_f32_16x16x32_bf16(kc[0], qf[0], s0, 0, 0, 0); s0 = __builtin_amdgcn_mfma_f32_16x16x32_bf16(kc[1], qf[1], s0, 0, 0, 0);
        s1 = __builtin_amdgcn_mfma_f32_16x16x32_bf16(kc[2], qf[0], s1, 0, 0, 0); s1 = __builtin_amdgcn_mfma_f32_16x16x32_bf16(kc[3], qf[1], s1, 0, 0, 0);
        const int aq = aq0 + aqs * qi; float mx = -INFINITY;
#pragma unroll
        for (int e = 0; e < 4; ++e) { const int ak0 = a0 + 4 * g + e, ak1 = ak0 + 16; const int d0 = aq - ak0, d1 = aq - ak1;
            s0[e] = (d0 >= 0 && d0 <= 128 && ak0 >= 0) ? s0[e] * sc - slope * (float)(d0 * dil) : -INFINITY;
            s1[e] = (d1 >= 0 && d1 <= 128 && ak1 >= 0) ? s1[e] * sc - slope * (float)(d1 * dil) : -INFINITY;
            mx = fmaxf(mx, fmaxf(s0[e], s1[e])); }
        mx = fmaxf(mx, __shfl_xor(mx, 16)); mx = fmaxf(mx, __shfl_xor(mx, 32));
        const float mn = fmaxf(m, mx), alpha = fast_exp2(m - mn); m = mn;
        float ps = 0.f; f32x4 p0, p1;
#pragma unroll
        for (int e = 0; e < 4; ++e) { p0[e] = fast_exp2(s0[e] - mn); p1[e] = fast_exp2(s1[e] - mn); ps += p0[e] + p1[e]; }
        lsum = lsum * alpha + ps;
        const u32x4 pw = pack8(p0, p1); const bf16x8 pf = __builtin_bit_cast(bf16x8, pw);
#pragma unroll
        for (int dt = 0; dt < 4; ++dt) { O[dt] *= alpha;
            LAS unsigned char* a0p = vb + (4 * g + (qi >> 2)) * VROW + (16 * dt + 4 * (qi & 3)) * 2;
            const s16x4 lo = __builtin_bit_cast(s16x4, __builtin_amdgcn_ds_read_tr16_b64_v4i16((LAS v4i16_t*)a0p));
            const s16x4 hi = __builtin_bit_cast(s16x4, __builtin_amdgcn_ds_read_tr16_b64_v4i16((LAS v4i16_t*)(a0p + 16 * VROW)));
            bf16x8 vf; vf[0] = lo[0]; vf[1] = lo[1]; vf[2] = lo[2]; vf[3] = lo[3]; vf[4] = hi[0]; vf[5] = hi[1]; vf[6] = hi[2]; vf[7] = hi[3];
            O[dt] = __builtin_amdgcn_mfma_f32_16x16x32_bf16(vf, pf, O[dt], 0, 0, 0); }
    }
    lsum += __shfl_xor(lsum, 16); lsum += __shfl_xor(lsum, 32);
    const float inv = 1.f / lsum; float* yc = (float*)(ws + WS_YC) + (size_t)(b * SEQ + base + r + 16 * qi) * 512 + h * 64 + 4 * g;
#pragma unroll
    for (int dt = 0; dt < 4; ++dt) *(f32x4*)(yc + 16 * dt) = O[dt] * inv;
}

__device__ __forceinline__ void xattn_sample(const Frame& F, unsigned char* ws, const float* cmk, const float* cmv  , int sb, int h) {
    const bf16_t* QX = (const bf16_t*)(ws + WS_QX) + (size_t)(M + sb * 4) * D + h * 256; bf16_t* OB = (bf16_t*)(ws + WS_OB) + (size_t)(M + sb * 4) * D + h * 256;
    LAS float* q = (LAS float*)F.lds;
    LAS float* sc = q + 1024;
    for (int i = F.tid; i < 1024; i += NTHR) q[i] = bf2f(QX[(size_t)(i >> 8) * D + (i & 255)]);
    WG_SYNC();
    { const int m = F.tid & 255, th = F.tid >> 8; const float* kr = cmk + ((size_t)(sb * 256 + m) * 4 + h) * 256; float s0 = 0.f, s1 = 0.f;
#pragma unroll 4
      for (int d4 = 0; d4 < 64; ++d4) { const f32x4 kv = *(const f32x4*)(kr + 4 * d4), q0 = *(const LAS f32x4*)(q + (2 * th) * 256 + 4 * d4), q1 = *(const LAS f32x4*)(q + (2 * th + 1) * 256 + 4 * d4);
          s0 += (kv[0] * q0[0] + kv[1] * q0[1]) + (kv[2] * q0[2] + kv[3] * q0[3]); s1 += (kv[0] * q1[0] + kv[1] * q1[1]) + (kv[2] * q1[2] + kv[3] * q1[3]); }
      sc[(2 * th) * 256 + m] = s0 * (LOG2E / 16.f); sc[(2 * th + 1) * 256 + m] = s1 * (LOG2E / 16.f); }
    WG_SYNC();
    if (F.wave < 4) { const f32x4 s = *(const LAS f32x4*)(sc + F.wave * 256 + 4 * F.lane); const float mx = wave_max(fmaxf(fmaxf(s[0], s[1]), fmaxf(s[2], s[3])));
        f32x4 p; float ps = 0.f;
#pragma unroll
        for (int e = 0; e < 4; ++e) { p[e] = fast_exp2(s[e] - mx); ps += p[e]; }
        ps = wave_sum(ps); *(LAS f32x4*)(sc + F.wave * 256 + 4 * F.lane) = p * (1.f / ps); }
    WG_SYNC();
    { const int d = F.tid & 255, th = F.tid >> 8; const float* vr = cmv + ((size_t)(sb * 256) * 4 + h) * 256 + d; float o0 = 0.f, o1 = 0.f;
#pragma unroll 8
      for (int m = 0; m < 256; ++m) { const float v = vr[(size_t)m * 1024]; o0 += sc[(2 * th) * 256 + m] * v; o1 += sc[(2 * th + 1) * 256 + m] * v; }
      OB[(size_t)(2 * th) * D + d] = (bf16_t)f2bf(o0); OB[(size_t)(2 * th + 1) * D + d] = (bf16_t)f2bf(o1); }
    WG_SYNC();
}

constexpr int PH_PRO = 0, PH_MEM = 1, PH_L0 = 2, PH_PER_L = 13, PH_FIN = PH_L0 + NL * PH_PER_L, N_PHASES = PH_FIN + 1;

__device__ __forceinline__ const float* ain(const Args& a, int i) { asm volatile("" : "+s"(i)); return a.in[i]; }
#define AIN(i) ain(a, (i))
#define WSL unsigned char* ws = ws0; asm volatile("" : "+s"(ws))
__global__ void __launch_bounds__(NTHR, 2) fwd(Args a) {
    extern __shared__ __attribute__((aligned(16))) unsigned char lds_raw[];
    Frame F0; Frame& F = F0;
    F.lds = (LAS unsigned char*)lds_raw;
    F.tid = 0; F.lane = 0; F.wave = __builtin_amdgcn_readfirstlane(threadIdx.x >> 6);
    F.G = gridDim.x; F.wg = blockIdx.x;
    unsigned char* ws0 = a.ws;
    gu32* ctl = (gu32*)(ws0 + WS_CTL);
    for (int u = threadIdx.x; u < (LDS_BYTES - LDSCTL_OFF) / 4; u += NTHR) ((LAS unsigned*)(F.lds + LDSCTL_OFF))[u] = 0u;
    __syncthreads();
    XcdBarrier bar = xcd_barrier_post((unsigned*)(ctl + CW_BAR), (volatile LAS unsigned*)(F.lds + LDSCTL_OFF + 64));
#define IN(k) true
#define SEAM(k) do { if (IN(k) && IN((k) + 1)) { XcdBarrier b_ = bar; asm volatile("" : "+s"(b_.bar), "+s"(b_.x)); xcd_barrier(b_); } } while (0)
#define FRESH(Fn) Frame Fn = F0; asm volatile("" : "+s"(Fn.wave), "+s"(Fn.G), "+s"(Fn.wg)); Fn.lane = (int)__builtin_amdgcn_mbcnt_hi(~0u, __builtin_amdgcn_mbcnt_lo(~0u, 0u)); asm volatile("" : "+v"(Fn.lane)); Fn.tid = Fn.wave * 64 + Fn.lane

    if (IN(PH_PRO)) { FRESH(F); p0_prologue(F, a); }
    SEAM(PH_PRO);
    if (IN(PH_MEM)) { FRESH(F); WSL;
        pg8::Gemm g{(const bf16_t*)(ws + WS_MEMB), (const bf16_t*)(ws + WS_WKV), D, D, D, 0, 0, 256 * D};
        pg8::StaticOrder S; S.init(512, 8192, F.G, F.wg);
        EpiMem E{a.out + O_PMK, a.out + O_PMV, (bf16_t*)(ws + WS_MEMK), (bf16_t*)(ws + WS_MEMVT), (float*)(ws + WS_KMAX)};
        pg8::gemm_phase<EpiMem, pg8::StaticOrder, false, true>(F.lds, g, S, E, F.wave);
        p1_cache_copy(F, a);
    }
    SEAM(PH_MEM);
#ifdef DBG
    if (0 && IN(PH_MEM) && F.wg == F.G - 1) { FRESH(F); WSL;
        for (int i = 0; i < 16; ++i) { const unsigned hsh = (unsigned)(i * 8 + F.wave) * 2654435761u; const int l = hsh & 3, kv = (hsh >> 2) & 1, b = (hsh >> 3) & 1, m = (hsh >> 4) & 255, n = (hsh >> 12) & 1023;
            const float* A = AIN(I_MEMP) + (size_t)(b * 256 + m) * D; const float* W = AIN(kv ? I_XWV : I_XWK) + (size_t)l * D * D + n;
            const float ref = ndot([&](int k) { return A[k]; }, W, D, D, F.lane);
            const float got = (a.out + (kv ? O_PMV : O_PMK))[((size_t)((l * 2 + b) * 256 + m)) * 1024 + n];
            const float gb = kv ? bf2f(((const bf16_t*)(ws + WS_MEMVT))[((size_t)(l * 2 + b) * 1024 + n) * 256 + m]) : bf2f(((const bf16_t*)(ws + WS_MEMK))[((size_t)((l * 2 + b) * 256 + m)) * 1024 + n]);
            if (F.lane == 0) { atomicAdd((float*)(ctl + CW_DBG + 0), (got - ref) * (got - ref)); atomicAdd((float*)(ctl + CW_DBG + 1), ref * ref);
                               atomicAdd((float*)(ctl + CW_DBG + 2), (gb - ref) * (gb - ref)); atomicAdd((float*)(ctl + CW_DBG + 3), ref * ref); } }
    }
#endif
#ifdef DBG
#define OUTL float* OUTS = (float*)(ws + WS_SHADOW); float* XP = OUTS + O_YP; float* XS = OUTS + O_YS; (void)XP; (void)XS
#else
#define OUTL float* OUTS = a.out; asm volatile("" : "+s"(OUTS)); float* XP = OUTS + O_YP; float* XS = OUTS + O_YS; (void)XP; (void)XS
#endif
#pragma unroll 1
    for (int l = 0; l < NL; ++l) {
        const int pb = PH_L0 + l * PH_PER_L;
        if (IN(pb + 0)) { FRESH(F); WSL; phase_ffn_up(F, ws, (const bf16_t*)(ws + WS_W) + (size_t)l * LW_SZ + LW_1U); }
        SEAM(pb + 0);
#ifdef DBG
        if (l == 0 && IN(pb + 0) && F.wg == F.G - 1) { FRESH(F); WSL; OUTL;
            for (int i = 0; i < 8; ++i) { const unsigned hsh = (unsigned)(i * 8 + F.wave + 1) * 2654435761u; int row = (hsh >> 4) % MT; if (i == 7) row = M + (hsh >> 4) % MS; const int c = (hsh >> 19) % FF;
                const float* x = row < M ? AIN(I_XP) + (size_t)row * D : AIN(I_XS) + (size_t)(row - M) * D; const float* gn = AIN(I_NF1);
                const float ss = ndot([&](int k) { return x[k]; }, x, D, 1, F.lane); const float rs = frsq(ss / D + EPS);
                const float gv = ndot([&](int k) { return x[k] * rs * gn[k]; }, AIN(I_F1G) + c, D, FF, F.lane), uv = ndot([&](int k) { return x[k] * rs * gn[k]; }, AIN(I_F1U) + c, D, FF, F.lane);
                const float ref = gv / (1.f + fexp(-gv)) * uv, got = bf2f(((const bf16_t*)(ws + WS_ACT))[(size_t)row * FF + c]);
                if (F.lane == 0) { atomicAdd((float*)(ctl + CW_DBG + 4), (got - ref) * (got - ref)); atomicAdd((float*)(ctl + CW_DBG + 5), ref * ref); } }
        }
#endif
        if (IN(pb + 1)) { FRESH(F); WSL; OUTL; phase_resid(F, ws, (const bf16_t*)(ws + WS_ACT), FF, (const bf16_t*)(ws + WS_W) + (size_t)l * LW_SZ + LW_1D, l == 0 ? AIN(I_XP) : XP, XP, l == 0 ? AIN(I_XS) : XS, XS, 0.5f); }
        SEAM(pb + 1);
#ifdef DBG
        if (l == 0 && IN(pb + 1) && F.wg == F.G - 1) { FRESH(F); WSL; OUTL;
            for (int i = 0; i < 8; ++i) { const unsigned hsh = (unsigned)(i * 8 + F.wave + 77) * 2654435761u; int row = (hsh >> 4) % MT; if (i == 7) row = M + (hsh >> 4) % MS; const int n = (hsh >> 19) % D;
                const float xo = row < M ? AIN(I_XP)[(size_t)row * D + n] : AIN(I_XS)[(size_t)(row - M) * D + n]; const bf16_t* ar = (const bf16_t*)(ws + WS_ACT) + (size_t)row * FF;
                const float ref = xo + 0.5f * ndot([&](int k) { return bf2f(ar[k]); }, AIN(I_F1D) + n, FF, D, F.lane);
                const float* xr = row < M ? XP + (size_t)row * D : XS + (size_t)(row - M) * D; const float got = xr[n];
                const float ss = ndot([&](int k) { return xr[k]; }, xr, D, 1, F.lane);
                float sp = 0.f; if (row < M) { if (F.lane < 16) sp = ((const float*)(ws + WS_SSQ))[(size_t)row * 16 + F.lane]; } else sp = ((const float*)(ws + WS_SSQS))[(size_t)(row - M) * 64 + F.lane]; sp = wave_sum(sp);
                const float xbv = bf2f(((const bf16_t*)(ws + WS_XB))[(size_t)row * D + n]);
                if (F.lane == 0) { atomicAdd((float*)(ctl + CW_DBG + 6), (got - ref) * (got - ref) + (xbv - got) * (xbv - got)); atomicAdd((float*)(ctl + CW_DBG + 7), ref * ref);
                                   atomicAdd((float*)(ctl + CW_DBG + 8), (sp - ss) * (sp - ss)); atomicAdd((float*)(ctl + CW_DBG + 9), ss * ss); } }
        }
#endif
        if (IN(pb + 2)) { FRESH(F); WSL; OUTL; phase_win(F, ws, (const bf16_t*)(ws + WS_W) + (size_t)l * LW_SZ + LW_IN, OUTS + O_PSK + (size_t)l * NB * WINDOW * 512); }
        SEAM(pb + 2);
#ifdef DBG
        if (l == 0 && IN(pb + 2) && F.wg == F.G - 1) { FRESH(F); WSL; OUTL;
            for (int i = 0; i < 12; ++i) { const unsigned hsh = (unsigned)(i * 8 + F.wave + 177) * 2654435761u; int row = (hsh >> 4) % M; if (i >= 10) row = M + (hsh >> 4) % MS; if (i == 8 || i == 9) row = (row & 8191) | 6144 | (row & 8192 ? 8192 : 0);
                int n = (hsh >> 19) % DIN; if (i == 8) n = 2048 + n % 512; if (i == 9) n = 2560 + n % 512;
                const float* xr = row < M ? XP + (size_t)row * D : XS + (size_t)(row - M) * D; const float* gn = AIN(I_NMIX);
                const float ss = ndot([&](int k) { return xr[k]; }, xr, D, 1, F.lane); const float rs = frsq(ss / D + EPS);
                const float ref = ndot([&](int k) { return xr[k] * rs * gn[k]; }, AIN(I_WIN) + n, D, DIN, F.lane);
                float got, got2 = ref;
                if (row >= M) got = ((const float*)(ws + WS_ZS))[(size_t)(row - M) * DIN + n];
                else if (n < 1536) got = ((const float*)(ws + WS_ZF))[(size_t)row * 1536 + n];
                else { const int gsel = (n - 1536) / 512, c512 = (n - 1536) % 512, h = c512 >> 6, d = c512 & 63, b = row >> 13, t = row & 8191;
                    const bf16_t* src = (const bf16_t*)(ws + (gsel == 0 ? WS_QA : (gsel == 1 ? WS_KA : WS_VA))); got = bf2f(src[((size_t)(b * 8 + h) * SEQ + t) * 64 + d]);
                    if (gsel >= 1 && t >= SEQ - WINDOW) got2 = (OUTS + (gsel == 1 ? O_PSK : O_PSV))[((size_t)(b * WINDOW + t - (SEQ - WINDOW)) * 8 + h) * 64 + d]; }
                if (F.lane == 0) { atomicAdd((float*)(ctl + CW_DBG + 10), (got - ref) * (got - ref) + (got2 - ref) * (got2 - ref)); atomicAdd((float*)(ctl + CW_DBG + 11), ref * ref); } }
        }
#endif
        if (IN(pb + 3)) { FRESH(F); WSL; OUTL; const LruW LW{AIN(I_CONVW) + l * 1024, AIN(I_CONVB) + l * 256, AIN(I_LWA) + (size_t)l * 16384, AIN(I_LBA) + l * 256, AIN(I_LWX) + (size_t)l * 16384, AIN(I_LBX) + l * 256, AIN(I_LAM) + l * 256, AIN(I_GNA) + l * 256};
            const float* LBP = AIN(I_HLB); const float* HNORM = AIN(I_HNORM) + l * 64; bf16_t* Ybuf = (bf16_t*)(ws + WS_Y); float* ZS = (float*)(ws + WS_ZS); (void)LW; (void)LBP; (void)HNORM; (void)Ybuf; (void)ZS;
            for (int task = F.wg; task < 256; task += F.G) lru_local(F, ws, LW, task, OUTS + O_PLC + (size_t)l * NB * 768);
            for (int task = F.wg; task < 1024; task += F.G) hgrn_local(F, ws, LBP, l, task);
            for (int s = F.G - 1 - F.wg; s < 160; s += F.G) {
                if (s < 32) lru_seq<0>(F, LW, ZS + (size_t)s * 4 * DIN, DIN, 4, AIN(I_SLC) + (size_t)(l * 32 + s) * 768, AIN(I_SLH) + (size_t)(l * 32 + s) * 256, Ybuf + (size_t)(M + s * 4) * D,
                                       OUTS + O_SLH + (size_t)(l * 32 + s) * 256, OUTS + O_SLC + (size_t)(l * 32 + s) * 768, ctl, 0);
                else { const int sb = (s - 32) >> 2, hh = (s - 32) & 3; const size_t so = ((size_t)(l * 32 + sb) * 4 + hh) * 4096;
                    hgrn_seq<0>(F, LBP, HNORM, l, hh, ZS + (size_t)sb * 4 * DIN, DIN, 4, AIN(I_SHG) + so, Ybuf + (size_t)(M + sb * 4) * D, OUTS + O_SHG + so, ctl, 0); }
            }
        }
        SEAM(pb + 3);
        if (IN(pb + 4)) { FRESH(F); WSL; OUTL; const LruW LW{AIN(I_CONVW) + l * 1024, AIN(I_CONVB) + l * 256, AIN(I_LWA) + (size_t)l * 16384, AIN(I_LBA) + l * 256, AIN(I_LWX) + (size_t)l * 16384, AIN(I_LBX) + l * 256, AIN(I_LAM) + l * 256, AIN(I_GNA) + l * 256};
            const float* LBP = AIN(I_HLB); const float* HNORM = AIN(I_HNORM) + l * 64; bf16_t* Ybuf = (bf16_t*)(ws + WS_Y); float* ZS = (float*)(ws + WS_ZS); (void)LW; (void)LBP; (void)HNORM; (void)Ybuf; (void)ZS;
            if (F.wave < 2) { for (int chain = F.wg * 2 + F.wave; chain < 512; chain += F.G * 2) { const int bh = chain >> 6, dr = chain & 63; float S = 0.f;
                    const float* KV = (const float*)(ws + WS_HKV) + (size_t)bh * 128 * 4096 + dr * 64 + F.lane; const float* DEC = (const float*)(ws + WS_HDEC) + (size_t)bh * 128 * 64 + dr; float* SP = (float*)(ws + WS_HSP) + (size_t)bh * 128 * 4096 + dr * 64 + F.lane;
#pragma unroll 8
                    for (int c = 0; c < 128; ++c) { SP[(size_t)c * 4096] = S; S = DEC[c * 64] * S + KV[(size_t)c * 4096]; }
                    (OUTS + O_PHG)[((size_t)(l * 8 + bh)) * 4096 + dr * 64 + F.lane] = S; } }
            else if (F.wave == 2) { for (int t = F.wg; t < 8; t += F.G) { const int b = t >> 2, ch = (t & 3) * 64 + F.lane; float hc = 0.f;
                    const float* CA = (const float*)(ws + WS_CA) + (size_t)b * 128 * 256 + ch; const float* CH = (const float*)(ws + WS_CH) + (size_t)b * 128 * 256 + ch; float* HIN = (float*)(ws + WS_HIN) + (size_t)b * 128 * 256 + ch;
#pragma unroll 8
                    for (int c = 0; c < 128; ++c) { HIN[c * 256] = hc; hc = CA[c * 256] * hc + CH[c * 256]; }
                    (OUTS + O_PLH)[(l * 2 + b) * 256 + ch] = hc; } }
            for (int u = F.wg; u < 512; u += F.G) { const int b = u >> 8, h = (u >> 5) & 7, P = u & 31;
                for (int r = F.wave; r < 16; r += 8) attn_wave_task(F, ws, b, h, P, r, F.lds + F.wave * ATT_WAVE_LDS); }
            for (int id = F.wg * 8 + F.wave; id < 1024; id += F.G * 8) { const int t = id & 3, h = (id >> 2) & 7, sb = id >> 5, row = sb * 4 + t, part = F.lane & 3;
                float q[16], o[16];
#pragma unroll
                for (int i = 0; i < 16; ++i) q[i] = ZS[(size_t)row * DIN + ZC_QC + h * 64 + part * 16 + i];
                KVDecode kv{AIN(I_CSK) + (size_t)(l * 32 + sb) * WINDOW * 512, AIN(I_CSV) + (size_t)(l * 32 + sb) * WINDOW * 512, ZS + (size_t)sb * 4 * DIN, h};
                attn_naive(kv, q, WINDOW + t, h, F.lane, o);
                if (F.lane < 4) { float* yc = (float*)(ws + WS_YC) + (size_t)(M + row) * 512 + h * 64 + part * 16;
#pragma unroll
                    for (int i = 0; i < 16; ++i) yc[i] = o[i]; } }
            for (int e = F.wg * NTHR + F.tid; e < MS * 256; e += F.G * NTHR) { const int row = e >> 8, c4 = (e & 255) * 4, kvs = c4 >> 9, cc = c4 & 511, sb = row >> 2, t = row & 3;
                *(f32x4*)(a.out + (kvs ? O_SSV : O_SSK) + ((size_t)(l * 32 + sb) * WINDOW + (WINDOW - STOK) + t) * 512 + cc) = *(const f32x4*)(ZS + (size_t)row * DIN + ZC_KC + kvs * 512 + cc); }
        }
        SEAM(pb + 4);
        if (IN(pb + 5)) { FRESH(F); WSL; OUTL; const LruW LW{AIN(I_CONVW) + l * 1024, AIN(I_CONVB) + l * 256, AIN(I_LWA) + (size_t)l * 16384, AIN(I_LBA) + l * 256, AIN(I_LWX) + (size_t)l * 16384, AIN(I_LBX) + l * 256, AIN(I_LAM) + l * 256, AIN(I_GNA) + l * 256};
            const float* LBP = AIN(I_HLB); const float* HNORM = AIN(I_HNORM) + l * 64; bf16_t* Ybuf = (bf16_t*)(ws + WS_Y); float* ZS = (float*)(ws + WS_ZS); (void)LW; (void)LBP; (void)HNORM; (void)Ybuf; (void)ZS;
            for (int task = F.wg; task < 1024; task += F.G) hgrn_out(F, ws, LBP, HNORM, l, task);
            const float* GNC = AIN(I_GNC) + l * 512; const float* ZF = (const float*)(ws + WS_ZF);
            for (int row = F.wg * NWAVES + F.wave; row < MT; row += F.G * NWAVES) {
                if (row < M) { const int b = row >> 13, ck = (row & 8191) >> 6, c4 = 4 * F.lane;
                    const f32x4 ac = *(const f32x4*)((const float*)(ws + WS_ACUM) + (size_t)row * 256 + c4), hl = *(const f32x4*)((const float*)(ws + WS_HLOC) + (size_t)row * 256 + c4),
                                hi = *(const f32x4*)((const float*)(ws + WS_HIN) + (size_t)(b * 128 + ck) * 256 + c4), ga = *(const f32x4*)(ZF + (size_t)row * 1536 + ZC_GA + c4), gn = *(const f32x4*)(LW.gna + c4);
                    f32x4 y; float ss = 0.f;
#pragma unroll
                    for (int e = 0; e < 4; ++e) { y[e] = (ac[e] * hi[e] + hl[e]) * gelu_tanh(ga[e]); ss += y[e] * y[e]; }
                    ss = wave_sum(ss); const float rs = frsq(ss * (1.f / 256.f) + EPS);
                    u32x2v w; w.x = pk2(y[0] * rs * gn[0], y[1] * rs * gn[1]); w.y = pk2(y[2] * rs * gn[2], y[3] * rs * gn[3]); *(u32x2v*)(Ybuf + (size_t)row * D + c4) = w; }
                { const float* yc = (const float*)(ws + WS_YC) + (size_t)row * 512 + 8 * F.lane; const f32x4 v0 = *(const f32x4*)yc, v1 = *(const f32x4*)(yc + 4), g0 = *(const f32x4*)(GNC + 8 * F.lane), g1 = *(const f32x4*)(GNC + 8 * F.lane + 4);
                    float ss = wave_sum(sq4(v0) + sq4(v1)); const float rs = frsq(ss * (1.f / 512.f) + EPS);
                    *(u32x4*)(Ybuf + (size_t)row * D + 512 + 8 * F.lane) = pack8(v0 * g0 * rs, v1 * g1 * rs); }
            }
        }
        SEAM(pb + 5);
#ifdef DBG
        if (l == 0 && IN(pb + 5)) { FRESH(F); WSL; OUTL; const LruW LW{AIN(I_CONVW) + l * 1024, AIN(I_CONVB) + l * 256, AIN(I_LWA) + (size_t)l * 16384, AIN(I_LBA) + l * 256, AIN(I_LWX) + (size_t)l * 16384, AIN(I_LBX) + l * 256, AIN(I_LAM) + l * 256, AIN(I_GNA) + l * 256};
            const float* LBP = AIN(I_HLB); const float* HNORM = AIN(I_HNORM) + l * 64; bf16_t* Ybuf = (bf16_t*)(ws + WS_Y); float* ZS = (float*)(ws + WS_ZS); (void)LW; (void)LBP; (void)HNORM; (void)Ybuf; (void)ZS;
            if (F.wg == F.G - 1) lru_seq<1>(F, LW, (const float*)(ws + WS_ZF) + (size_t)SEQ * 1536, 1536, 136, nullptr, nullptr, Ybuf + (size_t)SEQ * D, nullptr, nullptr, ctl, 6);
            if (F.wg == F.G - 2) hgrn_seq<1>(F, LBP, HNORM, l, 2, (const float*)(ws + WS_ZF) + (size_t)SEQ * 1536, 1536, 136, nullptr, Ybuf + (size_t)SEQ * D, nullptr, ctl, 7);
            if (F.wg == F.G - 3) { for (int i = 0; i < 6; ++i) { const unsigned hsh = (unsigned)(i * 8 + F.wave + 301) * 2654435761u; const int b = (hsh >> 3) & 1, h = (hsh >> 4) & 7; int pos = (hsh >> 8) % SEQ; if (i == 0) pos = (hsh >> 8) % 100; if (i == 1) pos = 128 + (hsh >> 8) % 1900;
                    const int part = F.lane & 3; float q[16], o[16];
                    const bf16_t* qp = (const bf16_t*)(ws + WS_QA) + ((size_t)(b * 8 + h) * SEQ + pos) * 64 + part * 16;
#pragma unroll
                    for (int e = 0; e < 16; ++e) q[e] = bf2f(qp[e]);
                    KVPrompt kv{(const bf16_t*)(ws + WS_KA) + (size_t)(b * 8 + h) * SEQ * 64, (const bf16_t*)(ws + WS_VA) + (size_t)(b * 8 + h) * SEQ * 64};
                    attn_naive(kv, q, pos, h, F.lane, o);
                    float dn = 0.f, dd = 0.f; if (F.lane < 4) { const float* yc = (const float*)(ws + WS_YC) + (size_t)(b * SEQ + pos) * 512 + h * 64 + part * 16;
#pragma unroll
                        for (int e = 0; e < 16; ++e) { dn += (yc[e] - o[e]) * (yc[e] - o[e]); dd += o[e] * o[e]; } }
                    dbg_acc(ctl, 8, dn, dd, F.lane); } }
        }
#endif
        if (IN(pb + 6)) { FRESH(F); WSL; OUTL; phase_resid(F, ws, (const bf16_t*)(ws + WS_Y), D, (const bf16_t*)(ws + WS_W) + (size_t)l * LW_SZ + LW_OUT, XP, XP, XS, XS, 1.0f); }
        SEAM(pb + 6);
        if (IN(pb + 7)) { FRESH(F); WSL; const bf16_t* LWb = (const bf16_t*)(ws + WS_W) + (size_t)l * LW_SZ;
            bf16_t* XB = (bf16_t*)(ws + WS_XB); bf16_t* QX = (bf16_t*)(ws + WS_QX);
            pg8::Gemm g{XB, LWb + LW_Q, D, D, D, 0, 0, 256 * D}; pg8::StaticOrder S; S.init(M, D, F.G, F.wg);
            EpiQx E{QX, (float*)(ws + WS_QSS), (const float*)(ws + WS_SSQ)};
            pg8::gemm_phase<EpiQx, pg8::StaticOrder, false, true>(F.lds, g, S, E, F.wave);
            int lane = F.lane; asm volatile("" : "+v"(lane));
            for (int s = F.G - 1 - F.wg; s < D / 16; s += F.G) { const int n0 = 16 * s; f32x4 ac, dum; slab_mma<1>(XB + (size_t)M * D, D, LWb + LW_Q + (size_t)n0 * D, LWb + LW_Q, D, D, F.wave, lane, ac, dum);
                const int row = 16 * F.wave + (lane & 15); const float rs = rstd64((const float*)(ws + WS_SSQS), row);
                u32x2v w; w.x = pk2(ac[0] * rs, ac[1] * rs); w.y = pk2(ac[2] * rs, ac[3] * rs); *(u32x2v*)(QX + (size_t)(M + row) * D + n0 + 4 * (lane >> 4)) = w; }
        }
        SEAM(pb + 7);
        if (IN(pb + 8)) { FRESH(F); WSL;
            pg8::Gemm g{(const bf16_t*)(ws + WS_QX), (const bf16_t*)(ws + WS_MEMK) + (size_t)l * 2 * 256 * 1024, D, D, 256, 256, 256 * 1024, 256}; pg8::StaticOrder S; S.init(M, D, F.G, F.wg);
            EpiS E{(bf16_t*)(ws + WS_PB), (float*)(ws + WS_LS), (const float*)(ws + WS_QSS), (const float*)(ws + WS_KMAX) + l * 64};
            pg8::gemm_phase<EpiS, pg8::StaticOrder, false, true>(F.lds, g, S, E, F.wave);
            FRESH(F2);
            for (int s = F.G - 1 - F.wg; s < 128; s += F.G) xattn_sample(F2, ws, AIN(I_CMK) + (size_t)l * 32 * 256 * 1024, AIN(I_CMV) + (size_t)l * 32 * 256 * 1024, s >> 2, s & 3);
        }
        SEAM(pb + 8);
        if (IN(pb + 9)) { FRESH(F); WSL;
            pg8::Gemm g{(const bf16_t*)(ws + WS_PB), (const bf16_t*)(ws + WS_MEMVT) + (size_t)l * 2 * 1024 * 256, D, 256, 256, 256, 1024 * 256, 256 * 256}; pg8::StaticOrder S; S.init(M, D, F.G, F.wg);
            EpiPV E{(bf16_t*)(ws + WS_OB), (const float*)(ws + WS_LS)};
            pg8::gemm_phase<EpiPV, pg8::StaticOrder, false, true>(F.lds, g, S, E, F.wave);
        }
        SEAM(pb + 9);
#ifdef DBG
        if (l == 0 && IN(pb + 9) && F.wg == F.G - 1) { FRESH(F); WSL; OUTL;
            for (int i = 0; i < 6; ++i) { const unsigned hsh = (unsigned)(i * 8 + F.wave + 501) * 2654435761u; int row = (hsh >> 4) % M; if (i == 5) row = M + (hsh >> 4) % MS; const int h = (hsh >> 19) & 3, d = (hsh >> 21) & 255;
                const bf16_t* qr = (const bf16_t*)(ws + WS_QX) + (size_t)row * D + h * 256; float sv[4], mx = -INFINITY;
                for (int e = 0; e < 4; ++e) { const int m = F.lane * 4 + e; float s = 0.f;
                    if (row < M) { const bf16_t* kr = (const bf16_t*)(ws + WS_MEMK) + ((size_t)(l * 2 + (row >> 13)) * 256 + m) * 1024 + h * 256; for (int k = 0; k < 256; ++k) s += bf2f(qr[k]) * bf2f(kr[k]); }
                    else { const float* kr = AIN(I_CMK) + (((size_t)(l * 32 + ((row - M) >> 2)) * 256 + m) * 4 + h) * 256; for (int k = 0; k < 256; ++k) s += bf2f(qr[k]) * kr[k]; }
                    sv[e] = s / 16.f; mx = fmaxf(mx, sv[e]); }
                mx = wave_max(mx); float ps = 0.f, o = 0.f;
                for (int e = 0; e < 4; ++e) { const int m = F.lane * 4 + e; const float p = fexp(sv[e] - mx); ps += p;
                    const float v = row < M ? bf2f(((const bf16_t*)(ws + WS_MEMVT))[((size_t)(l * 2 + (row >> 13)) * 1024 + h * 256 + d) * 256 + m]) : AIN(I_CMV)[(((size_t)(l * 32 + ((row - M) >> 2)) * 256 + m) * 4 + h) * 256 + d];
                    o += p * v; }
                ps = wave_sum(ps); o = wave_sum(o) / ps; const float got = bf2f(((const bf16_t*)(ws + WS_OB))[(size_t)row * D + h * 256 + d]);
                const int n = (hsh >> 9) & 1023; const float* xr = row < M ? XP + (size_t)row * D : XS + (size_t)(row - M) * D; const float* gn = AIN(I_NCROSS);
                const float ss = ndot([&](int k) { return xr[k]; }, xr, D, 1, F.lane); const float rs = frsq(ss / D + EPS);
                const float qref = ndot([&](int k) { return xr[k] * rs * gn[k]; }, AIN(I_XWQ) + n, D, D, F.lane), qgot = bf2f(((const bf16_t*)(ws + WS_QX))[(size_t)row * D + n]);
                if (F.lane == 0) { atomicAdd((float*)(ctl + CW_DBG + 0), (got - o) * (got - o)); atomicAdd((float*)(ctl + CW_DBG + 1), o * o);
                                   atomicAdd((float*)(ctl + CW_DBG + 2), (qgot - qref) * (qgot - qref)); atomicAdd((float*)(ctl + CW_DBG + 3), qref * qref); } }
        }
#endif
        if (IN(pb + 10)) { FRESH(F); WSL; OUTL; phase_resid(F, ws, (const bf16_t*)(ws + WS_OB), D, (const bf16_t*)(ws + WS_W) + (size_t)l * LW_SZ + LW_O, XP, XP, XS, XS, 1.0f); }
        SEAM(pb + 10);
        if (IN(pb + 11)) { FRESH(F); WSL; phase_ffn_up(F, ws, (const bf16_t*)(ws + WS_W) + (size_t)l * LW_SZ + LW_2U); }
        SEAM(pb + 11);
        if (IN(pb + 12)) { FRESH(F); WSL; OUTL; phase_resid(F, ws, (const bf16_t*)(ws + WS_ACT), FF, (const bf16_t*)(ws + WS_W) + (size_t)l * LW_SZ + LW_2D, XP, XP, XS, XS, 0.5f); }
        SEAM(pb + 12);
    }
    if (IN(PH_FIN)) { FRESH(F); WSL; OUTL;
        const float* NF = AIN(I_NFIN);
        for (int row = F.wg * NWAVES + F.wave; row < MT; row += F.G * NWAVES) {
            float* xr = row < M ? XP + (size_t)row * D : XS + (size_t)(row - M) * D; const float rs = row < M ? rstd16((const float*)(ws + WS_SSQ), row) : rstd64((const float*)(ws + WS_SSQS), row - M);
#pragma unroll
            for (int jj = 0; jj < 4; ++jj) { f32x4* p = (f32x4*)xr + F.lane + 64 * jj; const f32x4 g = *((const f32x4*)NF + F.lane + 64 * jj); *p = *p * g * rs; } }
    }
#ifdef DBG
    __syncthreads(); { XcdBarrier b_ = bar; asm volatile("" : "+s"(b_.bar), "+s"(b_.x)); xcd_barrier(b_); }
    { FRESH(Fd); dbg_finish(Fd, a, ctl); }
#endif
#undef IN
#undef SEAM
}

extern "C" void kernel_launch(void* const* d_in, const int* in_sizes, int n_in, void* d_out, int out_size, void* d_ws, size_t ws_size, hipStream_t stream) {
    static int grid = 0;
    if (grid == 0) {
        if (n_in != N_IN || (size_t)out_size != O_END || ws_size < WS_TOTAL) { fprintf(stderr, "kernel_launch: unexpected shapes: n_in %d out %d ws %zu (need %zu)\n", n_in, out_size, ws_size, (size_t)WS_TOTAL); grid = -1; return; }
        int dev = 0, cus = 0, per_cu = 0;
        if (hipGetDevice(&dev) != hipSuccess || hipDeviceGetAttribute(&cus, hipDeviceAttributeMultiprocessorCount, dev) != hipSuccess) { grid = -1; return; }
        if (hipFuncSetAttribute((const void*)fwd, hipFuncAttributeMaxDynamicSharedMemorySize, LDS_BYTES) != hipSuccess) { fprintf(stderr, "kernel_launch: hipFuncSetAttribute failed\n"); grid = -1; return; }
        if (hipOccupancyMaxActiveBlocksPerMultiprocessor(&per_cu, (const void*)fwd, NTHR, LDS_BYTES) != hipSuccess || per_cu < 1) { fprintf(stderr, "kernel_launch: occupancy query says %d\n", per_cu); }
        (void)hipGetLastError();
        grid = cus;
    }
    if (grid < 0) return;
    (void)in_sizes;
    if (hipMemsetAsync((char*)d_ws + WS_CTL, 0, CTL_BYTES, stream) != hipSuccess) return;
    Args a{};
    for (int i = 0; i < N_IN; ++i) a.in[i] = (const float*)d_in[i];
    a.out = (float*)d_out; a.ws = (unsigned char*)d_ws; a.ph_lo = 0; a.ph_hi = N_PHASES;
    hipLaunchKernelGGL(fwd, dim3(grid), dim3(NTHR), LDS_BYTES, stream, a);
}
```

```cpp
#include <hip/hip_runtime.h>
#include <cstdio>
#include <cstdint>
namespace pg8 {
#define PG8_LAS __attribute__((address_space(3)))
typedef unsigned short bf16_t;
typedef short bf16x8 __attribute__((ext_vector_type(8)));
typedef float f32x4 __attribute__((ext_vector_type(4)));
typedef unsigned u32x4 __attribute__((ext_vector_type(4)));
constexpr int BM = 256, BK = 64, HALF = 128, HTB = HALF * BK * 2  , STAGE_BYTES = 8 * HTB, NXCD = 8, WGM = 8;

__host__ __device__ __forceinline__ int lds_byte(int r, int c) { const int st = (r >> 4) * 2 + (c >> 5), rr = r & 15, cc = c & 31, ob = rr * 64 + cc * 2; return st * 1024 + (ob ^ (((ob >> 9) & 1) << 5)); }
__host__ __device__ __forceinline__ void stage_rc(int b, int& R, int& C) { const int st = b / 1024, sb = b % 1024, swz = sb ^ (((sb >> 9) & 1) << 5); R = (st >> 1) * 16 + swz / 64; C = (st & 1) * 32 + (swz % 64) / 2; }
__host__ __device__ __forceinline__ int perm32(int rho) { const int n = rho >> 4, i = rho & 15; return 8 * (i >> 2) + 4 * n + (i & 3); }

struct Unit { int pm, pn; };
struct Gemm { const bf16_t* A; const bf16_t* Bt; int lda, ldb, K; int acs; int bbs, bps;
    __device__ __forceinline__ const char* aptr(const Unit& u) const { return (const char*)(A + (size_t)u.pm * 256 * lda + (size_t)u.pn * acs); }
    __device__ __forceinline__ const char* bptr(const Unit& u) const { return (const char*)(Bt + (size_t)(u.pm >> 5) * bbs + (size_t)u.pn * bps); } };

struct StaticOrder {
    int nM, nN, nwg, G, c;
    __host__ __device__ void init(int M, int N, int G_, int c_) { nM = M / BM; nN = N / BM; nwg = nM * nN; G = G_; c = c_; }
    __host__ __device__ bool next(int i, Unit& u) const {
        const long L = (long)i * G + c; if (L >= nwg) return false;
        int wgid = (int)L; { const int q = nwg / NXCD, r = nwg % NXCD, xcd = wgid % NXCD, off = wgid / NXCD; wgid = (xcd < r ? xcd * (q + 1) : r * (q + 1) + (xcd - r) * q) + off; }
        const int nig = WGM * nN, gid = wgid / nig, fm = gid * WGM, gsz = (nM - fm) < WGM ? (nM - fm) : WGM;
        u.pm = fm + ((wgid % nig) % gsz); u.pn = (wgid % nig) / gsz; return true;
    }
    __device__ __forceinline__ void a_ready(const Unit&) const {}
    __device__ __forceinline__ void done(const Unit&) const {}
};

__device__ __forceinline__ unsigned cvt_pk_bf16(float lo, float hi) { unsigned r; asm volatile("v_cvt_pk_bf16_f32 %0, %1, %2" : "=v"(r) : "v"(lo), "v"(hi)); return r; }
typedef float f32x2 __attribute__((ext_vector_type(2)));
template <class Epi, class Sched, bool ALIGN_EPI = false, bool SP2 = false>
__device__ __forceinline__ void gemm_phase(PG8_LAS unsigned char* lds, const Gemm g, const Sched& S, const Epi& E, int wave_in  ) {
    int wv_ = wave_in; asm volatile("" : "+s"(wv_));
    int lane_ = (int)__builtin_amdgcn_mbcnt_hi(~0u, __builtin_amdgcn_mbcnt_lo(~0u, 0u)); asm volatile("" : "+v"(lane_)); const int lane = lane_;
    const int wid = wv_, tid = wid * 64 + lane, wr = wid >> 2, wc = wid & 3, fr = lane & 15, fq = lane >> 4;
    int K_ = g.K; asm volatile("" : "+s"(K_)); const int K = K_, nt = K / BK, lda = g.lda, ldb = g.ldb;
    unsigned voffA[2], voffB[2];
#pragma unroll
    for (int i = 0; i < 2; ++i) { int R, C; stage_rc(tid * 16 + i * 8192, R, C); const int Rb = Epi::PERM ? ((R & ~31) + perm32(R & 31)) : R;
        voffA[i] = (unsigned)(R * lda + C) * 2u; voffB[i] = (unsigned)(Rb * ldb + C) * 2u; }
    const size_t kstep = (size_t)(BK * 2);
    const size_t hstepA = (size_t)HALF * lda * 2, hstepB = (size_t)HALF * ldb * 2;
    const unsigned ldsw = (unsigned)wid * 1024u;
    const int aoff = lds_byte(wr * 64 + fr, fq * 8), boff = lds_byte(wc * 32 + fr, fq * 8);
#define PG8_SA(b, h) (((b) * 2 + (h)) * HTB)
#define PG8_SB(b, h) ((4 + (b) * 2 + (h)) * HTB)
#define PG8_STAGE(bufoff, gbase, voff) do { _Pragma("unroll") for (int _i = 0; _i < 2; ++_i) \
        __builtin_amdgcn_global_load_lds((const unsigned*)((const char*)(gbase) + (voff)[_i]), (PG8_LAS unsigned*)(lds + (bufoff) + ldsw + _i * 8192), 16, 0, 0); } while (0)
#define PG8_LDA(dst, b, h) do { _Pragma("unroll") for (int m = 0; m < 4; ++m) _Pragma("unroll") for (int k = 0; k < 2; ++k) dst[m][k] = *(const PG8_LAS bf16x8*)(lds + PG8_SA(b, h) + aoff + m * 2048 + k * 1024); } while (0)
#define PG8_LDB(dst, b, h) do { _Pragma("unroll") for (int n = 0; n < 2; ++n) _Pragma("unroll") for (int k = 0; k < 2; ++k) dst[n][k] = *(const PG8_LAS bf16x8*)(lds + PG8_SB(b, h) + boff + n * 2048 + k * 1024); } while (0)
#define PG8_MMA(ai, bj, At, Bt) do { __builtin_amdgcn_s_setprio(1); _Pragma("unroll") for (int m = 0; m < 4; ++m) _Pragma("unroll") for (int n = 0; n < 2; ++n) _Pragma("unroll") for (int k = 0; k < 2; ++k) \
        acc[ai][bj][m][n] = __builtin_amdgcn_mfma_f32_16x16x32_bf16(Bt[n][k], At[m][k], acc[ai][bj][m][n], 0, 0, 0); __builtin_amdgcn_s_setprio(0); } while (0)
#define PG8_WAIT_V(n) asm volatile("s_waitcnt vmcnt(" #n ")" ::: "memory")
#define PG8_WAIT_L(n) asm volatile("s_waitcnt lgkmcnt(" #n ")" ::: "memory")
#define PG8_BAR __builtin_amdgcn_s_barrier()
#define PG8_SCHED __builtin_amdgcn_sched_barrier(0)
    Unit cur, nxt; int ui = 0;
    if (!S.next(0, cur)) return;
    f32x4 acc[2][2][4][2];
#pragma unroll
    for (int a = 0; a < 2; ++a)
#pragma unroll
        for (int b = 0; b < 2; ++b)
#pragma unroll
            for (int m = 0; m < 4; ++m)
#pragma unroll
                for (int n = 0; n < 2; ++n) acc[a][b][m][n] = (f32x4){0.f, 0.f, 0.f, 0.f};
    bf16x8 At[4][2], B0[2][2], B1[2][2];
    const char* cA = g.aptr(cur); const char* cB = g.bptr(cur);
    S.a_ready(cur);
    if constexpr (SP2) {
        PG8_STAGE(PG8_SB(0, 0), cB, voffB); PG8_STAGE(PG8_SB(0, 1), cB + hstepB, voffB); PG8_STAGE(PG8_SA(0, 0), cA, voffA); PG8_STAGE(PG8_SA(0, 1), cA + hstepA, voffA);
        if (wr == 1) PG8_BAR;
        PG8_WAIT_V(2); PG8_BAR;
        PG8_STAGE(PG8_SB(1, 0), cB + kstep, voffB); PG8_STAGE(PG8_SA(1, 0), cA + kstep, voffA); PG8_STAGE(PG8_SB(1, 1), cB + hstepB + kstep, voffB);
        PG8_WAIT_V(6); PG8_BAR;
    } else {
        PG8_STAGE(PG8_SB(0, 0), cB, voffB); PG8_STAGE(PG8_SA(0, 0), cA, voffA); PG8_STAGE(PG8_SB(0, 1), cB + hstepB, voffB); PG8_STAGE(PG8_SA(0, 1), cA + hstepA, voffA);
        if (wr == 1) PG8_BAR;
        PG8_WAIT_V(4); PG8_BAR;
        PG8_STAGE(PG8_SB(1, 0), cB + kstep, voffB); PG8_STAGE(PG8_SA(1, 0), cA + kstep, voffA); PG8_STAGE(PG8_SB(1, 1), cB + hstepB + kstep, voffB);
        PG8_WAIT_V(6); PG8_BAR;
    }
    for (;;) {
        const bool has_next = S.next(ui + 1, nxt);
        const char* nA = has_next ? g.aptr(nxt) : cA; const char* nB = has_next ? g.bptr(nxt) : cB;
        for (int t = 0; t < nt; t += 2) {
            const bool last = (t == nt - 2);
            const char* a1 = cA + (size_t)(t + 1) * kstep;
            const char* a2 = last ? nA : cA + (size_t)(t + 2) * kstep; const char* b2 = last ? nB : cB + (size_t)(t + 2) * kstep;
            const char* a3 = a2 + kstep; const char* b3 = b2 + kstep;
            if (last && has_next) S.a_ready(nxt);
            if constexpr (SP2) {
            PG8_LDB(B0, 0, 0); PG8_LDB(B1, 0, 1); PG8_SCHED; PG8_LDA(At, 0, 0); PG8_STAGE(PG8_SA(1, 1), a1 + hstepA, voffA);
            PG8_WAIT_V(8); PG8_WAIT_L(0); PG8_BAR; PG8_MMA(0, 0, At, B0); PG8_MMA(0, 1, At, B1); PG8_BAR; PG8_SCHED;
            PG8_LDA(At, 0, 1); PG8_STAGE(PG8_SB(0, 0), b2, voffB); PG8_STAGE(PG8_SB(0, 1), b2 + hstepB, voffB); PG8_STAGE(PG8_SA(0, 0), a2, voffA);
            PG8_WAIT_V(8); PG8_WAIT_L(0); PG8_BAR; PG8_MMA(1, 0, At, B0); PG8_MMA(1, 1, At, B1); PG8_BAR; PG8_SCHED;
            PG8_LDB(B0, 1, 0); PG8_LDB(B1, 1, 1); PG8_SCHED; PG8_LDA(At, 1, 0); PG8_STAGE(PG8_SA(0, 1), a2 + hstepA, voffA);
            PG8_WAIT_V(8); PG8_WAIT_L(0); PG8_BAR; PG8_MMA(0, 0, At, B0); PG8_MMA(0, 1, At, B1); PG8_BAR; PG8_SCHED;
            PG8_LDA(At, 1, 1); PG8_STAGE(PG8_SB(1, 0), b3, voffB); PG8_STAGE(PG8_SB(1, 1), b3 + hstepB, voffB); PG8_STAGE(PG8_SA(1, 0), a3, voffA);
            PG8_WAIT_V(8); PG8_WAIT_L(0); PG8_BAR; PG8_MMA(1, 0, At, B0); PG8_MMA(1, 1, At, B1); PG8_BAR; PG8_SCHED;
            } else {
            PG8_LDB(B0, 0, 0); PG8_SCHED; PG8_LDA(At, 0, 0); PG8_STAGE(PG8_SA(1, 1), a1 + hstepA, voffA);
            PG8_WAIT_L(8); PG8_BAR; PG8_WAIT_L(0); PG8_MMA(0, 0, At, B0); PG8_BAR; PG8_SCHED;
            PG8_LDB(B1, 0, 1); PG8_STAGE(PG8_SB(0, 0), b2, voffB);
            PG8_BAR; PG8_WAIT_L(0); PG8_MMA(0, 1, At, B1); PG8_BAR;
            PG8_LDA(At, 0, 1); PG8_STAGE(PG8_SA(0, 0), a2, voffA);
            PG8_BAR; PG8_WAIT_L(0); PG8_MMA(1, 0, At, B0); PG8_BAR; PG8_SCHED;
            PG8_STAGE(PG8_SB(0, 1), b2 + hstepB, voffB);
            PG8_WAIT_V(6); PG8_BAR; PG8_MMA(1, 1, At, B1); PG8_BAR;
            PG8_LDB(B0, 1, 0); PG8_SCHED; PG8_LDA(At, 1, 0); PG8_STAGE(PG8_SA(0, 1), a2 + hstepA, voffA);
            PG8_WAIT_L(8); PG8_BAR; PG8_WAIT_L(0); PG8_MMA(0, 0, At, B0); PG8_BAR; PG8_SCHED;
            PG8_LDB(B1, 1, 1); PG8_STAGE(PG8_SB(1, 0), b3, voffB);
            PG8_BAR; PG8_WAIT_L(0); PG8_MMA(0, 1, At, B1); PG8_BAR;
            PG8_LDA(At, 1, 1); PG8_STAGE(PG8_SA(1, 0), a3, voffA);
            PG8_BAR; PG8_WAIT_L(0); PG8_MMA(1, 0, At, B0); PG8_BAR; PG8_SCHED;
            PG8_STAGE(PG8_SB(1, 1), b3 + hstepB, voffB);
            PG8_WAIT_V(6); PG8_BAR; PG8_MMA(1, 1, At, B1); PG8_BAR;
            }
        }
        if constexpr (ALIGN_EPI) { if (wr == 0) PG8_BAR; }
        if constexpr (!Epi::AFTER_DRAIN) { int l2 = (int)__builtin_amdgcn_mbcnt_hi(~0u, __builtin_amdgcn_mbcnt_lo(~0u, 0u)); asm volatile("" : "+v"(l2)); const int fr2 = l2 & 15, fq2 = l2 >> 4; E(acc, cur, wr, wc, fr2, fq2); S.done(cur); }
        if (!has_next) break;
#pragma unroll
        for (int a = 0; a < 2; ++a)
#pragma unroll
            for (int b = 0; b < 2; ++b)
#pragma unroll
                for (int m = 0; m < 4; ++m)
#pragma unroll
                    for (int n = 0; n < 2; ++n) acc[a][b][m][n] = (f32x4){0.f, 0.f, 0.f, 0.f};
        cur = nxt; cA = nA; cB = nB; ++ui;
        if constexpr (ALIGN_EPI) { if (wr == 1) PG8_BAR; }
    }
    PG8_WAIT_V(0);
    if constexpr (!ALIGN_EPI) { if (wr == 0) PG8_BAR; }
    PG8_BAR;
    if constexpr (Epi::AFTER_DRAIN) { E.fused(acc, cur, wr, wc, fr, fq, lds, wid, lane); S.done(cur); }
#undef PG8_SA
#undef PG8_SB
#undef PG8_STAGE
#undef PG8_LDA
#undef PG8_LDB
#undef PG8_MMA
#undef PG8_WAIT_V
#undef PG8_WAIT_L
#undef PG8_BAR
#undef PG8_SCHED
}
}
#define GAS __attribute__((address_space(1)))
#define LAS __attribute__((address_space(3)))
#define XB_TMO      128
#define XB_XCNT(j)  (256  + 64 * (j))
#define XB_XSUB(j)  (1280 + 64 * (j))
#define XB_XGEN(j)  (2304 + 64 * (j))
#define XB_TOP      3328
#define XB_TOPGEN   3392
#define XCD_BAR_WORDS 3456
#define XB_SPIN_CAP (1u << 18)

__device__ __forceinline__ unsigned xb_ld(unsigned* p)              { return __hip_atomic_load(p, __ATOMIC_RELAXED, __HIP_MEMORY_SCOPE_AGENT); }
__device__ __forceinline__ unsigned xb_add(unsigned* p, unsigned v) { return __hip_atomic_fetch_add(p, v, __ATOMIC_RELAXED, __HIP_MEMORY_SCOPE_AGENT); }
__device__ __forceinline__ unsigned xb_xcc_id() { return (unsigned)__builtin_amdgcn_s_getreg((3 << 11) | 20) & 0xFu; }
#define XB_SPIN(cond, bar) do { unsigned _sp = 0; while (cond) { __builtin_amdgcn_s_sleep(1); \
    if ((++_sp & 255u) == 0u) { if (xb_ld(&(bar)[XB_TMO])) break; if (_sp > XB_SPIN_CAP) { atomicAdd(&(bar)[XB_TMO], 1u); break; } } } } while (0)

struct XcdBarrier {
    unsigned* bar; unsigned x;
    volatile LAS unsigned* st;
};

__device__ __forceinline__ XcdBarrier xcd_barrier_post(unsigned* bar, volatile LAS unsigned* st) {
    XcdBarrier b; b.bar = bar; b.x = xb_xcc_id(); b.st = st;
    if (threadIdx.x == 0) (void)xb_add(&bar[XB_XCNT(b.x)], 1u);
    return b;
}
__device__ __forceinline__ void xcd_barrier_complete(unsigned* bar, unsigned x, unsigned& nloc, unsigned& nx) {
    const unsigned G = gridDim.x * gridDim.y * gridDim.z;
    unsigned sum, cnt, mine, sp = 0u;
    for (;;) {
        sum = 0u; cnt = 0u; mine = 0u;
#pragma unroll
        for (unsigned j = 0; j < 16; ++j) { const unsigned c = xb_ld(&bar[XB_XCNT(j)]); sum += c; cnt += (c > 0u) ? 1u : 0u; mine = (j == x) ? c : mine; }
        if (sum == G) break;
        __builtin_amdgcn_s_sleep(1);
        if ((++sp & 255u) == 0u) { if (xb_ld(&bar[XB_TMO])) break; if (sp > XB_SPIN_CAP) { atomicAdd(&bar[XB_TMO], 1u); break; } }
    }
    nloc = mine > 0u ? mine : 1u; nx = cnt > 0u ? cnt : 1u;
}

__device__ __forceinline__ void xcd_barrier(const XcdBarrier& b) {
    asm volatile("s_waitcnt vmcnt(0)" ::: "memory");
    __syncthreads();
    if (threadIdx.x == 0) {
        unsigned* bar = b.bar;
        __builtin_amdgcn_s_waitcnt(0);
        unsigned nloc = b.st[0], nx = b.st[1];
        if (nloc == 0u) { xcd_barrier_complete(bar, b.x, nloc, nx); b.st[0] = nloc; b.st[1] = nx; }
        const unsigned old = xb_add(&bar[XB_XSUB(b.x)], 1u);
        const unsigned gen = old / nloc;
        if (old + 1u == (gen + 1u) * nloc) {
            __builtin_amdgcn_fence(__ATOMIC_RELEASE, "agent");
            asm volatile("s_waitcnt vmcnt(0)" ::: "memory");
            const unsigned og = xb_add(&bar[XB_TOP], 1u);
            const unsigned tg = og / nx;
            if (og + 1u == (tg + 1u) * nx) xb_add(&bar[XB_TOPGEN], 1u);
            else XB_SPIN(xb_ld(&bar[XB_TOPGEN]) == tg, bar);
            __builtin_amdgcn_fence(__ATOMIC_ACQUIRE, "agent");
            xb_add(&bar[XB_XGEN(b.x)], 1u);
            asm volatile("s_waitcnt vmcnt(0)" ::: "memory");
        } else {
            XB_SPIN(xb_ld(&bar[XB_XGEN(b.x)]) == gen, bar);
            __builtin_amdgcn_fence(__ATOMIC_ACQUIRE, "agent");
            asm volatile("s_waitcnt vmcnt(0)" ::: "memory");
        }
    }
    __syncthreads();
}

using pg8::bf16_t; using pg8::f32x4; using pg8::u32x4; using pg8::bf16x8; using pg8::Unit;
typedef GAS unsigned gu32;
typedef float f32x2v __attribute__((ext_vector_type(2)));
typedef unsigned u32x2v __attribute__((ext_vector_type(2)));
constexpr int NB = 2, SEQ = 8192, D = 1024, M = NB * SEQ, NL = 4;
constexpr int SBATCH = 32, STOK = 4, MS = SBATCH * STOK, MT = M + MS;
constexpr int FF = 2816, DIN = 3072, WINDOW = 2048;
constexpr float EPS = 1e-6f, LOG2E = 1.4426950408889634f;
constexpr int NWAVES = 8, NTHR = 512;

constexpr size_t O_YP = 0, O_YS = O_YP + (size_t)M * D, O_PLH = O_YS + (size_t)MS * D, O_PLC = O_PLH + NL * NB * 256, O_PHG = O_PLC + NL * NB * 3 * 256,
    O_PSK = O_PHG + (size_t)NL * NB * 4 * 4096, O_PSV = O_PSK + (size_t)NL * NB * 2048 * 512, O_PMK = O_PSV + (size_t)NL * NB * 2048 * 512,
    O_PMV = O_PMK + (size_t)NL * NB * 256 * 1024, O_SLH = O_PMV + (size_t)NL * NB * 256 * 1024, O_SLC = O_SLH + NL * 32 * 256, O_SHG = O_SLC + NL * 32 * 3 * 256,
    O_SSK = O_SHG + (size_t)NL * 32 * 4 * 4096, O_SSV = O_SSK + (size_t)NL * 32 * 2048 * 512, O_END = O_SSV + (size_t)NL * 32 * 2048 * 512;
static_assert(O_END == 308682752ull, "output size");

enum { I_XP = 0, I_XS, I_SLH, I_SLC, I_SHG, I_CSK, I_CSV, I_CMK, I_CMV, I_MEMP, I_NF1, I_F1G, I_F1U, I_F1D, I_NMIX, I_WIN, I_CONVW, I_CONVB, I_LWA, I_LBA, I_LWX, I_LBX,
       I_LAM, I_HLB, I_HNORM, I_GNA, I_GNC, I_WOUT, I_NCROSS, I_XWQ, I_XWK, I_XWV, I_XWO, I_NF2, I_F2G, I_F2U, I_F2D, I_NFIN, N_IN };
static_assert(N_IN == 38, "inputs");

constexpr size_t al4k(size_t x) { return (x + 4095) & ~(size_t)4095; }
constexpr size_t SZ_UP = (size_t)2 * FF * D, SZ_DN = (size_t)D * FF, SZ_IN = (size_t)DIN * D, SZ_SQ = (size_t)D * D;
constexpr size_t LW_1U = 0, LW_1D = LW_1U + SZ_UP, LW_IN = LW_1D + SZ_DN, LW_OUT = LW_IN + SZ_IN, LW_Q = LW_OUT + SZ_SQ, LW_O = LW_Q + SZ_SQ, LW_2U = LW_O + SZ_SQ,
    LW_2D = LW_2U + SZ_UP, LW_SZ = LW_2D + SZ_DN;
constexpr size_t WS_CTL = 0, CTL_BYTES = 1u << 20;
constexpr size_t WS_W = CTL_BYTES;
constexpr size_t WS_WKV = al4k(WS_W + NL * LW_SZ * 2);
constexpr size_t WS_XB = al4k(WS_WKV + 8 * SZ_SQ * 2);
constexpr size_t WS_SSQ = al4k(WS_XB + (size_t)MT * D * 2);
constexpr size_t WS_SSQS = al4k(WS_SSQ + (size_t)M * 16 * 4);
constexpr size_t WS_ACT = al4k(WS_SSQS + (size_t)MS * 64 * 4);
constexpr size_t WS_ZF = al4k(WS_ACT + (size_t)MT * FF * 2);
constexpr size_t WS_ZS = al4k(WS_ZF + (size_t)M * 1536 * 4);
constexpr size_t WS_QA = al4k(WS_ZS + (size_t)MS * 3072 * 4);
constexpr size_t WS_KA = al4k(WS_QA + (size_t)M * 512 * 2);
constexpr size_t WS_VA = al4k(WS_KA + (size_t)M * 512 * 2);
constexpr size_t WS_ACUM = al4k(WS_VA + (size_t)M * 512 * 2);
constexpr size_t WS_HLOC = al4k(WS_ACUM + (size_t)M * 256 * 4);
constexpr size_t WS_CA = al4k(WS_HLOC + (size_t)M * 256 * 4);
constexpr size_t WS_CH = al4k(WS_CA + 2 * 128 * 256 * 4);
constexpr size_t WS_HIN = al4k(WS_CH + 2 * 128 * 256 * 4);
constexpr size_t WS_HKV = al4k(WS_HIN + 2 * 128 * 256 * 4);
constexpr size_t WS_HDEC = al4k(WS_HKV + (size_t)1024 * 4096 * 4);
constexpr size_t WS_HSP = al4k(WS_HDEC + 1024 * 64 * 4);
constexpr size_t WS_YC = al4k(WS_HSP + (size_t)1024 * 4096 * 4);
constexpr size_t WS_Y = al4k(WS_YC + (size_t)MT * 512 * 4);
constexpr size_t WS_QX = al4k(WS_Y + (size_t)MT * D * 2);
constexpr size_t WS_QSS = al4k(WS_QX + (size_t)MT * D * 2);
constexpr size_t WS_PB = al4k(WS_QSS + (size_t)M * 16 * 4);
constexpr size_t WS_LS = al4k(WS_PB + (size_t)M * D * 2);
constexpr size_t WS_OB = al4k(WS_LS + (size_t)M * 16 * 4);
constexpr size_t WS_MEMB = al4k(WS_OB + (size_t)MT * D * 2);
constexpr size_t WS_MEMK = al4k(WS_MEMB + 512 * D * 2);
constexpr size_t WS_MEMVT = al4k(WS_MEMK + (size_t)NL * 2 * 256 * 1024 * 2);
constexpr size_t WS_KMAX = al4k(WS_MEMVT + (size_t)NL * 2 * 256 * 1024 * 2);
constexpr size_t WS_LRUW = al4k(WS_KMAX + NL * 2 * 4 * 8 * 4);
constexpr size_t WS_QXS = al4k(WS_LRUW + (size_t)NL * 2 * 4 * 4096 * 2);
constexpr size_t WS_XL = al4k(WS_QXS + (size_t)MS * D * 4);
constexpr size_t WS_END = al4k(WS_XL + (size_t)M * D * 2);
constexpr size_t WS_SHADOW = WS_END, WS_TOTAL = WS_SHADOW + O_SSK * 4;
constexpr size_t QKV_STRIDE = (WS_KA - WS_QA) / 2, PSKV_STRIDE = O_PSV - O_PSK;
static_assert(WS_VA - WS_KA == WS_KA - WS_QA, "q k v equally spaced");
constexpr int CW_CPQ = 12288;
constexpr int CW_XQ = 16384;
constexpr int CW_BAR = 4096;

constexpr int RING_BYTES = 131072, LDSCTL_OFF = RING_BYTES, LDS_BYTES = 147456;


template <int CTRL> __device__ __forceinline__ float dpp_(float v) { return __builtin_bit_cast(float, __builtin_amdgcn_update_dpp(0, __builtin_bit_cast(int, v), CTRL, 0xF, 0xF, true)); }
__device__ __forceinline__ float x1_(float v) { return dpp_<0xB1>(v); }
__device__ __forceinline__ float x2_(float v) { return dpp_<0x4E>(v); }
__device__ __forceinline__ float sw4_(float v) { return __builtin_bit_cast(float, __builtin_amdgcn_ds_swizzle(__builtin_bit_cast(int, v), 0x101F)); }
__device__ __forceinline__ float sw8_(float v) { return __builtin_bit_cast(float, __builtin_amdgcn_ds_swizzle(__builtin_bit_cast(int, v), 0x201F)); }
__device__ __forceinline__ float sum_g(float v) {
    { const unsigned u = __builtin_bit_cast(unsigned, v); const auto r = __builtin_amdgcn_permlane16_swap(u, u, false, false); v = __builtin_bit_cast(float, (unsigned)r[0]) + __builtin_bit_cast(float, (unsigned)r[1]); }
    { const unsigned u = __builtin_bit_cast(unsigned, v); const auto r = __builtin_amdgcn_permlane32_swap(u, u, false, false); v = __builtin_bit_cast(float, (unsigned)r[0]) + __builtin_bit_cast(float, (unsigned)r[1]); }
    return v; }
__device__ __forceinline__ float max_g(float v) {
    { const unsigned u = __builtin_bit_cast(unsigned, v); const auto r = __builtin_amdgcn_permlane16_swap(u, u, false, false); v = fmaxf(__builtin_bit_cast(float, (unsigned)r[0]), __builtin_bit_cast(float, (unsigned)r[1])); }
    { const unsigned u = __builtin_bit_cast(unsigned, v); const auto r = __builtin_amdgcn_permlane32_swap(u, u, false, false); v = fmaxf(__builtin_bit_cast(float, (unsigned)r[0]), __builtin_bit_cast(float, (unsigned)r[1])); }
    return v; }
__device__ __forceinline__ float row_sum(float v) { v += x1_(v); v += x2_(v); v += dpp_<0x141>(v); v += dpp_<0x140>(v); return v; }
__device__ __forceinline__ float row_max(float v) { v = fmaxf(v, x1_(v)); v = fmaxf(v, x2_(v)); v = fmaxf(v, dpp_<0x141>(v)); v = fmaxf(v, dpp_<0x140>(v)); return v; }
__device__ __forceinline__ float bperm_(float v, int src_lane) { return __builtin_bit_cast(float, __builtin_amdgcn_ds_bpermute(src_lane << 2, __builtin_bit_cast(int, v))); }
__device__ __forceinline__ float wave_sum(float v) { return sum_g(row_sum(v)); }
__device__ __forceinline__ float wave_max(float v) { return max_g(row_max(v)); }
__device__ __forceinline__ unsigned f2bf(float f) { unsigned u = __builtin_bit_cast(unsigned, f); return (u + 0x7fffu + ((u >> 16) & 1u)) >> 16; }
typedef float f32x2_t __attribute__((ext_vector_type(2))); typedef __bf16 bf16x2_t __attribute__((ext_vector_type(2)));
__device__ __forceinline__ unsigned pk2(float lo, float hi) { f32x2_t v = {lo, hi}; bf16x2_t b = __builtin_convertvector(v, bf16x2_t); return __builtin_bit_cast(unsigned, b); }
__device__ __forceinline__ float bf2f(unsigned short h) { return __builtin_bit_cast(float, (unsigned)h << 16); }
__device__ __forceinline__ u32x4 pack8(f32x4 a, f32x4 b) { u32x4 w; w.x = pk2(a[0], a[1]); w.y = pk2(a[2], a[3]); w.z = pk2(b[0], b[1]); w.w = pk2(b[2], b[3]); return w; }
__device__ __forceinline__ float fast_exp2(float x) { return __builtin_amdgcn_exp2f(x); }
__device__ __forceinline__ float fast_rcp(float x) { return __builtin_amdgcn_rcpf(x); }
__device__ __forceinline__ float fexp(float x) { return __builtin_amdgcn_exp2f(x * LOG2E); }
__device__ __forceinline__ float flog2(float x) { return __builtin_amdgcn_logf(x); }
__device__ __forceinline__ float fsqrt(float x) { return __builtin_amdgcn_sqrtf(x); }
__device__ __forceinline__ float frsq(float x) { return __builtin_amdgcn_rsqf(x); }
__device__ __forceinline__ float sigmoidf_(float x) { return fast_rcp(1.f + fast_exp2(-x * LOG2E)); }
__device__ __forceinline__ float siluf_(float x) { return x * sigmoidf_(x); }
__device__ __forceinline__ float gelu_tanh(float x) {
    const float u = 0.7978845608028654f * (x + 0.044715f * x * x * x);
    return x * sigmoidf_(2.f * u);
}
__device__ __forceinline__ f32x4 ldbf4(const bf16_t* p) { const u32x2v w = *(const u32x2v*)p; f32x4 r; r[0] = __builtin_bit_cast(float, w.x << 16); r[1] = __builtin_bit_cast(float, w.x & 0xffff0000u); r[2] = __builtin_bit_cast(float, w.y << 16); r[3] = __builtin_bit_cast(float, w.y & 0xffff0000u); return r; }
__device__ __forceinline__ float sum4(f32x4 a) { return (a[0] + a[1]) + (a[2] + a[3]); }
__device__ __forceinline__ float sq4(f32x4 a) { return (a[0] * a[0] + a[1] * a[1]) + (a[2] * a[2] + a[3] * a[3]); }
__device__ __forceinline__ float rstd16(const float* ssq, int row) {
    const f32x4* p = (const f32x4*)(ssq + (size_t)row * 16);
    const f32x4 a = p[0], b = p[1], c = p[2], d = p[3];
    const float s = (sum4(a) + sum4(b)) + (sum4(c) + sum4(d));
    return frsq(s * (1.0f / D) + EPS);
}
__device__ __forceinline__ void rstd16x4(const float* ssq, int row0  , float (&rs)[4]) {
    f32x4 t[4][4];
#pragma unroll
    for (int m = 0; m < 4; ++m)
#pragma unroll
        for (int i = 0; i < 4; ++i) t[m][i] = *((const f32x4*)(ssq + (size_t)(row0 + 16 * m) * 16) + i);
#pragma unroll
    for (int m = 0; m < 4; ++m) rs[m] = frsq(((sum4(t[m][0]) + sum4(t[m][1])) + (sum4(t[m][2]) + sum4(t[m][3]))) * (1.0f / D) + EPS);
}
__device__ __forceinline__ float rstd64(const float* ssq, int row) {
    const f32x4* p = (const f32x4*)(ssq + (size_t)row * 64);
    float s = 0.f;
#pragma unroll
    for (int i = 0; i < 16; ++i) s += sum4(p[i]);
    return frsq(s * (1.0f / D) + EPS);
}

#define EPI_FOR_ROWS _Pragma("unroll") for (int ai = 0; ai < 2; ++ai) _Pragma("unroll") for (int m = 0; m < 4; ++m)
#define EPI_FENCE asm volatile("" ::: "memory")

struct EpiUp {
    static constexpr bool PERM = true, AFTER_DRAIN = false;
    bf16_t* act; const float* ssq;
    __device__ __forceinline__ void operator()(const f32x4 (&acc)[2][2][4][2], const Unit& u, int wr, int wc, int fr, int fq) const {
        const int col0 = u.pn * 128 + wc * 32 + 8 * fq;
#pragma unroll
        for (int ai = 0; ai < 2; ++ai) { EPI_FENCE; float rs4[4]; rstd16x4(ssq, u.pm * 256 + ai * 128 + wr * 64 + fr, rs4);
#pragma unroll
          for (int m = 0; m < 4; ++m) { const int row = u.pm * 256 + ai * 128 + wr * 64 + m * 16 + fr; const float rs = rs4[m];
            f32x4 o[2];
#pragma unroll
            for (int n = 0; n < 2; ++n) { const f32x4 g = acc[ai][0][m][n] * rs, up = acc[ai][1][m][n] * rs;
#pragma unroll
                for (int e = 0; e < 4; ++e) o[n][e] = siluf_(g[e]) * up[e]; }
            *(u32x4*)(act + (size_t)row * FF + col0) = pack8(o[0], o[1]); } }
    }
};
constexpr bool RESID_PAIR = false;
struct EpiResid {
    static constexpr bool PERM = true, AFTER_DRAIN = false;
    const float* xin; bf16_t* xb; bf16_t* xl; float* ssq; float alpha;
    __device__ __forceinline__ void operator()(const f32x4 (&acc)[2][2][4][2], const Unit& u, int wr, int wc, int fr, int fq) const {
#pragma unroll
        for (int ai = 0; ai < 2; ++ai) { EPI_FENCE;
            f32x4 xv[4][2][2];
            if (xin) {
#pragma unroll
                for (int m = 0; m < 4; ++m)
#pragma unroll
                    for (int bj = 0; bj < 2; ++bj) { const size_t off = (size_t)(u.pm * 256 + ai * 128 + wr * 64 + m * 16 + fr) * D + u.pn * 256 + bj * 128 + wc * 32 + 8 * fq;
                        xv[m][bj][0] = *(const f32x4*)(xin + off); xv[m][bj][1] = *(const f32x4*)(xin + off + 4); }
            } else if constexpr (RESID_PAIR) { u32x4 hv[4][2], lv[4][2];
#pragma unroll
                for (int m = 0; m < 4; ++m)
#pragma unroll
                    for (int bj = 0; bj < 2; ++bj) { const size_t off = (size_t)(u.pm * 256 + ai * 128 + wr * 64 + m * 16 + fr) * D + u.pn * 256 + bj * 128 + wc * 32 + 8 * fq;
                        hv[m][bj] = *(const u32x4*)(xb + off); lv[m][bj] = *(const u32x4*)(xl + off); }
#pragma unroll
                for (int m = 0; m < 4; ++m)
#pragma unroll
                    for (int bj = 0; bj < 2; ++bj)
#pragma unroll
                        for (int e = 0; e < 4; ++e) { const unsigned hw = hv[m][bj][e], lw = lv[m][bj][e];
                            const float x0 = __builtin_bit_cast(float, hw << 16) + __builtin_bit_cast(float, lw << 16), x1 = __builtin_bit_cast(float, hw & 0xffff0000u) + __builtin_bit_cast(float, lw & 0xffff0000u);
                            xv[m][bj][e >> 1][(e & 1) * 2] = x0; xv[m][bj][e >> 1][(e & 1) * 2 + 1] = x1; }
            } else { u32x4 hv[4][2];
#pragma unroll
                for (int m = 0; m < 4; ++m)
#pragma unroll
                    for (int bj = 0; bj < 2; ++bj) hv[m][bj] = *(const u32x4*)(xb + (size_t)(u.pm * 256 + ai * 128 + wr * 64 + m * 16 + fr) * D + u.pn * 256 + bj * 128 + wc * 32 + 8 * fq);
#pragma unroll
                for (int m = 0; m < 4; ++m)
#pragma unroll
                    for (int bj = 0; bj < 2; ++bj)
#pragma unroll
                        for (int e = 0; e < 4; ++e) { const unsigned hw = hv[m][bj][e]; xv[m][bj][e >> 1][(e & 1) * 2] = __builtin_bit_cast(float, hw << 16); xv[m][bj][e >> 1][(e & 1) * 2 + 1] = __builtin_bit_cast(float, hw & 0xffff0000u); } }
#pragma unroll
            for (int m = 0; m < 4; ++m) { const int row = u.pm * 256 + ai * 128 + wr * 64 + m * 16 + fr; float s = 0.f;
#pragma unroll
                for (int bj = 0; bj < 2; ++bj) { const size_t off = (size_t)row * D + u.pn * 256 + bj * 128 + wc * 32 + 8 * fq;
                    const f32x4 v0 = xv[m][bj][0] + acc[ai][bj][m][0] * alpha, v1 = xv[m][bj][1] + acc[ai][bj][m][1] * alpha;
                    const u32x4 hw = pack8(v0, v1); f32x4 r0, r1;
                    r0[0] = v0[0] - __builtin_bit_cast(float, hw.x << 16); r0[1] = v0[1] - __builtin_bit_cast(float, hw.x & 0xffff0000u); r0[2] = v0[2] - __builtin_bit_cast(float, hw.y << 16); r0[3] = v0[3] - __builtin_bit_cast(float, hw.y & 0xffff0000u);
                    r1[0] = v1[0] - __builtin_bit_cast(float, hw.z << 16); r1[1] = v1[1] - __builtin_bit_cast(float, hw.z & 0xffff0000u); r1[2] = v1[2] - __builtin_bit_cast(float, hw.w << 16); r1[3] = v1[3] - __builtin_bit_cast(float, hw.w & 0xffff0000u);
                    *(u32x4*)(xb + off) = hw; if (RESID_PAIR) *(u32x4*)(xl + off) = pack8(r0, r1);
                    s += sq4(v0) + sq4(v1); }
                s = sum_g(s);
                if (fq == 0) ssq[(size_t)row * 16 + u.pn * 4 + wc] = s; } }
    }
};
struct EpiZ {
    static constexpr bool PERM = true, AFTER_DRAIN = false;
    bf16_t* zf; bf16_t* qa; float* psk; const float* ssq;
    __device__ __forceinline__ void operator()(const f32x4 (&acc)[2][2][4][2], const Unit& u, int wr, int wc, int fr, int fq) const {
#pragma unroll
        for (int ai = 0; ai < 2; ++ai) { EPI_FENCE; float rs4[4]; rstd16x4(ssq, u.pm * 256 + ai * 128 + wr * 64 + fr, rs4);
#pragma unroll
          for (int m = 0; m < 4; ++m) { const int row = u.pm * 256 + ai * 128 + wr * 64 + m * 16 + fr; const float rs = rs4[m];
#pragma unroll
            for (int bj = 0; bj < 2; ++bj) { const int cc = bj * 128 + wc * 32 + 8 * fq;
                const f32x4 v0 = acc[ai][bj][m][0] * rs, v1 = acc[ai][bj][m][1] * rs;
                if (u.pn < 6) { *(u32x4*)(zf + (size_t)row * 1536 + u.pn * 256 + cc) = pack8(v0, v1); }
                else { const int g = (u.pn - 6) >> 1, c512 = ((u.pn - 6) & 1) * 256 + cc, h = c512 >> 6, d = c512 & 63, b = row >> 13, t = row & 8191;
                    bf16_t* dst = qa + (size_t)g * QKV_STRIDE + ((size_t)(b * 8 + h) * SEQ + t) * 64 + d;
                    *(u32x4*)dst = pack8(v0, v1);
                    if (g >= 1 && t >= SEQ - WINDOW) { float* o = psk + (size_t)(g - 1) * PSKV_STRIDE + ((size_t)(b * WINDOW + (t - (SEQ - WINDOW))) * 8 + h) * 64 + d; *(f32x4*)o = v0; *(f32x4*)(o + 4) = v1; } } } } }
    }
};
struct EpiQx {
    static constexpr bool PERM = true, AFTER_DRAIN = false;
    bf16_t* qx; float* qss; const float* ssq;
    __device__ __forceinline__ void operator()(const f32x4 (&acc)[2][2][4][2], const Unit& u, int wr, int wc, int fr, int fq) const {
#pragma unroll
        for (int ai = 0; ai < 2; ++ai) { EPI_FENCE; float rs4[4]; rstd16x4(ssq, u.pm * 256 + ai * 128 + wr * 64 + fr, rs4);
#pragma unroll
          for (int m = 0; m < 4; ++m) { const int row = u.pm * 256 + ai * 128 + wr * 64 + m * 16 + fr; const float rs = rs4[m]; float s = 0.f;
#pragma unroll
            for (int bj = 0; bj < 2; ++bj) { const size_t off = (size_t)row * D + u.pn * 256 + bj * 128 + wc * 32 + 8 * fq;
                const f32x4 v0 = acc[ai][bj][m][0] * rs, v1 = acc[ai][bj][m][1] * rs;
                const u32x4 w = pack8(v0, v1); *(u32x4*)(qx + off) = w;
                s += sq4(v0) + sq4(v1); }
            s = sum_g(s);
            if (fq == 0) qss[(size_t)row * 16 + u.pn * 4 + wc] = s; } }
    }
};
struct EpiS {
    static constexpr bool PERM = true, AFTER_DRAIN = false;
    bf16_t* pb; float* ls; const float* qss; const float* kmaxp;
    __device__ __forceinline__ void operator()(const f32x4 (&acc)[2][2][4][2], const Unit& u, int wr, int wc, int fr, int fq) const {
        const int b = u.pm >> 5, h = u.pn; const float* kp = kmaxp + (b * 4 + h) * 8;
        float k2 = 0.f;
#pragma unroll
        for (int c = 0; c < 4; ++c) k2 += fmaxf(kp[c], kp[4 + c]);
        const float sc = LOG2E * (1.0f / 16.0f);
        EPI_FOR_ROWS { EPI_FENCE; const int row = u.pm * 256 + ai * 128 + wr * 64 + m * 16 + fr;
            const f32x4 q4 = *(const f32x4*)(qss + (size_t)row * 16 + h * 4); const float bound = fsqrt(sum4(q4) * k2) * sc; float s = 0.f;
#pragma unroll
            for (int bj = 0; bj < 2; ++bj) { const size_t off = (size_t)row * D + h * 256 + bj * 128 + wc * 32 + 8 * fq; f32x4 p0, p1;
#pragma unroll
                for (int e = 0; e < 4; ++e) { p0[e] = fast_exp2(acc[ai][bj][m][0][e] * sc - bound); p1[e] = fast_exp2(acc[ai][bj][m][1][e] * sc - bound); }
                const u32x4 w = pack8(p0, p1); *(u32x4*)(pb + off) = w;
                s += (bf2f(w.x & 0xffff) + bf2f(w.x >> 16)) + (bf2f(w.y & 0xffff) + bf2f(w.y >> 16)) + (bf2f(w.z & 0xffff) + bf2f(w.z >> 16)) + (bf2f(w.w & 0xffff) + bf2f(w.w >> 16)); }
            s = sum_g(s);
            if (fq == 0) ls[(size_t)row * 16 + h * 4 + wc] = s; }
    }
};
struct EpiPV {
    static constexpr bool PERM = true, AFTER_DRAIN = false;
    bf16_t* ob; const float* ls;
    __device__ __forceinline__ void operator()(const f32x4 (&acc)[2][2][4][2], const Unit& u, int wr, int wc, int fr, int fq) const {
        EPI_FOR_ROWS { EPI_FENCE; const int row = u.pm * 256 + ai * 128 + wr * 64 + m * 16 + fr;
            const f32x4 l4 = *(const f32x4*)(ls + (size_t)row * 16 + u.pn * 4); const float inv = 1.0f / sum4(l4);
#pragma unroll
            for (int bj = 0; bj < 2; ++bj) { const size_t off = (size_t)row * D + u.pn * 256 + bj * 128 + wc * 32 + 8 * fq;
                *(u32x4*)(ob + off) = pack8(acc[ai][bj][m][0] * inv, acc[ai][bj][m][1] * inv); } }
    }
};
struct EpiMem {
    static constexpr bool PERM = true, AFTER_DRAIN = false;
    float* out_k; float* out_v; bf16_t* memk; bf16_t* memvt; float* kmaxp;
    __device__ __forceinline__ void operator()(const f32x4 (&acc)[2][2][4][2], const Unit& u, int wr, int wc, int fr, int fq) const {
        const int l = u.pn >> 3, kv = (u.pn >> 2) & 1, h = u.pn & 3, b = u.pm; float rmax = 0.f;
        EPI_FOR_ROWS { EPI_FENCE; const int mrow = ai * 128 + wr * 64 + m * 16 + fr; float s = 0.f;
#pragma unroll
            for (int bj = 0; bj < 2; ++bj) { const int c = h * 256 + bj * 128 + wc * 32 + 8 * fq; const f32x4 v0 = acc[ai][bj][m][0], v1 = acc[ai][bj][m][1];
                float* o = (kv ? out_v : out_k) + ((size_t)((l * 2 + b) * 256 + mrow)) * 1024 + c; *(f32x4*)o = v0; *(f32x4*)(o + 4) = v1;
                if (kv == 0) { *(u32x4*)(memk + ((size_t)((l * 2 + b) * 256 + mrow)) * 1024 + c) = pack8(v0, v1); s += sq4(v0) + sq4(v1); }
                else { bf16_t* t = memvt + ((size_t)(l * 2 + b) * 1024 + c) * 256 + mrow;
#pragma unroll
                    for (int e = 0; e < 4; ++e) { t[(size_t)e * 256] = (bf16_t)f2bf(v0[e]); t[(size_t)(4 + e) * 256] = (bf16_t)f2bf(v1[e]); } } }
            s = sum_g(s); rmax = fmaxf(rmax, s); }
        if (kv == 0) {
            rmax = row_max(rmax);
            if ((threadIdx.x & 63) == 0) kmaxp[((l * 2 + b) * 4 + h) * 8 + wr * 4 + wc] = rmax; }
    }
};

struct Args { const float* in[N_IN]; float* out; unsigned char* ws; int ph_lo, ph_hi; };
struct Frame {
    LAS unsigned char* lds; int tid, lane, wave, G, wg;
};

struct TrItem { const float* W; int K, N; bf16_t* WT; const float* gain; int mode, k0, n0; };
__device__ __forceinline__ void tr_load(const TrItem& t, int item, float (&tv)[32], int lane, TrItem& o) {
    o = t; const int nblk = t.N / 32, kb = item / nblk, nb = item % nblk; o.k0 = 64 * kb; o.n0 = 32 * nb;
#pragma unroll
    for (int i = 0; i < 32; ++i) tv[i] = t.W[(size_t)(o.k0 + 2 * i + (lane >> 5)) * t.N + o.n0 + (lane & 31)];
}
__device__ __forceinline__ void tr_finish(const TrItem& t, float (&tv)[32], LAS float* scr, int lane) {
    if (t.gain) {
#pragma unroll
        for (int i = 0; i < 32; ++i) tv[i] *= t.gain[t.k0 + 2 * i + (lane >> 5)]; }
#pragma unroll
    for (int i = 0; i < 32; ++i) scr[(2 * i + (lane >> 5)) * 33 + (lane & 31)] = tv[i];
    asm volatile("s_waitcnt lgkmcnt(0)" ::: "memory");
    const int c = lane & 7;
#pragma unroll
    for (int j = 0; j < 4; ++j) { const int n = (lane >> 3) + 8 * j; const LAS float* s = scr + (8 * c) * 33 + n;
        u32x4 o; o.x = pk2(s[0 * 33], s[1 * 33]); o.y = pk2(s[2 * 33], s[3 * 33]); o.z = pk2(s[4 * 33], s[5 * 33]); o.w = pk2(s[6 * 33], s[7 * 33]);
        const int ng = t.n0 + n; const int drow = t.mode == 0 ? ng : ((ng >> 7) * 256 + (t.mode == 2 ? 128 : 0) + (ng & 127));
        *(u32x4*)(t.WT + (size_t)drow * t.K + t.k0 + 8 * c) = o; }
    asm volatile("s_waitcnt lgkmcnt(0)" ::: "memory");
}
__device__ __forceinline__ void row_init(const float* xrow, bf16_t* orow, float* slots, int nslots, int lane) {
    const f32x4* xr = (const f32x4*)xrow + lane; f32x4 v[4]; float s = 0.f;
#pragma unroll
    for (int j = 0; j < 4; ++j) { v[j] = xr[64 * j]; s += sq4(v[j]); }
    s = wave_sum(s);
    u32x2v* o8 = (u32x2v*)orow + lane;
#pragma unroll
    for (int j = 0; j < 4; ++j) { u32x2v w; w.x = pk2(v[j][0], v[j][1]); w.y = pk2(v[j][2], v[j][3]); o8[64 * j] = w; }
    if (slots && lane < nslots) slots[lane] = (lane == 0) ? s : 0.f;
}

__device__ __forceinline__ void p0_prologue(const Frame& F, const Args& a) {
    unsigned char* ws = a.ws;
    LAS float* scr = (LAS float*)(F.lds + F.wave * 16384);
    const int gw = F.wg * NWAVES + F.wave, NGW = F.G * NWAVES;
    constexpr int I_UP = (D / 64) * (FF / 32), I_DN = (FF / 64) * (D / 32), I_INP = (D / 64) * (DIN / 32), I_SQ = (D / 64) * (D / 32);
    constexpr int PER_L = 6 * I_UP + I_INP + 5 * I_SQ;
    static_assert(I_UP == 1408 && I_DN == 1408 && I_INP == 1536 && I_SQ == 512 && PER_L == 12544, "items");
    auto decode = [&](int it, TrItem& t, int& r) {
        const int l = it / PER_L; r = it % PER_L;
        bf16_t* LWb = (bf16_t*)(ws + WS_W) + (size_t)l * LW_SZ; bf16_t* KV = (bf16_t*)(ws + WS_WKV) + (size_t)l * 2 * SZ_SQ;
        const size_t oUP = (size_t)l * D * FF, oDN = (size_t)l * FF * D, oSQ = (size_t)l * D * D;
        if (r < I_UP) { t = TrItem{a.in[I_F1G] + oUP, D, FF, LWb + LW_1U, a.in[I_NF1] + l * D, 1, 0, 0}; return; } r -= I_UP;
        if (r < I_UP) { t = TrItem{a.in[I_F1U] + oUP, D, FF, LWb + LW_1U, a.in[I_NF1] + l * D, 2, 0, 0}; return; } r -= I_UP;
        if (r < I_DN) { t = TrItem{a.in[I_F1D] + oDN, FF, D, LWb + LW_1D, nullptr, 0, 0, 0}; return; } r -= I_DN;
        if (r < I_INP) { t = TrItem{a.in[I_WIN] + (size_t)l * D * DIN, D, DIN, LWb + LW_IN, a.in[I_NMIX] + l * D, 0, 0, 0}; return; } r -= I_INP;
        if (r < I_SQ) { t = TrItem{a.in[I_WOUT] + oSQ, D, D, LWb + LW_OUT, nullptr, 0, 0, 0}; return; } r -= I_SQ;
        if (r < I_SQ) { t = TrItem{a.in[I_XWQ] + oSQ, D, D, LWb + LW_Q, a.in[I_NCROSS] + l * D, 0, 0, 0}; return; } r -= I_SQ;
        if (r < I_SQ) { t = TrItem{a.in[I_XWK] + oSQ, D, D, KV, nullptr, 0, 0, 0}; return; } r -= I_SQ;
        if (r < I_SQ) { t = TrItem{a.in[I_XWV] + oSQ, D, D, KV + SZ_SQ, nullptr, 0, 0, 0}; return; } r -= I_SQ;
        if (r < I_SQ) { t = TrItem{a.in[I_XWO] + oSQ, D, D, LWb + LW_O, nullptr, 0, 0, 0}; return; } r -= I_SQ;
        if (r < I_UP) { t = TrItem{a.in[I_F2G] + oUP, D, FF, LWb + LW_2U, a.in[I_NF2] + l * D, 1, 0, 0}; return; } r -= I_UP;
        if (r < I_UP) { t = TrItem{a.in[I_F2U] + oUP, D, FF, LWb + LW_2U, a.in[I_NF2] + l * D, 2, 0, 0}; return; } r -= I_UP;
        t = TrItem{a.in[I_F2D] + oDN, FF, D, LWb + LW_2D, nullptr, 0, 0, 0}; };
    { float tvA[32], tvB[32]; TrItem tA, tB, td; int r; int it = gw;
      if (it < NL * PER_L) { decode(it, td, r); tr_load(td, r, tvA, F.lane, tA); }
      while (it < NL * PER_L) {
          const int itn = it + NGW; if (itn < NL * PER_L) { decode(itn, td, r); tr_load(td, r, tvB, F.lane, tB); }
          tr_finish(tA, tvA, scr, F.lane);
          it = itn; if (it >= NL * PER_L) break;
          const int itn2 = it + NGW; if (itn2 < NL * PER_L) { decode(itn2, td, r); tr_load(td, r, tvA, F.lane, tA); }
          tr_finish(tB, tvB, scr, F.lane);
          it = itn2; } }
    { bf16_t* LW = (bf16_t*)(ws + WS_LRUW);
      for (int idx = F.wg * NTHR + F.tid; idx < NL * 2 * 4 * 4096; idx += F.G * NTHR) { const int k = idx & 63, j = (idx >> 6) & 63, n = (idx >> 12) & 3, ax = (idx >> 14) & 1, l = idx >> 15;
          LW[idx] = (bf16_t)f2bf((ax ? a.in[I_LWX] : a.in[I_LWA])[(size_t)((l * 4 + n) * 64 + k) * 64 + j]); } }
    bf16_t* XB = (bf16_t*)(ws + WS_XB); float* SSQ = (float*)(ws + WS_SSQ); float* SSQS = (float*)(ws + WS_SSQS); bf16_t* MEMB = (bf16_t*)(ws + WS_MEMB);
#pragma unroll 1
    for (int mb = gw; mb < M; mb += 4 * NGW) { f32x4 v[4][4];
#pragma unroll
        for (int i = 0; i < 4; ++i) { const int m = mb + i * NGW < M ? mb + i * NGW : M - 1; const f32x4* xr = (const f32x4*)(a.in[I_XP] + (size_t)m * D) + F.lane;
#pragma unroll
            for (int j = 0; j < 4; ++j) v[i][j] = xr[64 * j]; }
#pragma unroll
        for (int i = 0; i < 4; ++i) { const int m = mb + i * NGW; float sq = 0.f;
#pragma unroll
            for (int j = 0; j < 4; ++j) sq += sq4(v[i][j]);
            sq = wave_sum(sq);
            if (m < M) { u32x2v* o8 = (u32x2v*)(XB + (size_t)m * D) + F.lane;
#pragma unroll
                for (int j = 0; j < 4; ++j) { u32x2v w; w.x = pk2(v[i][j][0], v[i][j][1]); w.y = pk2(v[i][j][2], v[i][j][3]); o8[64 * j] = w; }
                if (F.lane < 16) SSQ[(size_t)m * 16 + F.lane] = (F.lane == 0) ? sq : 0.f; } } }
    for (int m = M + gw; m < MT + 512; m += NGW) {
        if (m < MT) row_init(a.in[I_XS] + (size_t)(m - M) * D, XB + (size_t)m * D, SSQS + (size_t)(m - M) * 64, 64, F.lane);
        else row_init(a.in[I_MEMP] + (size_t)(m - MT) * D, MEMB + (size_t)(m - MT) * D, nullptr, 0, F.lane);
    }
}
__device__ __forceinline__ void p1_cache_copy(const Frame& F, const Args& a) {
    constexpr int HALFP = (WINDOW - STOK) * 128 / 2;
#pragma unroll 1
    for (int kv = 0; kv < 2; ++kv) {
        const f32x4* src = (const f32x4*)a.in[kv ? I_CSV : I_CSK]; f32x4* dst = (f32x4*)(a.out + (kv ? O_SSV : O_SSK));
#pragma unroll 1
        for (int pp = F.wg; pp < NL * SBATCH * 2; pp += F.G) {
            const int p = pp >> 1, hf = pp & 1;
            const f32x4* s = src + (size_t)p * (WINDOW * 128) + STOK * 128 + (size_t)hf * HALFP; f32x4* d = dst + (size_t)p * (WINDOW * 128) + (size_t)hf * HALFP;
#pragma unroll 8
            for (int e = F.tid; e < HALFP; e += NTHR) { const f32x4 v = __builtin_nontemporal_load(s + e); __builtin_nontemporal_store(v, d + e); }
        }
    }
}

constexpr int CP_BLK = 4088, CP_NBLK = 2 * NL * SBATCH * 64;
static_assert((WINDOW - STOK) * 128 == 64 * CP_BLK, "copy blocks");
__device__ __forceinline__ void cache_copy_block_wave(int lane, const float* csk, const float* csv, float* out, int blk) {
    const int kv = blk >> 13, p = (blk >> 6) & 127, q = blk & 63;
    const f32x4* s = (const f32x4*)(kv ? csv : csk) + (size_t)p * (WINDOW * 128) + STOK * 128 + (size_t)q * CP_BLK; f32x4* d = (f32x4*)(out + (kv ? O_SSV : O_SSK)) + (size_t)p * (WINDOW * 128) + (size_t)q * CP_BLK;
#pragma unroll 1
    for (int it = 0; it < 4; ++it) { f32x4 v[16];
#pragma unroll
        for (int i = 0; i < 16; ++i) { const int e = lane + 64 * (16 * it + i); v[i] = __builtin_nontemporal_load(s + (e < CP_BLK ? e : CP_BLK - 1)); }
#pragma unroll
        for (int i = 0; i < 16; ++i) { const int e = lane + 64 * (16 * it + i); if (e < CP_BLK) __builtin_nontemporal_store(v[i], d + e); } }
}

template <int NBT> __device__ __forceinline__ void slab_mma(const bf16_t* A, int lda, const bf16_t* B0, const bf16_t* B1, int ldb, int K, int wave, int lane, f32x4& acc0, f32x4& acc1) {
    const int fr = lane & 15, g = lane >> 4;
    const bf16_t* ap = A + (size_t)(16 * wave + fr) * lda + 8 * g;
    const bf16_t* b0 = B0 + (size_t)fr * ldb + 8 * g; const bf16_t* b1 = B1 + (size_t)fr * ldb + 8 * g;
    acc0 = (f32x4){0.f, 0.f, 0.f, 0.f}; acc1 = (f32x4){0.f, 0.f, 0.f, 0.f};
    constexpr int NS = NBT == 2 ? 11 : 16;
#pragma unroll 1
    for (int kb = 0; kb < K; kb += 32 * NS) {
        bf16x8 af[NS], bf0[NS], bf1[NBT == 2 ? NS : 1];
#pragma unroll
        for (int i = 0; i < NS; ++i) { const int k0 = kb + 32 * i; if (k0 < K) { af[i] = *(const bf16x8*)(ap + k0); bf0[i] = *(const bf16x8*)(b0 + k0); if (NBT == 2) bf1[i] = *(const bf16x8*)(b1 + k0); } }
#pragma unroll
        for (int i = 0; i < NS; ++i) { const int k0 = kb + 32 * i; if (k0 < K) { acc0 = __builtin_amdgcn_mfma_f32_16x16x32_bf16(bf0[i], af[i], acc0, 0, 0, 0);
                if (NBT == 2) acc1 = __builtin_amdgcn_mfma_f32_16x16x32_bf16(bf1[i], af[i], acc1, 0, 0, 0); } }
    }
}

template <int NBT> __device__ __forceinline__ void slab_mma_f32a(const float* A, const bf16_t* B0, const bf16_t* B1, int ldb, int wave, int lane, f32x4& acc0, f32x4& acc1, float& rs) {
    const int fr = lane & 15, g = lane >> 4;
    const float* ap = A + (size_t)(16 * wave + fr) * D + 8 * g;
    const bf16_t* b0 = B0 + (size_t)fr * ldb + 8 * g; const bf16_t* b1 = B1 + (size_t)fr * ldb + 8 * g;
    acc0 = (f32x4){0.f, 0.f, 0.f, 0.f}; acc1 = (f32x4){0.f, 0.f, 0.f, 0.f}; float ss = 0.f;
    constexpr int NS = 8;
#pragma unroll 1
    for (int kb = 0; kb < D; kb += 32 * NS) {
        f32x4 a0[NS], a1[NS]; bf16x8 bf0[NS], bf1[NBT == 2 ? NS : 1];
#pragma unroll
        for (int i = 0; i < NS; ++i) { const int k0 = kb + 32 * i; a0[i] = *(const f32x4*)(ap + k0); a1[i] = *(const f32x4*)(ap + k0 + 4); bf0[i] = *(const bf16x8*)(b0 + k0); if (NBT == 2) bf1[i] = *(const bf16x8*)(b1 + k0); }
#pragma unroll
        for (int i = 0; i < NS; ++i) { ss += sq4(a0[i]) + sq4(a1[i]); const bf16x8 af = __builtin_bit_cast(bf16x8, pack8(a0[i], a1[i]));
            acc0 = __builtin_amdgcn_mfma_f32_16x16x32_bf16(bf0[i], af, acc0, 0, 0, 0);
            if (NBT == 2) acc1 = __builtin_amdgcn_mfma_f32_16x16x32_bf16(bf1[i], af, acc1, 0, 0, 0); }
    }
    ss = sum_g(ss);
    rs = frsq(ss * (1.0f / D) + EPS);
}

__device__ __forceinline__ void slab_up32_f32a(const float* A, const bf16_t* Bg  , int wave, int lane, f32x4 (&ag)[2], f32x4 (&au)[2], float& rs) {
    const int fr = lane & 15, g = lane >> 4;
    const float* ap = A + (size_t)(16 * wave + fr) * D + 8 * g;
    const bf16_t* bg = Bg + (size_t)fr * D + 8 * g;
#pragma unroll
    for (int j = 0; j < 2; ++j) { ag[j] = (f32x4){0.f, 0.f, 0.f, 0.f}; au[j] = (f32x4){0.f, 0.f, 0.f, 0.f}; }
    float ss = 0.f;
    constexpr int NS = 5;
#pragma unroll 1
    for (int kb = 0; kb < D; kb += 32 * NS) {
        f32x4 a0[NS], a1[NS]; bf16x8 bq[NS][4];
#pragma unroll
        for (int i = 0; i < NS; ++i) { const int k0 = kb + 32 * i; if (k0 < D) { a0[i] = *(const f32x4*)(ap + k0); a1[i] = *(const f32x4*)(ap + k0 + 4);
                bq[i][0] = *(const bf16x8*)(bg + k0); bq[i][1] = *(const bf16x8*)(bg + (size_t)16 * D + k0); bq[i][2] = *(const bf16x8*)(bg + (size_t)128 * D + k0); bq[i][3] = *(const bf16x8*)(bg + (size_t)144 * D + k0); } }
#pragma unroll
        for (int i = 0; i < NS; ++i) if (kb + 32 * i < D) { ss += sq4(a0[i]) + sq4(a1[i]); const bf16x8 af = __builtin_bit_cast(bf16x8, pack8(a0[i], a1[i]));
            ag[0] = __builtin_amdgcn_mfma_f32_16x16x32_bf16(bq[i][0], af, ag[0], 0, 0, 0); ag[1] = __builtin_amdgcn_mfma_f32_16x16x32_bf16(bq[i][1], af, ag[1], 0, 0, 0);
            au[0] = __builtin_amdgcn_mfma_f32_16x16x32_bf16(bq[i][2], af, au[0], 0, 0, 0); au[1] = __builtin_amdgcn_mfma_f32_16x16x32_bf16(bq[i][3], af, au[1], 0, 0, 0); }
    }
    ss = sum_g(ss);
    rs = frsq(ss * (1.0f / D) + EPS);
}

__device__ __forceinline__ f32x4 slab_f32a_q(const float* A, const bf16_t* B, int wave, int lane) {
    const int fr = lane & 15, g = lane >> 4;
    const float* ap = A + (size_t)(16 * wave + fr) * D + 8 * g; const bf16_t* bp = B + (size_t)fr * D + 8 * g;
    f32x4 a0[8], a1[8]; bf16x8 bf[8]; f32x4 acc = {0.f, 0.f, 0.f, 0.f};
#pragma unroll
    for (int i = 0; i < 8; ++i) { a0[i] = *(const f32x4*)(ap + 32 * i); a1[i] = *(const f32x4*)(ap + 32 * i + 4); bf[i] = *(const bf16x8*)(bp + 32 * i); }
#pragma unroll
    for (int i = 0; i < 8; ++i) acc = __builtin_amdgcn_mfma_f32_16x16x32_bf16(bf[i], __builtin_bit_cast(bf16x8, pack8(a0[i], a1[i])), acc, 0, 0, 0);
    return acc;
}

__device__ __forceinline__ void phase_ffn_up(const Frame& F, unsigned char* ws, const bf16_t* Wu, const float* xs  ) {
    bf16_t* XB = (bf16_t*)(ws + WS_XB); bf16_t* ACT = (bf16_t*)(ws + WS_ACT); const float* SSQ = (const float*)(ws + WS_SSQ);
    pg8::Gemm g{XB, Wu, D, D, D, 0, 0, 256 * D}; pg8::StaticOrder S; S.init(M, 2 * FF, F.G, F.wg);
    EpiUp E{ACT, SSQ};
    pg8::gemm_phase<EpiUp, pg8::StaticOrder, true, true>(F.lds, g, S, E, F.wave);
    int lane = F.lane; asm volatile("" : "+v"(lane));
    for (int s = F.wg - F.G / 2; s >= 0 && s < FF / 32; s += F.G / 2) {
        const int n0 = 32 * s; const bf16_t* Bg = Wu + (size_t)((n0 >> 7) * 256 + (n0 & 127)) * D;
        f32x4 ag[2], au[2]; float rs; slab_up32_f32a(xs, Bg, F.wave, lane, ag, au, rs);
        const int row = 16 * F.wave + (lane & 15);
#pragma unroll
        for (int j = 0; j < 2; ++j) { u32x2v w; w.x = pk2(siluf_(ag[j][0] * rs) * (au[j][0] * rs), siluf_(ag[j][1] * rs) * (au[j][1] * rs)); w.y = pk2(siluf_(ag[j][2] * rs) * (au[j][2] * rs), siluf_(ag[j][3] * rs) * (au[j][3] * rs));
            *(u32x2v*)(ACT + (size_t)(M + row) * FF + n0 + 16 * j + 4 * (lane >> 4)) = w; }
    }
}
__device__ __forceinline__ void phase_resid(const Frame& F, unsigned char* ws, const bf16_t* A, int K, const bf16_t* W, const float* xin  , float* xsout  , float alpha) {
    bf16_t* XB = (bf16_t*)(ws + WS_XB); float* SSQ = (float*)(ws + WS_SSQ);
    pg8::Gemm g{A, W, K, K, K, 0, 0, 256 * K}; pg8::StaticOrder S; S.init(M, D, F.G, F.wg);
    EpiResid E{xin, XB, (bf16_t*)(ws + WS_XL), SSQ, alpha};
    pg8::gemm_phase<EpiResid, pg8::StaticOrder, false, true>(F.lds, g, S, E, F.wave);
    int lane = F.lane; asm volatile("" : "+v"(lane));
    for (int t = F.wg; t < 256; t += F.G) {
        const int sl = t >> 2, kq = t & 3, n0 = 16 * sl, k0 = kq * (K / 4); f32x4 ac, dum; slab_mma<1>(A + (size_t)M * K + k0, K, W + (size_t)n0 * K + k0, W, K, K / 4, F.wave, lane, ac, dum);
        const int row = 16 * F.wave + (lane & 15), c = n0 + 4 * (lane >> 4); float* xp = xsout + (size_t)row * D + c;
#pragma unroll
        for (int e = 0; e < 4; ++e) atomicAdd(xp + e, ac[e] * alpha);
    }
}
__device__ __forceinline__ void phase_win(const Frame& F, unsigned char* ws, const bf16_t* W, float* psk, const float* xs) {
    bf16_t* XB = (bf16_t*)(ws + WS_XB); const float* SSQ = (const float*)(ws + WS_SSQ); float* ZS = (float*)(ws + WS_ZS);
    pg8::Gemm g{XB, W, D, D, D, 0, 0, 256 * D}; pg8::StaticOrder S; S.init(M, DIN, F.G, F.wg);
    EpiZ E{(bf16_t*)(ws + WS_ZF), (bf16_t*)(ws + WS_QA), psk, SSQ};
    pg8::gemm_phase<EpiZ, pg8::StaticOrder, true, true>(F.lds, g, S, E, F.wave);
    int lane = F.lane; asm volatile("" : "+v"(lane));
    for (int s = F.G - 1 - F.wg; s < DIN / 16; s += F.G) {
        const int n0 = 16 * s; f32x4 ac, dum; float rs; slab_mma_f32a<1>(xs, W + (size_t)n0 * D, W, D, F.wave, lane, ac, dum, rs);
        const int row = 16 * F.wave + (lane & 15);
        *(f32x4*)(ZS + (size_t)row * DIN + n0 + 4 * (lane >> 4)) = ac * rs;
    }
}

constexpr int CW_DBG = 8192;
#ifdef DBG
constexpr int N_CH = 9;
__device__ __forceinline__ void dbg_acc(gu32* ctl, int c, float num, float den, int lane) {
    num = wave_sum(num); den = wave_sum(den);
    if (lane == 0) { atomicAdd((float*)(ctl + CW_DBG + 2 * c), num); atomicAdd((float*)(ctl + CW_DBG + 2 * c + 1), den); }
}
template <class FA> __device__ __forceinline__ float ndot(FA fa, const float* W, int K, size_t ldw, int lane) {
    float s = 0.f; for (int k = lane; k < K; k += 64) s += fa(k) * W[(size_t)k * ldw]; return wave_sum(s);
}
__device__ __forceinline__ void dbg_finish(const Frame& F, const Args& a, gu32* ctl) {
    const size_t ooff[N_CH] = {O_YS, O_PLH, O_PLC, O_PHG, O_PSK, O_PSV, O_SLH, O_SLC, O_SHG};
    const size_t osz[N_CH] = {(size_t)MS * D, NL * NB * 256, NL * NB * 768, (size_t)NL * NB * 16384, (size_t)NL * NB * 2048 * 512, (size_t)NL * NB * 2048 * 512, NL * 32 * 256, NL * 32 * 768, (size_t)NL * 32 * 16384};
    const size_t gt = (size_t)F.wg * NTHR + F.tid, NT = (size_t)F.G * NTHR;
    for (size_t e = gt; e < (size_t)M * D; e += NT) a.out[O_YP + e] = 0.f;
    for (int c = 0; c < N_CH; ++c) {
        const float num = __hip_atomic_load((float*)(ctl + CW_DBG + 2 * c), __ATOMIC_RELAXED, __HIP_MEMORY_SCOPE_AGENT), den = __hip_atomic_load((float*)(ctl + CW_DBG + 2 * c + 1), __ATOMIC_RELAXED, __HIP_MEMORY_SCOPE_AGENT);
        size_t n = 0; if (den > 0.f) { float r = 1e4f * fsqrt(num / den); if (!(r < 90000.f)) r = 90000.f; n = 1 + (size_t)(r + 0.5f); }
#ifdef DBGT
        { const int sel1[N_CH] = {2, 15, 0, 3, 4, 5, 6, 7, 8}, sel2[N_CH] = {9, 1, 10, 11, 12, 13, 14, 16, 16}; const int ty = (DBGT == 1 ? sel1 : sel2)[c];
          unsigned tk = 0; if (DBGT == 3 || DBGT == 4) tk = __hip_atomic_load((unsigned*)(ctl + CW_DBG + 96 + c), __ATOMIC_RELAXED, __HIP_MEMORY_SCOPE_AGENT); else if (ty < 16) tk = __hip_atomic_load((unsigned*)(ctl + CW_DBG + 64 + ty), __ATOMIC_RELAXED, __HIP_MEMORY_SCOPE_AGENT); n = 1 + tk / 100; }
#endif
        size_t cap = osz[c] < 99999 ? osz[c] : 99999; if (n > cap) n = cap;
        for (size_t e = n + gt; e < osz[c]; e += NT) a.out[ooff[c] + e] = 0.f;
    }
    for (int p = F.wg * NTHR + F.tid; p < 2 * NL * SBATCH * 4 * 128; p += F.G * NTHR) { const int kv = p / (NL * SBATCH * 512), r = p % (NL * SBATCH * 512), pr = r / 512, e = r % 512;
        ((f32x4*)(a.out + (kv ? O_SSV : O_SSK)))[(size_t)pr * (WINDOW * 128) + (WINDOW - STOK) * 128 + e] = (f32x4){0.f, 0.f, 0.f, 0.f}; }
}
#endif

constexpr int ZC_XA = 0, ZC_GA = 256, ZC_QB = 512, ZC_FB = 768, ZC_VB = 1024, ZC_GB = 1280, ZC_QC = 1536, ZC_KC = 2048, ZC_VC = 2560;
constexpr float LN2 = 0.6931471805599453f;
#define WG_SYNC() __syncthreads()
#define WG_SYNC_LDS() asm volatile("s_waitcnt lgkmcnt(0)\n\ts_barrier" ::: "memory")

constexpr int LC_OFF = 102400, LC_PIECES = 28;
struct LdsCopy { const char* src; char* dst; };
__device__ __forceinline__ void lc_issue(const Frame& F, const LdsCopy& c) { if (!c.src) return;
    for (int j = F.wave; j < LC_PIECES; j += NWAVES) __builtin_amdgcn_global_load_lds((const unsigned*)(c.src + j * 1024 + F.lane * 16), (LAS unsigned*)(F.lds + LC_OFF + j * 1024), 16, 0, 0); }
__device__ __forceinline__ void lc_store(const Frame& F, const LdsCopy& c) { if (!c.src) return;
    asm volatile("s_waitcnt vmcnt(0)" ::: "memory");
    for (int j = F.wave; j < LC_PIECES; j += NWAVES) { const f32x4 v = *(const LAS f32x4*)(F.lds + LC_OFF + j * 1024 + F.lane * 16); __builtin_nontemporal_store(v, (f32x4*)(c.dst + j * 1024 + F.lane * 16)); } }
constexpr int LC_NCHUNK = 56 * 146;
__device__ __forceinline__ LdsCopy lc_chunk(const float* csk, float* out, int cidx) { LdsCopy c; c.src = nullptr; c.dst = nullptr;
    if (cidx < LC_NCHUNK) { const int p = cidx / 146, q = cidx % 146; c.src = (const char*)(csk + (size_t)p * (WINDOW * 512) + STOK * 512) + (size_t)q * 28672; c.dst = (char*)(out + O_SSK + (size_t)p * (WINDOW * 512)) + (size_t)q * 28672; }
    return c; }

__device__ __forceinline__ float hgrn_lb(const float* lbp, int l, int c) {
    const float v0 = lbp[c], v1 = lbp[256 + c], v2 = lbp[512 + c], v3 = lbp[768 + c];
    const float mx = fmaxf(fmaxf(v0, v1), fmaxf(v2, v3));
    const float e0 = fexp(v0 - mx), e1 = fexp(v1 - mx), e2 = fexp(v2 - mx), e3 = fexp(v3 - mx);
    const float inv = 1.0f / ((e0 + e1) + (e2 + e3));
    float s = 0.f; if (l >= 1) s += e1; if (l >= 2) s += e2; if (l >= 3) s += e3;
    return s * inv;
}

struct LruW { const float* convw; const float* convb; const float* wa; const float* ba; const float* wx; const float* bx; const float* lam; const float* gna; };
template <int MODE> __device__ __forceinline__ void lru_seq(const Frame& F, const LruW& W, const float* z, int zld, int T, const float* buf3  , const float* h0  ,
                                                            bf16_t* Y  , float* out_h, float* out_conv, gu32* ctl, int dch) {
    LAS float* xc = (LAS float*)F.lds;
    LAS float* red = xc + 1024;
    const int c = F.tid, n = (c >> 6) & 3, j = c & 63; const bool act = c < 256;
    float xm3 = 0.f, xm2 = 0.f, xm1 = 0.f, h = 0.f;
    float w0 = 0.f, w1 = 0.f, w2 = 0.f, w3 = 0.f, cb = 0.f, ba = 0.f, bx = 0.f, sp = 0.f, gn = 0.f;
    if (act) { if (buf3) { xm3 = buf3[c]; xm2 = buf3[256 + c]; xm1 = buf3[512 + c]; } if (h0) h = h0[c];
        w0 = W.convw[c]; w1 = W.convw[256 + c]; w2 = W.convw[512 + c]; w3 = W.convw[768 + c]; cb = W.convb[c]; ba = W.ba[c]; bx = W.bx[c]; gn = W.gna[c];
        sp = 0.6931471805599453f * flog2(1.f + fexp(-W.lam[c])); }
    float dn = 0.f, dd = 0.f;
    for (int t0 = 0; t0 < T; t0 += 4) {
        float xv[4], xcv[4];
        if (act) {
#pragma unroll
            for (int t = 0; t < 4; ++t) xv[t] = z[(size_t)(t0 + t) * zld + ZC_XA + c];
            xcv[0] = cb + w0 * xm3 + w1 * xm2 + w2 * xm1 + w3 * xv[0];
            xcv[1] = cb + w0 * xm2 + w1 * xm1 + w2 * xv[0] + w3 * xv[1];
            xcv[2] = cb + w0 * xm1 + w1 * xv[0] + w2 * xv[1] + w3 * xv[2];
            xcv[3] = cb + w0 * xv[0] + w1 * xv[1] + w2 * xv[2] + w3 * xv[3];
            xm3 = xv[1]; xm2 = xv[2]; xm1 = xv[3];
#pragma unroll
            for (int t = 0; t < 4; ++t) xc[t * 256 + c] = xcv[t];
        }
        WG_SYNC();
        float y[4] = {0.f, 0.f, 0.f, 0.f};
        if (act) {
            float ra[4] = {0.f, 0.f, 0.f, 0.f}, ri[4] = {0.f, 0.f, 0.f, 0.f};
#pragma unroll 1
            for (int kb = 0; kb < 64; kb += 16) { float wa[16], wx[16];
#pragma unroll
                for (int k = 0; k < 16; ++k) { wa[k] = W.wa[(size_t)(n * 64 + kb + k) * 64 + j]; wx[k] = W.wx[(size_t)(n * 64 + kb + k) * 64 + j]; }
#pragma unroll
                for (int k = 0; k < 16; ++k) {
#pragma unroll
                    for (int t = 0; t < 4; ++t) { const float x = xc[t * 256 + n * 64 + kb + k]; ra[t] += x * wa[k]; ri[t] += x * wx[k]; } } }
#pragma unroll
            for (int t = 0; t < 4; ++t) { const float r = sigmoidf_(ra[t] + ba), ig = sigmoidf_(ri[t] + bx);
                const float la = -8.0f * r * sp, av = fexp(la), u = fsqrt(1.f - fexp(2.f * la)) * (ig * xcv[t]);
                h = av * h + u; const float ga = z[(size_t)(t0 + t) * zld + ZC_GA + c]; y[t] = h * gelu_tanh(ga); }
        }
#pragma unroll
        for (int t = 0; t < 4; ++t) { const float s = wave_sum(y[t] * y[t]); if (F.lane == 0 && F.wave < 4) red[t * 4 + F.wave] = s; }
        WG_SYNC();
        if (act) {
#pragma unroll
            for (int t = 0; t < 4; ++t) { const float tot = (red[t * 4] + red[t * 4 + 1]) + (red[t * 4 + 2] + red[t * 4 + 3]); const float o = y[t] * frsq(tot * (1.f / 256.f) + EPS) * gn;
                if (MODE == 0) Y[(size_t)(t0 + t) * D + c] = (bf16_t)f2bf(o);
                else { const float got = bf2f(Y[(size_t)(t0 + t) * D + c]); dn += (got - o) * (got - o); dd += o * o; } }
        }
        WG_SYNC();
    }
    if (MODE == 0 && act) { out_h[c] = h; out_conv[c] = xm3; out_conv[256 + c] = xm2; out_conv[512 + c] = xm1; }
#ifdef DBG
    if (MODE == 1) dbg_acc(ctl, dch, dn, dd, F.lane);
#endif
}

template <int MODE> __device__ __forceinline__ void hgrn_seq(const Frame& F, const float* lbp, const float* hnorm, int l, int hh, const float* z, int zld, int T, const float* s0  ,
                                                             bf16_t* Y, float* out_s, gu32* ctl, int dch) {
    LAS float* red = (LAS float*)F.lds + 2048;
    const int v = F.lane, d0 = F.wave * 8;
    float S[8], lb[8];
#pragma unroll
    for (int i = 0; i < 8; ++i) { S[i] = s0 ? s0[(size_t)(d0 + i) * 64 + v] : 0.f; lb[i] = hgrn_lb(lbp, l, hh * 64 + d0 + i); }
    const float ng = hnorm[v]; float dn = 0.f, dd = 0.f;
    for (int t = 0; t < T; ++t) {
        const float* zr = z + (size_t)t * zld; const float vv = zr[ZC_VB + hh * 64 + v]; float op = 0.f;
#pragma unroll
        for (int i = 0; i < 8; ++i) { const float fp = zr[ZC_FB + hh * 64 + d0 + i], q = zr[ZC_QB + hh * 64 + d0 + i];
            const float f = lb[i] + (1.f - lb[i]) * sigmoidf_(fp);
            S[i] = f * S[i] + (1.f - f) * vv; op += q * S[i]; }
        red[F.wave * 64 + v] = op;
        WG_SYNC();
        float o = 0.f;
#pragma unroll
        for (int w = 0; w < 8; ++w) o += red[w * 64 + v];
        const float ss = wave_sum(o * o); const float gg = zr[ZC_GB + hh * 64 + v];
        const float y = o * frsq(ss * (1.f / 64.f) + EPS) * ng * siluf_(gg);
        if (F.wave == 0) { if (MODE == 0) Y[(size_t)t * D + 256 + hh * 64 + v] = (bf16_t)f2bf(y);
            else { const float got = bf2f(Y[(size_t)t * D + 256 + hh * 64 + v]); dn += (got - y) * (got - y); dd += y * y; } }
        WG_SYNC();
    }
    if (MODE == 0) {
#pragma unroll
        for (int i = 0; i < 8; ++i) out_s[(size_t)(d0 + i) * 64 + v] = S[i]; }
#ifdef DBG
    if (MODE == 1 && F.wave == 0) dbg_acc(ctl, dch, dn, dd, F.lane);
#endif
}

template <class KV> __device__ __forceinline__ void attn_naive(const KV& kv, const float (&q)[16], int qpos, int h, int lane, float (&o)[16]) {
    const int slot = lane >> 2; const float slope = fast_exp2(-(float)(h + 1)) * LOG2E, sc = 0.125f * LOG2E;
    float m = -1e30f, lsum = 0.f;
#pragma unroll
    for (int i = 0; i < 16; ++i) o[i] = 0.f;
#pragma unroll 1
    for (int pat = 0; pat < 3; ++pat) { const int dil = pat == 0 ? 1 : (pat == 1 ? 4 : 16);
#pragma unroll 3
        for (int j0 = 0; j0 < 129; j0 += 16) { const int jj = j0 + slot; const int kp = qpos - jj * dil; const bool valid = jj <= 128 && kp >= 0;
            float kf[16], vf[16]; kv(valid ? kp : qpos, lane & 3, kf, vf);
            float s = 0.f;
#pragma unroll
            for (int i = 0; i < 16; ++i) s += q[i] * kf[i];
            s += x1_(s); s += x2_(s);
            s = valid ? s * sc - slope * (float)(jj * dil) : -INFINITY;
            float mx = s;
            mx = fmaxf(mx, sw4_(mx)); mx = fmaxf(mx, sw8_(mx)); mx = max_g(mx);
            const float mn = fmaxf(m, mx), alpha = fast_exp2(m - mn), p = fast_exp2(s - mn); m = mn;
            lsum = lsum * alpha + p;
#pragma unroll
            for (int i = 0; i < 16; ++i) o[i] = o[i] * alpha + p * vf[i]; } }
    lsum += sw4_(lsum); lsum += sw8_(lsum); lsum = sum_g(lsum);
#pragma unroll
    for (int i = 0; i < 16; ++i) { o[i] += sw4_(o[i]); o[i] += sw8_(o[i]); o[i] = sum_g(o[i]); }
    const float inv = 1.f / lsum;
#pragma unroll
    for (int i = 0; i < 16; ++i) o[i] *= inv;
}
struct KVDecode {
    const float* ck; const float* cv; const float* zs; int h;
    __device__ __forceinline__ void operator()(int kp, int part, float (&kf)[16], float (&vf)[16]) const {
        const float* kr; const float* vr;
        if (kp < WINDOW) { kr = ck + ((size_t)kp * 8 + h) * 64; vr = cv + ((size_t)kp * 8 + h) * 64; } else { kr = zs + (size_t)(kp - WINDOW) * DIN + ZC_KC + h * 64; vr = zs + (size_t)(kp - WINDOW) * DIN + ZC_VC + h * 64; }
#pragma unroll
        for (int i = 0; i < 4; ++i) { const f32x4 a = *(const f32x4*)(kr + part * 16 + 4 * i), b = *(const f32x4*)(vr + part * 16 + 4 * i);
#pragma unroll
            for (int e = 0; e < 4; ++e) { kf[4 * i + e] = a[e]; vf[4 * i + e] = b[e]; } }
    }
};
struct KVPrompt {
    const bf16_t* k; const bf16_t* v;
    __device__ __forceinline__ void operator()(int kp, int part, float (&kf)[16], float (&vf)[16]) const {
#pragma unroll
        for (int i = 0; i < 16; ++i) { kf[i] = bf2f(k[(size_t)kp * 64 + part * 16 + i]); vf[i] = bf2f(v[(size_t)kp * 64 + part * 16 + i]); }
    }
};

__device__ __forceinline__ void lru_local(const Frame& F, unsigned char* ws, const LruW& W, int task, float* out_conv  ) {
    const float* ZF = (const float*)(ws + WS_ZF); float* ACUM = (float*)(ws + WS_ACUM); float* HLOC = (float*)(ws + WS_HLOC);
    const int b = task >> 7, ck = task & 127, t0 = ck * 64, row0 = b * SEQ + t0;
    LAS float* xc = (LAS float*)F.lds;
    LAS float* exch = xc + 64 * 256;
    for (int idx = F.tid; idx < 64 * 64; idx += NTHR) { const int t = idx >> 6, c4 = (idx & 63) * 4;
        f32x4 acc = *(const f32x4*)(W.convb + c4);
#pragma unroll
        for (int tap = 0; tap < 4; ++tap) { const int tt = t0 + t - 3 + tap; if (tt >= 0) acc += *(const f32x4*)(W.convw + tap * 256 + c4) * *(const f32x4*)(ZF + (size_t)(b * SEQ + tt) * 1536 + ZC_XA + c4); }
        *(LAS f32x4*)(xc + t * 256 + c4) = acc; }
    WG_SYNC();
    const int c = F.tid & 255, th = F.tid >> 8, n = c >> 6, j = c & 63;
    float ra[32], ri[32];
#pragma unroll
    for (int t = 0; t < 32; ++t) { ra[t] = 0.f; ri[t] = 0.f; }
#pragma unroll 1
    for (int k4 = 0; k4 < 16; ++k4) {
        float wa[4], wx[4];
#pragma unroll
        for (int e = 0; e < 4; ++e) { wa[e] = W.wa[(size_t)(n * 64 + 4 * k4 + e) * 64 + j]; wx[e] = W.wx[(size_t)(n * 64 + 4 * k4 + e) * 64 + j]; }
#pragma unroll
        for (int t = 0; t < 32; ++t) { const f32x4 x = *(const LAS f32x4*)(xc + (th * 32 + t) * 256 + n * 64 + 4 * k4);
            ra[t] += (x[0] * wa[0] + x[1] * wa[1]) + (x[2] * wa[2] + x[3] * wa[3]); ri[t] += (x[0] * wx[0] + x[1] * wx[1]) + (x[2] * wx[2] + x[3] * wx[3]); }
    }
    const float ba = W.ba[c], bx = W.bx[c], sp = 0.6931471805599453f * flog2(1.f + fexp(-W.lam[c]));
#pragma unroll
    for (int t = 0; t < 32; ++t) { const float r = sigmoidf_(ra[t] + ba), ig = sigmoidf_(ri[t] + bx);
        const float la = -8.0f * r * sp; ra[t] = fexp(la); ri[t] = fsqrt(1.f - fexp(2.f * la)) * (ig * xc[(th * 32 + t) * 256 + c]); }
    float A = 1.f, H = 0.f;
    if (th == 0) {
#pragma unroll
        for (int t = 0; t < 32; ++t) { H = ra[t] * H + ri[t]; A *= ra[t]; ACUM[(size_t)(row0 + t) * 256 + c] = A; HLOC[(size_t)(row0 + t) * 256 + c] = H; }
        exch[2 * c] = A; exch[2 * c + 1] = H; }
    WG_SYNC();
    if (th == 1) { A = exch[2 * c]; H = exch[2 * c + 1];
#pragma unroll
        for (int t = 0; t < 32; ++t) { H = ra[t] * H + ri[t]; A *= ra[t]; ACUM[(size_t)(row0 + 32 + t) * 256 + c] = A; HLOC[(size_t)(row0 + 32 + t) * 256 + c] = H; }
        ((float*)(ws + WS_CA))[(size_t)task * 256 + c] = A; ((float*)(ws + WS_CH))[(size_t)task * 256 + c] = H;
        if (ck == 127) {
#pragma unroll
            for (int q = 0; q < 3; ++q) out_conv[(b * 3 + q) * 256 + c] = ZF[(size_t)(row0 + 61 + q) * 1536 + ZC_XA + c]; } }
    WG_SYNC();
}

constexpr int HS = 68;
__device__ __forceinline__ void hgrn_cum(const Frame& F, const float* ZF, const float* lbp, int l, int b, int hh, int ck, LAS float* gt  , float (&cum8)[8], float (&kk8)[8], float& tot) {
    const int d = F.tid & 63, tg = F.tid >> 6; const float lb = hgrn_lb(lbp, l, hh * 64 + d); float run = 0.f;
#pragma unroll
    for (int i = 0; i < 8; ++i) { const float fp = ZF[(size_t)(b * SEQ + ck * 64 + tg * 8 + i) * 1536 + ZC_FB + hh * 64 + d]; const float f = lb + (1.f - lb) * sigmoidf_(fp);
        run += flog2(f); cum8[i] = run; kk8[i] = 1.f - f; }
    gt[tg * 64 + d] = run;
    WG_SYNC();
    float pre = 0.f; tot = 0.f;
#pragma unroll
    for (int g = 0; g < 8; ++g) { const float x = gt[g * 64 + d]; if (g < tg) pre += x; tot += x; }
#pragma unroll
    for (int i = 0; i < 8; ++i) cum8[i] += pre;
}
__device__ __forceinline__ void hgrn_local(const Frame& F, unsigned char* ws, const float* lbp, int l, int task) {
    const float* ZF = (const float*)(ws + WS_ZF);
    const int ck = task & 127, hh = (task >> 7) & 3, b = task >> 9;
    LAS float* kp = (LAS float*)F.lds; LAS float* vv = kp + 64 * HS; LAS float* gt = vv + 64 * HS;
    float cum8[8], kk8[8], tot; hgrn_cum(F, ZF, lbp, l, b, hh, ck, gt, cum8, kk8, tot);
    const int d = F.tid & 63, tg = F.tid >> 6;
#pragma unroll
    for (int i = 0; i < 8; ++i) { kp[(tg * 8 + i) * HS + d] = kk8[i] * fast_exp2(tot - cum8[i]); vv[(tg * 8 + i) * HS + d] = ZF[(size_t)(b * SEQ + ck * 64 + tg * 8 + i) * 1536 + ZC_VB + hh * 64 + d]; }
    if (tg == 0) ((float*)(ws + WS_HDEC))[(size_t)task * 64 + d] = fast_exp2(tot);
    WG_SYNC();
    const int dd0 = 2 * (F.tid >> 4), v0 = 4 * (F.tid & 15); f32x4 a0 = {0.f, 0.f, 0.f, 0.f}, a1 = {0.f, 0.f, 0.f, 0.f};
#pragma unroll 8
    for (int s = 0; s < 64; ++s) { const f32x2v kx = *(const LAS f32x2v*)(kp + s * HS + dd0); const f32x4 vx = *(const LAS f32x4*)(vv + s * HS + v0); a0 += vx * kx[0]; a1 += vx * kx[1]; }
    float* KV = (float*)(ws + WS_HKV) + (size_t)task * 4096;
    *(f32x4*)(KV + dd0 * 64 + v0) = a0; *(f32x4*)(KV + (dd0 + 1) * 64 + v0) = a1;
    WG_SYNC();
}
__device__ __forceinline__ void hgrn_out(const Frame& F, unsigned char* ws, const float* lbp, const float* hnorm, int l, int task) {
    const float* ZF = (const float*)(ws + WS_ZF); bf16_t* Y = (bf16_t*)(ws + WS_Y);
    const int ck = task & 127, hh = (task >> 7) & 3, b = task >> 9, row0 = b * SEQ + ck * 64;
    LAS float* q = (LAS float*)F.lds; LAS float* k = q + 64 * HS; LAS float* cu = k + 64 * HS; LAS float* vv = cu + 64 * HS; LAS float* sc = vv + 64 * HS; LAS float* sp = sc + 64 * HS; LAS float* gt = sp + 64 * HS;
    float cum8[8], kk8[8], tot; hgrn_cum(F, ZF, lbp, l, b, hh, ck, gt, cum8, kk8, tot);
    const int d = F.tid & 63, tg = F.tid >> 6;
#pragma unroll
    for (int i = 0; i < 8; ++i) { const int t = tg * 8 + i; const float* zr = ZF + (size_t)(row0 + t) * 1536;
        q[t * HS + d] = zr[ZC_QB + hh * 64 + d]; k[t * HS + d] = kk8[i]; cu[t * HS + d] = cum8[i]; vv[t * HS + d] = zr[ZC_VB + hh * 64 + d]; }
    { const float* SP = (const float*)(ws + WS_HSP) + (size_t)task * 4096;
#pragma unroll
      for (int i = 0; i < 2; ++i) { const int idx = F.tid + NTHR * i, r = idx >> 4, c4 = (idx & 15) * 4; *(LAS f32x4*)(sp + r * HS + c4) = *(const f32x4*)(SP + r * 64 + c4); } }
    WG_SYNC();
    { const int t = F.tid >> 3, sg = F.tid & 7; float accs[8];
#pragma unroll
      for (int i = 0; i < 8; ++i) accs[i] = 0.f;
#pragma unroll 1
      for (int hf = 0; hf < 2; ++hf) { f32x4 qv[8], ct[8];
#pragma unroll
          for (int d4 = 0; d4 < 8; ++d4) { qv[d4] = *(const LAS f32x4*)(q + t * HS + 32 * hf + 4 * d4); ct[d4] = *(const LAS f32x4*)(cu + t * HS + 32 * hf + 4 * d4); }
#pragma unroll
          for (int i = 0; i < 8; ++i) { const int s_ = sg + 8 * i;
              if (s_ <= t) { f32x4 kv[8], cs[8];
#pragma unroll
                  for (int d4 = 0; d4 < 8; ++d4) { kv[d4] = *(const LAS f32x4*)(k + s_ * HS + 32 * hf + 4 * d4); cs[d4] = *(const LAS f32x4*)(cu + s_ * HS + 32 * hf + 4 * d4); }
#pragma unroll
                  for (int d4 = 0; d4 < 8; ++d4)
#pragma unroll
                      for (int e = 0; e < 4; ++e) accs[i] += qv[d4][e] * kv[d4][e] * fast_exp2(ct[d4][e] - cs[d4][e]); } } }
#pragma unroll
      for (int i = 0; i < 8; ++i) sc[t * HS + sg + 8 * i] = accs[i]; }
    WG_SYNC();
    { const int t = F.tid >> 3, vg = F.tid & 7, v0 = 8 * vg; f32x4 a0 = {0.f, 0.f, 0.f, 0.f}, a1 = {0.f, 0.f, 0.f, 0.f};
      const int smax = 8 * (F.wave + 1);
#pragma unroll 8
      for (int s_ = 0; s_ < smax; ++s_) { const float w = sc[t * HS + s_]; a0 += *(const LAS f32x4*)(vv + s_ * HS + v0) * w; a1 += *(const LAS f32x4*)(vv + s_ * HS + v0 + 4) * w; }
#pragma unroll 8
      for (int dd = 0; dd < 64; ++dd) { const float w = q[t * HS + dd] * fast_exp2(cu[t * HS + dd]); a0 += *(const LAS f32x4*)(sp + dd * HS + v0) * w; a1 += *(const LAS f32x4*)(sp + dd * HS + v0 + 4) * w; }
      float ss = sq4(a0) + sq4(a1); ss += x1_(ss); ss += x2_(ss); ss += sw4_(ss);
      const float rs = frsq(ss * (1.f / 64.f) + EPS); const float* zr = ZF + (size_t)(row0 + t) * 1536 + ZC_GB + hh * 64 + v0;
      const f32x4 g0 = *(const f32x4*)zr, g1 = *(const f32x4*)(zr + 4), n0 = *(const f32x4*)(hnorm + v0), n1 = *(const f32x4*)(hnorm + v0 + 4);
#pragma unroll
      for (int e = 0; e < 4; ++e) { a0[e] = a0[e] * rs * n0[e] * siluf_(g0[e]); a1[e] = a1[e] * rs * n1[e] * siluf_(g1[e]); }
      *(u32x4*)(Y + (size_t)(row0 + t) * D + 256 + hh * 64 + v0) = pack8(a0, a1); }
    WG_SYNC();
}

typedef short s16x4 __attribute__((ext_vector_type(4)));
typedef short v4i16_t __attribute__((ext_vector_type(4)));
constexpr int VROW = 144;
constexpr int ATT_WAVE_LDS = 2 * 2 * 16 * VROW;
__device__ __forceinline__ void attn_wave_task2(const Frame& F, unsigned char* ws, int b, int h, int P, int r0, LAS unsigned char* wl) {
    const bf16_t* QA = (const bf16_t*)(ws + WS_QA) + (size_t)(b * 8 + h) * SEQ * 64; const bf16_t* KA = (const bf16_t*)(ws + WS_KA) + (size_t)(b * 8 + h) * SEQ * 64; const bf16_t* VA = (const bf16_t*)(ws + WS_VA) + (size_t)(b * 8 + h) * SEQ * 64;
    const int lane = F.lane, qi = lane & 15, g = lane >> 4, base = 256 * P;
    const float sc = 0.125f * LOG2E, slope = fast_exp2(-(float)(h + 1)) * LOG2E;
    bf16x8 qf[2][2]; f32x4 O[2][4]; float m[2], lsum[2]; bf16x8 kreg[2][4]; u32x4 vreg[2][4];
#pragma unroll
    for (int s = 0; s < 2; ++s) { const bf16_t* qp = QA + (size_t)(base + r0 + 8 * s + 16 * qi) * 64 + 8 * g; qf[s][0] = *(const bf16x8*)qp; qf[s][1] = *(const bf16x8*)(qp + 32);
#pragma unroll
        for (int i = 0; i < 4; ++i) O[s][i] = (f32x4){0.f, 0.f, 0.f, 0.f};
        m[s] = -1e30f; lsum[s] = 0.f; }
    auto step_geom = [&](int st, int r, int& dil, int& res, int& a0, int& aq0, int& aqs) {
        if (st < 5) { dil = 16; res = r; a0 = 16 * P - 128 + 32 * st; aq0 = 16 * P; aqs = 1; }
        else if (st < 11) { dil = 4; res = r & 3; a0 = 64 * P - 128 + 32 * (st - 5); aq0 = 64 * P + (r >> 2); aqs = 4; }
        else { dil = 1; res = 0; a0 = 256 * P - 128 + 32 * (st - 11); aq0 = 256 * P + r; aqs = 16; } };
#define ATT_PREFETCH(st_, s_) do { int dil, res, a0, aq0, aqs; step_geom((st_), r0 + 8 * (s_), dil, res, a0, aq0, aqs); \
        _Pragma("unroll") for (int tt = 0; tt < 2; ++tt) { int pk = dil * (a0 + 16 * tt + qi) + res; pk = pk < 0 ? 0 : (pk > SEQ - 1 ? SEQ - 1 : pk); \
            const bf16_t* kp = KA + (size_t)pk * 64 + 8 * g; kreg[s_][2 * tt] = *(const bf16x8*)kp; kreg[s_][2 * tt + 1] = *(const bf16x8*)(kp + 32); \
            int pv = dil * (a0 + 16 * tt + (lane >> 2)) + res; pv = pv < 0 ? 0 : (pv > SEQ - 1 ? SEQ - 1 : pv); \
            const bf16_t* vp = VA + (size_t)pv * 64 + 16 * (lane & 3); vreg[s_][2 * tt] = *(const u32x4*)vp; vreg[s_][2 * tt + 1] = *(const u32x4*)(vp + 8); } } while (0)
    ATT_PREFETCH(0, 0); ATT_PREFETCH(0, 1);
#pragma unroll 1
    for (int st = 0; st < 23; ++st) {
        const bool shared = st >= 5, nshared = st + 1 >= 5;
        f32x4 sA[2], sB[2];
#define ATT_QK(s_, k_) do { sA[s_] = (f32x4){0.f, 0.f, 0.f, 0.f}; sB[s_] = (f32x4){0.f, 0.f, 0.f, 0.f}; \
            sA[s_] = __builtin_amdgcn_mfma_f32_16x16x32_bf16(kreg[k_][0], qf[s_][0], sA[s_], 0, 0, 0); sA[s_] = __builtin_amdgcn_mfma_f32_16x16x32_bf16(kreg[k_][1], qf[s_][1], sA[s_], 0, 0, 0); \
            sB[s_] = __builtin_amdgcn_mfma_f32_16x16x32_bf16(kreg[k_][2], qf[s_][0], sB[s_], 0, 0, 0); sB[s_] = __builtin_amdgcn_mfma_f32_16x16x32_bf16(kreg[k_][3], qf[s_][1], sB[s_], 0, 0, 0); } while (0)
        if (shared) { ATT_QK(0, 0); ATT_QK(1, 0); } else { ATT_QK(0, 0); ATT_QK(1, 1); }
#undef ATT_QK
#pragma unroll
        for (int s = 0; s < 2; ++s) if (s == 0 || !shared) { LAS unsigned char* vb = wl + s * (2 * 16 * VROW);
#pragma unroll
            for (int tt = 0; tt < 2; ++tt) { LAS unsigned char* p = vb + tt * (16 * VROW) + (lane >> 2) * VROW + 32 * (lane & 3); *(LAS u32x4*)p = vreg[s][2 * tt]; *(LAS u32x4*)(p + 16) = vreg[s][2 * tt + 1]; } }
        if (st + 1 < 23) { ATT_PREFETCH(st + 1, 0); if (!nshared) ATT_PREFETCH(st + 1, 1); }
#pragma unroll
        for (int s = 0; s < 2; ++s) {
            int dil, res, a0, aq0, aqs; step_geom(st, r0 + 8 * s, dil, res, a0, aq0, aqs);
            LAS unsigned char* vb = wl + (shared ? 0 : s) * (2 * 16 * VROW);
            f32x4 s0 = sA[s], s1 = sB[s];
            const int aq = aq0 + aqs * qi, db = aq - a0 - 4 * g; const unsigned lim = (unsigned)(aq < 128 ? aq : 128); const float sd = slope * (float)dil, fb = sd * (float)db; float mx = -INFINITY;
#pragma unroll
            for (int e = 0; e < 4; ++e) { const unsigned d0 = (unsigned)(db - e), d1 = (unsigned)(db - e - 16);
                s0[e] = d0 <= lim ? s0[e] * sc - (fb - sd * (float)e) : -INFINITY;
                s1[e] = d1 <= lim ? s1[e] * sc - (fb - sd * (float)(e + 16)) : -INFINITY;
                mx = fmaxf(mx, fmaxf(s0[e], s1[e])); }
            mx = max_g(mx);
            const float mn = fmaxf(m[s], mx), alpha = fast_exp2(m[s] - mn); m[s] = mn;
            float ps = 0.f; f32x4 p0, p1;
#pragma unroll
            for (int e = 0; e < 4; ++e) { p0[e] = fast_exp2(s0[e] - mn); p1[e] = fast_exp2(s1[e] - mn); ps += p0[e] + p1[e]; }
            lsum[s] = lsum[s] * alpha + ps;
            const u32x4 pw = pack8(p0, p1); const bf16x8 pf = __builtin_bit_cast(bf16x8, pw);
#pragma unroll
            for (int dt = 0; dt < 4; ++dt) { O[s][dt] *= alpha;
                LAS unsigned char* a0p = vb + (4 * g + (qi >> 2)) * VROW + (16 * dt + 4 * (qi & 3)) * 2;
                const s16x4 lo = __builtin_bit_cast(s16x4, __builtin_amdgcn_ds_read_tr16_b64_v4i16((LAS v4i16_t*)a0p));
                const s16x4 hi = __builtin_bit_cast(s16x4, __builtin_amdgcn_ds_read_tr16_b64_v4i16((LAS v4i16_t*)(a0p + 16 * VROW)));
                O[s][dt] = __builtin_amdgcn_mfma_f32_16x16x32_bf16(__builtin_shufflevector(lo, hi, 0, 1, 2, 3, 4, 5, 6, 7), pf, O[s][dt], 0, 0, 0); }
        }
    }
#undef ATT_PREFETCH
#pragma unroll
    for (int s = 0; s < 2; ++s) { float ls = lsum[s]; ls = sum_g(ls);
        const float inv = 1.f / ls; float* yc = (float*)(ws + WS_YC) + (size_t)(b * SEQ + base + r0 + 8 * s + 16 * qi) * 512 + h * 64 + 4 * g;
#pragma unroll
        for (int dt = 0; dt < 4; ++dt) *(f32x4*)(yc + 16 * dt) = O[s][dt] * inv; }
}

__device__ __forceinline__ void attn_wave_task4(const Frame& F, unsigned char* ws, int b, int h, int P, int r0, LAS unsigned char* wl) {
    const bf16_t* QA = (const bf16_t*)(ws + WS_QA) + (size_t)(b * 8 + h) * SEQ * 64; const bf16_t* KA = (const bf16_t*)(ws + WS_KA) + (size_t)(b * 8 + h) * SEQ * 64; const bf16_t* VA = (const bf16_t*)(ws + WS_VA) + (size_t)(b * 8 + h) * SEQ * 64;
    const int lane = F.lane, qi = lane & 15, g = lane >> 4, base = 256 * P;
    const float sc = 0.125f * LOG2E, slope = fast_exp2(-(float)(h + 1)) * LOG2E;
    bf16x8 qf[4][2]; f32x4 O[4][4]; float m[4], lsum[4]; bf16x8 kA[4], kB[4]; u32x4 vA[4], vB[4];
#pragma unroll
    for (int s = 0; s < 4; ++s) { const bf16_t* qp = QA + (size_t)(base + r0 + 4 * s + 16 * qi) * 64 + 8 * g; qf[s][0] = *(const bf16x8*)qp; qf[s][1] = *(const bf16x8*)(qp + 32);
#pragma unroll
        for (int i = 0; i < 4; ++i) O[s][i] = (f32x4){0.f, 0.f, 0.f, 0.f};
        m[s] = -1e30f; lsum[s] = 0.f; }
#define A4_LOAD(kr, vr, dil_, res_, a0_) do { \
        _Pragma("unroll") for (int tt = 0; tt < 2; ++tt) { int pk = (dil_) * ((a0_) + 16 * tt + qi) + (res_); pk = pk < 0 ? 0 : (pk > SEQ - 1 ? SEQ - 1 : pk); \
            const char* kp = (const char*)KA + (unsigned)(pk * 128 + g * 16); kr[2 * tt] = *(const bf16x8*)kp; kr[2 * tt + 1] = *(const bf16x8*)(kp + 64); \
            int pv = (dil_) * ((a0_) + 16 * tt + (lane >> 2)) + (res_); pv = pv < 0 ? 0 : (pv > SEQ - 1 ? SEQ - 1 : pv); \
            const char* vp = (const char*)VA + (unsigned)(pv * 128 + (lane & 3) * 32); vr[2 * tt] = *(const u32x4*)vp; vr[2 * tt + 1] = *(const u32x4*)(vp + 16); } } while (0)
#define A4_VSTORE(vr, vb_) do { _Pragma("unroll") for (int tt = 0; tt < 2; ++tt) { LAS unsigned char* p = (vb_) + tt * (16 * VROW) + (lane >> 2) * VROW + 32 * (lane & 3); *(LAS u32x4*)p = vr[2 * tt]; *(LAS u32x4*)(p + 16) = vr[2 * tt + 1]; } } while (0)
#define A4_STATE(s_, kr, vb_, dil_, a0_, aq_) do { \
        f32x4 s0 = {0.f, 0.f, 0.f, 0.f}, s1 = {0.f, 0.f, 0.f, 0.f}; \
        s0 = __builtin_amdgcn_mfma_f32_16x16x32_bf16(kr[0], qf[s_][0], s0, 0, 0, 0); s0 = __builtin_amdgcn_mfma_f32_16x16x32_bf16(kr[1], qf[s_][1], s0, 0, 0, 0); \
        s1 = __builtin_amdgcn_mfma_f32_16x16x32_bf16(kr[2], qf[s_][0], s1, 0, 0, 0); s1 = __builtin_amdgcn_mfma_f32_16x16x32_bf16(kr[3], qf[s_][1], s1, 0, 0, 0); \
        const int aqq_ = (aq_), db = aqq_ - (a0_) - 4 * g; const unsigned lim = (unsigned)(aqq_ < 128 ? aqq_ : 128); const float sd = slope * (float)(dil_), fb = sd * (float)db; float mx = -INFINITY; \
        _Pragma("unroll") for (int e = 0; e < 4; ++e) { const unsigned d0 = (unsigned)(db - e), d1 = (unsigned)(db - e - 16); \
            s0[e] = d0 <= lim ? s0[e] * sc - (fb - sd * (float)e) : -INFINITY; \
            s1[e] = d1 <= lim ? s1[e] * sc - (fb - sd * (float)(e + 16)) : -INFINITY; \
            mx = fmaxf(mx, fmaxf(s0[e], s1[e])); } \
        mx = max_g(mx); \
        const float mn = fmaxf(m[s_], mx), alpha = fast_exp2(m[s_] - mn); m[s_] = mn; \
        float ps = 0.f; f32x4 p0, p1; \
        _Pragma("unroll") for (int e = 0; e < 4; ++e) { p0[e] = fast_exp2(s0[e] - mn); p1[e] = fast_exp2(s1[e] - mn); ps += p0[e] + p1[e]; } \
        lsum[s_] = lsum[s_] * alpha + ps; \
        const bf16x8 pf = __builtin_bit_cast(bf16x8, pack8(p0, p1)); \
        _Pragma("unroll") for (int dt = 0; dt < 4; ++dt) { O[s_][dt] *= alpha; \
            LAS unsigned char* a0p = (vb_) + (4 * g + (qi >> 2)) * VROW + (16 * dt + 4 * (qi & 3)) * 2; \
            const s16x4 lo = __builtin_bit_cast(s16x4, __builtin_amdgcn_ds_read_tr16_b64_v4i16((LAS v4i16_t*)a0p)); \
            const s16x4 hi = __builtin_bit_cast(s16x4, __builtin_amdgcn_ds_read_tr16_b64_v4i16((LAS v4i16_t*)(a0p + 16 * VROW))); \
            O[s_][dt] = __builtin_amdgcn_mfma_f32_16x16x32_bf16(__builtin_shufflevector(lo, hi, 0, 1, 2, 3, 4, 5, 6, 7), pf, O[s_][dt], 0, 0, 0); } } while (0)
    LAS unsigned char* vbA = wl; LAS unsigned char* vbB = wl + 2 * 16 * VROW;
    A4_LOAD(kA, vA, 16, r0, 16 * P - 128);
#pragma unroll 1
    for (int st = 0; st < 5; ++st) { const int a0 = 16 * P - 128 + 32 * st, aq = 16 * P + qi;
        A4_VSTORE(vA, vbA); A4_LOAD(kB, vB, 16, r0 + 4, a0);  A4_STATE(0, kA, vbA, 16, a0, aq);
        A4_VSTORE(vB, vbB); A4_LOAD(kA, vA, 16, r0 + 8, a0);  A4_STATE(1, kB, vbB, 16, a0, aq);
        A4_VSTORE(vA, vbA); A4_LOAD(kB, vB, 16, r0 + 12, a0); A4_STATE(2, kA, vbA, 16, a0, aq);
        A4_VSTORE(vB, vbB);
        if (st < 4) A4_LOAD(kA, vA, 16, r0, a0 + 32); else A4_LOAD(kA, vA, 4, r0, 64 * P - 128);
        A4_STATE(3, kB, vbB, 16, a0, aq); }
#pragma unroll 1
    for (int j = 0; j < 18; j += 2) {
        { const int st = j; const bool d4 = st < 6; const int dil = d4 ? 4 : 1, a0 = d4 ? 64 * P - 128 + 32 * st : 256 * P - 128 + 32 * (st - 6);
          const int sn = st + 1; const bool n4 = sn < 6; A4_VSTORE(vA, vbA);
          if (n4) A4_LOAD(kB, vB, 4, r0, 64 * P - 128 + 32 * sn); else A4_LOAD(kB, vB, 1, 0, 256 * P - 128 + 32 * (sn - 6));
          A4_STATE(0, kA, vbA, dil, a0, (d4 ? 64 * P + 4 * qi : 256 * P + r0 + 16 * qi));
          A4_STATE(1, kA, vbA, dil, a0, (d4 ? 64 * P + 1 + 4 * qi : 256 * P + r0 + 4 + 16 * qi));
          A4_STATE(2, kA, vbA, dil, a0, (d4 ? 64 * P + 2 + 4 * qi : 256 * P + r0 + 8 + 16 * qi));
          A4_STATE(3, kA, vbA, dil, a0, (d4 ? 64 * P + 3 + 4 * qi : 256 * P + r0 + 12 + 16 * qi)); }
        { const int st = j + 1; const bool d4 = st < 6; const int dil = d4 ? 4 : 1, a0 = d4 ? 64 * P - 128 + 32 * st : 256 * P - 128 + 32 * (st - 6);
          const int sn = st + 1 < 18 ? st + 1 : 17; const bool n4 = sn < 6; A4_VSTORE(vB, vbB);
          if (n4) A4_LOAD(kA, vA, 4, r0, 64 * P - 128 + 32 * sn); else A4_LOAD(kA, vA, 1, 0, 256 * P - 128 + 32 * (sn - 6));
          A4_STATE(0, kB, vbB, dil, a0, (d4 ? 64 * P + 4 * qi : 256 * P + r0 + 16 * qi));
          A4_STATE(1, kB, vbB, dil, a0, (d4 ? 64 * P + 1 + 4 * qi : 256 * P + r0 + 4 + 16 * qi));
          A4_STATE(2, kB, vbB, dil, a0, (d4 ? 64 * P + 2 + 4 * qi : 256 * P + r0 + 8 + 16 * qi));
          A4_STATE(3, kB, vbB, dil, a0, (d4 ? 64 * P + 3 + 4 * qi : 256 * P + r0 + 12 + 16 * qi)); } }
#undef A4_LOAD
#undef A4_VSTORE
#undef A4_STATE
#pragma unroll
    for (int s = 0; s < 4; ++s) { float ls = lsum[s]; ls = sum_g(ls);
        const float inv = 1.f / ls; float* yc = (float*)(ws + WS_YC) + (size_t)(b * SEQ + base + r0 + 4 * s + 16 * qi) * 512 + h * 64 + 4 * g;
#pragma unroll
        for (int dt = 0; dt < 4; ++dt) *(f32x4*)(yc + 16 * dt) = O[s][dt] * inv; }
}

__device__ __forceinline__ void xattn_sample(const Frame& F, unsigned char* ws, const float* cmk, const float* cmv  , int sb, int h, const float* xs) {
    bf16_t* OB = (bf16_t*)(ws + WS_OB) + (size_t)(M + sb * 4) * D + h * 256;
    LAS float* q = (LAS float*)F.lds;
    LAS float* sc = q + 1024;
    LAS float* part = sc + 1024;
    LAS float* rsq = part + 8 * 4 * 256;
    if (F.wave < 4) { const f32x4* xr = (const f32x4*)(xs + (size_t)(sb * 4 + F.wave) * D) + F.lane; float ss = 0.f;
#pragma unroll
        for (int j = 0; j < 4; ++j) ss += sq4(xr[64 * j]);
        ss = wave_sum(ss); if (F.lane == 0) rsq[F.wave] = frsq(ss * (1.0f / D) + EPS); }
    WG_SYNC();
    { const float* QS = (const float*)(ws + WS_QXS) + (size_t)(sb * 4) * D + h * 256;
      for (int i = F.tid; i < 1024; i += NTHR) q[i] = QS[(size_t)(i >> 8) * D + (i & 255)] * rsq[i >> 8]; }
    WG_SYNC();
    const int lane = F.lane, m0 = F.wave * 32;
    { f32x4 qv[4];
#pragma unroll
      for (int t = 0; t < 4; ++t) qv[t] = *(const LAS f32x4*)(q + t * 256 + 4 * lane);
      const float* kb = cmk + ((size_t)(sb * 256 + m0) * 4 + h) * 256 + 4 * lane;
#pragma unroll 1
      for (int mb = 0; mb < 32; mb += 16) { f32x4 kv[16];
#pragma unroll
          for (int i = 0; i < 16; ++i) kv[i] = *(const f32x4*)(kb + (size_t)(mb + i) * 1024);
#pragma unroll
          for (int i = 0; i < 16; ++i) { float a0 = (kv[i][0] * qv[0][0] + kv[i][1] * qv[0][1]) + (kv[i][2] * qv[0][2] + kv[i][3] * qv[0][3]), a1 = (kv[i][0] * qv[1][0] + kv[i][1] * qv[1][1]) + (kv[i][2] * qv[1][2] + kv[i][3] * qv[1][3]),
                                              a2 = (kv[i][0] * qv[2][0] + kv[i][1] * qv[2][1]) + (kv[i][2] * qv[2][2] + kv[i][3] * qv[2][3]), a3 = (kv[i][0] * qv[3][0] + kv[i][1] * qv[3][1]) + (kv[i][2] * qv[3][2] + kv[i][3] * qv[3][3]);
              const bool o1 = lane & 1, o2 = lane & 2;
              float b0 = o1 ? a2 : a0, b1 = o1 ? a3 : a1; const float s0 = o1 ? a0 : a2, s1 = o1 ? a1 : a3;
              b0 += x1_(s0); b1 += x1_(s1);
              float c = o2 ? b1 : b0; const float sd = o2 ? b0 : b1; c += x2_(sd);
              c += sw4_(c); c += sw8_(c); c = sum_g(c);
              if (lane < 4) sc[(2 * (lane & 1) + (lane >> 1)) * 256 + m0 + mb + i] = c * (LOG2E / 16.f); } } }
    WG_SYNC();
    if (F.wave < 4) { const f32x4 sv = *(const LAS f32x4*)(sc + F.wave * 256 + 4 * lane); const float mx = wave_max(fmaxf(fmaxf(sv[0], sv[1]), fmaxf(sv[2], sv[3])));
        f32x4 p; float ps = 0.f;
#pragma unroll
        for (int e = 0; e < 4; ++e) { p[e] = fast_exp2(sv[e] - mx); ps += p[e]; }
        ps = wave_sum(ps); *(LAS f32x4*)(sc + F.wave * 256 + 4 * lane) = p * (1.f / ps); }
    WG_SYNC();
    { f32x4 o[4];
#pragma unroll
      for (int t = 0; t < 4; ++t) o[t] = (f32x4){0.f, 0.f, 0.f, 0.f};
      const float* vb = cmv + ((size_t)(sb * 256 + m0) * 4 + h) * 256 + 4 * lane;
#pragma unroll 1
      for (int mb = 0; mb < 32; mb += 16) { f32x4 vv[16];
#pragma unroll
          for (int i = 0; i < 16; ++i) vv[i] = *(const f32x4*)(vb + (size_t)(mb + i) * 1024);
#pragma unroll
          for (int i = 0; i < 16; ++i) {
#pragma unroll
              for (int t = 0; t < 4; ++t) o[t] += vv[i] * sc[t * 256 + m0 + mb + i]; } }
#pragma unroll
      for (int t = 0; t < 4; ++t) *(LAS f32x4*)(part + (F.wave * 4 + t) * 256 + 4 * lane) = o[t]; }
    WG_SYNC();
    { const int t = F.tid >> 7, d2 = (F.tid & 127) * 2; float o0 = 0.f, o1 = 0.f;
#pragma unroll
      for (int w = 0; w < 8; ++w) { const f32x2v x = *(const LAS f32x2v*)(part + (w * 4 + t) * 256 + d2); o0 += x[0]; o1 += x[1]; }
      *(unsigned*)(OB + (size_t)t * D + d2) = pk2(o0, o1); }
    WG_SYNC();
}

constexpr int HB = 72;
struct HgOutPre { float fp[8], qv[8], vv[8]; f32x4 spv[2]; };
__device__ __forceinline__ void hgrn_out_load(const Frame& F, unsigned char* ws, int task, HgOutPre& P) {
    const bf16_t* ZF = (const bf16_t*)(ws + WS_ZF); const int ck = task & 127, hh = (task >> 7) & 3, b = task >> 9, row0 = b * SEQ + ck * 64, d = F.tid & 63, tg = F.tid >> 6;
#pragma unroll
    for (int i = 0; i < 8; ++i) { const bf16_t* zr = ZF + (size_t)(row0 + tg * 8 + i) * 1536 + hh * 64 + d; P.fp[i] = bf2f(zr[ZC_FB]); P.qv[i] = bf2f(zr[ZC_QB]); P.vv[i] = bf2f(zr[ZC_VB]); }
    const float* SP = (const float*)(ws + WS_HSP) + (size_t)task * 4096;
#pragma unroll
    for (int i = 0; i < 2; ++i) { const int idx = F.tid + NTHR * i; P.spv[i] = *(const f32x4*)(SP + (idx >> 4) * 64 + (idx & 15) * 4); }
}
__device__ __forceinline__ void hgrn_out_mfma(const Frame& F, unsigned char* ws, const float* lbp, const float* hnorm, int l, int task, const HgOutPre& P, const LdsCopy& lc) {
    const bf16_t* ZF = (const bf16_t*)(ws + WS_ZF); bf16_t* Y = (bf16_t*)(ws + WS_Y);
    const int ck = task & 127, hh = (task >> 7) & 3, b = task >> 9, row0 = b * SEQ + ck * 64;
    LAS bf16_t* tQs = (LAS bf16_t*)F.lds; LAS bf16_t* tQc = tQs + 64 * HB; LAS bf16_t* tKe = tQc + 64 * HB; LAS bf16_t* tKb = tKe + 64 * HB; LAS bf16_t* tV = tKb + 64 * HB; LAS bf16_t* tS = tV + 64 * HB;
    LAS float* gt = (LAS float*)(tS + 64 * HB);
    LAS float* red = gt + 512;
    const int d = F.tid & 63, tg = F.tid >> 6;
    float fp[8], qv[8], vv[8]; f32x4 spv[2];
#pragma unroll
    for (int i = 0; i < 8; ++i) { fp[i] = P.fp[i]; qv[i] = P.qv[i]; vv[i] = P.vv[i]; }
    spv[0] = P.spv[0]; spv[1] = P.spv[1];
    const float lb = hgrn_lb(lbp, l, hh * 64 + d);
    float cum8[8], kk8[8], run = 0.f;
#pragma unroll
    for (int i = 0; i < 8; ++i) { const float f = lb + (1.f - lb) * sigmoidf_(fp[i]); run += flog2(f); cum8[i] = run; kk8[i] = 1.f - f; }
    gt[tg * 64 + d] = run;
#pragma unroll
    for (int i = 0; i < 2; ++i) { const int idx = F.tid + NTHR * i, r = idx >> 4, c4 = (idx & 15) * 4; u32x2v w; w.x = pk2(spv[i][0], spv[i][1]); w.y = pk2(spv[i][2], spv[i][3]); *(LAS u32x2v*)(tS + r * HB + c4) = w; }
    WG_SYNC_LDS(); lc_issue(F, lc);
    float pre = 0.f, refI = 0.f, endJ = 0.f;
#pragma unroll
    for (int g = 0; g < 8; ++g) { const float x = gt[g * 64 + d]; if (g < tg) pre += x; if (g < (tg & ~1)) refI += x; if (g <= (tg | 1)) endJ += x; }
#pragma unroll
    for (int i = 0; i < 8; ++i) { const int t = tg * 8 + i; const float c = cum8[i] + pre;
        tQs[t * HB + d] = (bf16_t)f2bf(qv[i] * fast_exp2(c - refI)); tQc[t * HB + d] = (bf16_t)f2bf(qv[i] * fast_exp2(c));
        tKe[t * HB + d] = (bf16_t)f2bf(kk8[i] * fast_exp2(endJ - c)); tKb[t * HB + d] = (bf16_t)f2bf(kk8[i] * fast_exp2(fminf(refI - c, 100.f)));
        tV[t * HB + d] = (bf16_t)f2bf(vv[i]); }
    WG_SYNC_LDS();
    const int lane = F.lane, ti = lane & 15, g = lane >> 4, I = F.wave >> 1, vh = F.wave & 1;
    bf16x8 qf[2];
#pragma unroll
    for (int ks = 0; ks < 2; ++ks) qf[ks] = *(const LAS bf16x8*)(tQs + (16 * I + ti) * HB + 32 * ks + 8 * g);
    f32x4 sT[4];
#pragma unroll
    for (int J = 0; J < 4; ++J) { sT[J] = (f32x4){0.f, 0.f, 0.f, 0.f};
        if (J <= I) {
            bf16x8 qx[2];
            if (J < I) {
#pragma unroll
                for (int ks = 0; ks < 2; ++ks) { float dl[8];
#pragma unroll
                    for (int e = 0; e < 8; ++e) dl[e] = 0.f;
                    for (int gg = 2 * J + 2; gg < 2 * I; ++gg) {
#pragma unroll
                        for (int e = 0; e < 8; ++e) dl[e] += gt[gg * 64 + 32 * ks + 8 * g + e]; }
                    f32x4 lo, hi;
#pragma unroll
                    for (int e = 0; e < 4; ++e) { lo[e] = bf2f((unsigned short)qf[ks][e]) * fast_exp2(dl[e]); hi[e] = bf2f((unsigned short)qf[ks][4 + e]) * fast_exp2(dl[4 + e]); }
                    qx[ks] = __builtin_bit_cast(bf16x8, pack8(lo, hi)); }
            } else { qx[0] = qf[0]; qx[1] = qf[1]; }
            const LAS bf16_t* kt = (J < I ? tKe : tKb) + (16 * J + ti) * HB + 8 * g;
            const bf16x8 k0 = *(const LAS bf16x8*)kt, k1 = *(const LAS bf16x8*)(kt + 32);
            sT[J] = __builtin_amdgcn_mfma_f32_16x16x32_bf16(k0, qx[0], sT[J], 0, 0, 0); sT[J] = __builtin_amdgcn_mfma_f32_16x16x32_bf16(k1, qx[1], sT[J], 0, 0, 0);
            if (J == I) {
#pragma unroll
                for (int e = 0; e < 4; ++e) if (4 * g + e > ti) sT[J][e] = 0.f; } } }
    f32x4 O[2];
#pragma unroll
    for (int vt = 0; vt < 2; ++vt) O[vt] = (f32x4){0.f, 0.f, 0.f, 0.f};
#pragma unroll
    for (int pp = 0; pp < 2; ++pp) { if (2 * pp <= I) {
        const bf16x8 pf = __builtin_bit_cast(bf16x8, pack8(sT[2 * pp], sT[2 * pp + 1]));
#pragma unroll
        for (int vt = 0; vt < 2; ++vt) { const LAS bf16_t* ap = tV + (32 * pp + 4 * g + (ti >> 2)) * HB + 32 * vh + 16 * vt + 4 * (ti & 3);
            const s16x4 lo = __builtin_bit_cast(s16x4, __builtin_amdgcn_ds_read_tr16_b64_v4i16((LAS v4i16_t*)ap));
            const s16x4 hi = __builtin_bit_cast(s16x4, __builtin_amdgcn_ds_read_tr16_b64_v4i16((LAS v4i16_t*)(ap + 16 * HB)));
            O[vt] = __builtin_amdgcn_mfma_f32_16x16x32_bf16(__builtin_shufflevector(lo, hi, 0, 1, 2, 3, 4, 5, 6, 7), pf, O[vt], 0, 0, 0); } } }
#pragma unroll
    for (int ks = 0; ks < 2; ++ks) { const LAS bf16_t* qc = tQc + (16 * I + ti) * HB + 32 * ks + 4 * g;
        const s16x4 q0 = *(const LAS s16x4*)qc, q1 = *(const LAS s16x4*)(qc + 16);
        const bf16x8 qcf = __builtin_shufflevector(q0, q1, 0, 1, 2, 3, 4, 5, 6, 7);
#pragma unroll
        for (int vt = 0; vt < 2; ++vt) { const LAS bf16_t* ap = tS + (32 * ks + 4 * g + (ti >> 2)) * HB + 32 * vh + 16 * vt + 4 * (ti & 3);
            const s16x4 lo = __builtin_bit_cast(s16x4, __builtin_amdgcn_ds_read_tr16_b64_v4i16((LAS v4i16_t*)ap));
            const s16x4 hi = __builtin_bit_cast(s16x4, __builtin_amdgcn_ds_read_tr16_b64_v4i16((LAS v4i16_t*)(ap + 16 * HB)));
            O[vt] = __builtin_amdgcn_mfma_f32_16x16x32_bf16(__builtin_shufflevector(lo, hi, 0, 1, 2, 3, 4, 5, 6, 7), qcf, O[vt], 0, 0, 0); } }
    float ss = sq4(O[0]) + sq4(O[1]); ss = sum_g(ss);
    if (g == 0) red[(I * 2 + vh) * 16 + ti] = ss;
    WG_SYNC_LDS();
    const float rs = frsq((red[(I * 2) * 16 + ti] + red[(I * 2 + 1) * 16 + ti]) * (1.f / 64.f) + EPS);
    const int row = row0 + 16 * I + ti;
#pragma unroll
    for (int vt = 0; vt < 2; ++vt) { const int v0 = 32 * vh + 16 * vt + 4 * g; const f32x4 gg = ldbf4(ZF + (size_t)row * 1536 + ZC_GB + hh * 64 + v0), nn = *(const f32x4*)(hnorm + v0);
        u32x2v w; w.x = pk2(O[vt][0] * rs * nn[0] * siluf_(gg[0]), O[vt][1] * rs * nn[1] * siluf_(gg[1])); w.y = pk2(O[vt][2] * rs * nn[2] * siluf_(gg[2]), O[vt][3] * rs * nn[3] * siluf_(gg[3]));
        *(u32x2v*)(Y + (size_t)row * D + 256 + hh * 64 + v0) = w; }
    lc_store(F, lc); WG_SYNC_LDS();
}

struct HgLocPre { float fp[8], vv[8]; };
__device__ __forceinline__ void hgrn_local_load(const Frame& F, unsigned char* ws, int task, HgLocPre& P) {
    const bf16_t* ZF = (const bf16_t*)(ws + WS_ZF); const int ck = task & 127, hh = (task >> 7) & 3, b = task >> 9, row0 = b * SEQ + ck * 64, d = F.tid & 63, tg = F.tid >> 6;
#pragma unroll
    for (int i = 0; i < 8; ++i) { const bf16_t* zr = ZF + (size_t)(row0 + tg * 8 + i) * 1536 + hh * 64 + d; P.fp[i] = bf2f(zr[ZC_FB]); P.vv[i] = bf2f(zr[ZC_VB]); }
}
__device__ __forceinline__ void hgrn_local_mfma(const Frame& F, unsigned char* ws, const float* lbp, int l, int task, const HgLocPre& P, const LdsCopy& lc) {
    const bf16_t* ZF = (const bf16_t*)(ws + WS_ZF);
    const int ck = task & 127, hh = (task >> 7) & 3, b = task >> 9, row0 = b * SEQ + ck * 64;
    LAS bf16_t* tKe = (LAS bf16_t*)F.lds; LAS bf16_t* tV = tKe + 64 * HB; LAS float* gt = (LAS float*)(tV + 64 * HB);
    const int d = F.tid & 63, tg = F.tid >> 6;
    float fp[8], vv[8];
#pragma unroll
    for (int i = 0; i < 8; ++i) { fp[i] = P.fp[i]; vv[i] = P.vv[i]; }
    const float lb = hgrn_lb(lbp, l, hh * 64 + d);
    float cum8[8], kk8[8], run = 0.f;
#pragma unroll
    for (int i = 0; i < 8; ++i) { const float f = lb + (1.f - lb) * sigmoidf_(fp[i]); run += flog2(f); cum8[i] = run; kk8[i] = 1.f - f; }
    gt[tg * 64 + d] = run;
    WG_SYNC_LDS(); lc_issue(F, lc);
    float pre = 0.f, tot = 0.f;
#pragma unroll
    for (int g = 0; g < 8; ++g) { const float x = gt[g * 64 + d]; if (g < tg) pre += x; tot += x; }
#pragma unroll
    for (int i = 0; i < 8; ++i) { const int t = tg * 8 + i; tKe[t * HB + d] = (bf16_t)f2bf(kk8[i] * fast_exp2(tot - (cum8[i] + pre))); tV[t * HB + d] = (bf16_t)f2bf(vv[i]); }
    if (tg == 0) ((float*)(ws + WS_HDEC))[(size_t)task * 64 + d] = fast_exp2(tot);
    WG_SYNC_LDS();
    const int lane = F.lane, ti = lane & 15, g = lane >> 4, dt = F.wave >> 1;
    f32x4 acc[2] = {{0.f, 0.f, 0.f, 0.f}, {0.f, 0.f, 0.f, 0.f}};
#pragma unroll
    for (int ks = 0; ks < 2; ++ks) { const int roff = (32 * ks + 4 * g + (ti >> 2)) * HB + 4 * (ti & 3);
        const s16x4 a0 = __builtin_bit_cast(s16x4, __builtin_amdgcn_ds_read_tr16_b64_v4i16((LAS v4i16_t*)(tKe + roff + 16 * dt)));
        const s16x4 a1 = __builtin_bit_cast(s16x4, __builtin_amdgcn_ds_read_tr16_b64_v4i16((LAS v4i16_t*)(tKe + roff + 16 * dt + 16 * HB)));
        const bf16x8 af = __builtin_shufflevector(a0, a1, 0, 1, 2, 3, 4, 5, 6, 7);
#pragma unroll
        for (int j = 0; j < 2; ++j) { const int vt = 2 * (F.wave & 1) + j;
            const s16x4 b0 = __builtin_bit_cast(s16x4, __builtin_amdgcn_ds_read_tr16_b64_v4i16((LAS v4i16_t*)(tV + roff + 16 * vt)));
            const s16x4 b1 = __builtin_bit_cast(s16x4, __builtin_amdgcn_ds_read_tr16_b64_v4i16((LAS v4i16_t*)(tV + roff + 16 * vt + 16 * HB)));
            acc[j] = __builtin_amdgcn_mfma_f32_16x16x32_bf16(af, __builtin_shufflevector(b0, b1, 0, 1, 2, 3, 4, 5, 6, 7), acc[j], 0, 0, 0); } }
    float* KV = (float*)(ws + WS_HKV) + (size_t)task * 4096;
#pragma unroll
    for (int j = 0; j < 2; ++j)
#pragma unroll
        for (int r = 0; r < 4; ++r) KV[(16 * dt + 4 * g + r) * 64 + 16 * (2 * (F.wave & 1) + j) + ti] = acc[j][r];
    lc_store(F, lc); WG_SYNC_LDS();
}

constexpr int XCB = 264;
__device__ __forceinline__ void lru_local_mfma(const Frame& F, unsigned char* ws, const LruW& W, int l, int task, float* out_conv) {
    const bf16_t* ZF = (const bf16_t*)(ws + WS_ZF); float* ACUM = (float*)(ws + WS_ACUM); float* HLOC = (float*)(ws + WS_HLOC);
    const int b = task >> 7, ck = task & 127, t0 = ck * 64, row0 = b * SEQ + t0;
    LAS float* xc = (LAS float*)F.lds;
    LAS bf16_t* xcb = (LAS bf16_t*)(F.lds + 65536);
    for (int idx = F.tid; idx < 64 * 64; idx += NTHR) { const int t = idx >> 6, c4 = (idx & 63) * 4;
        f32x4 acc = *(const f32x4*)(W.convb + c4);
#pragma unroll
        for (int tap = 0; tap < 4; ++tap) { const int tt = t0 + t - 3 + tap; if (tt >= 0) acc += *(const f32x4*)(W.convw + tap * 256 + c4) * ldbf4(ZF + (size_t)(b * SEQ + tt) * 1536 + ZC_XA + c4); }
        *(LAS f32x4*)(xc + t * 256 + c4) = acc; u32x2v w; w.x = pk2(acc[0], acc[1]); w.y = pk2(acc[2], acc[3]); *(LAS u32x2v*)(xcb + t * XCB + c4) = w; }
    if (ck == 127 && F.tid < 256) {
#pragma unroll
        for (int q = 0; q < 3; ++q) out_conv[(b * 3 + q) * 256 + F.tid] = bf2f(ZF[(size_t)(row0 + 61 + q) * 1536 + ZC_XA + F.tid]); }
    WG_SYNC();
    const int lane = F.lane, ti = lane & 15, g = lane >> 4, n = F.wave >> 1, jh = F.wave & 1;
    const bf16_t* LWT = (const bf16_t*)(ws + WS_LRUW) + (size_t)(l * 2) * 4 * 4096 + (size_t)n * 4096;
    f32x4 aa[4][2], ax[4][2];
#pragma unroll
    for (int tt = 0; tt < 4; ++tt)
#pragma unroll
        for (int jt = 0; jt < 2; ++jt) { aa[tt][jt] = (f32x4){0.f, 0.f, 0.f, 0.f}; ax[tt][jt] = (f32x4){0.f, 0.f, 0.f, 0.f}; }
#pragma unroll
    for (int ks = 0; ks < 2; ++ks) { bf16x8 wfa[2], wfx[2], xf[4];
#pragma unroll
        for (int jt = 0; jt < 2; ++jt) { const bf16_t* wp = LWT + (size_t)(32 * jh + 16 * jt + ti) * 64 + 32 * ks + 8 * g; wfa[jt] = *(const bf16x8*)wp; wfx[jt] = *(const bf16x8*)(wp + 4 * 4096); }
#pragma unroll
        for (int tt = 0; tt < 4; ++tt) xf[tt] = *(const LAS bf16x8*)(xcb + (16 * tt + ti) * XCB + n * 64 + 32 * ks + 8 * g);
#pragma unroll
        for (int tt = 0; tt < 4; ++tt)
#pragma unroll
            for (int jt = 0; jt < 2; ++jt) { aa[tt][jt] = __builtin_amdgcn_mfma_f32_16x16x32_bf16(xf[tt], wfa[jt], aa[tt][jt], 0, 0, 0); ax[tt][jt] = __builtin_amdgcn_mfma_f32_16x16x32_bf16(xf[tt], wfx[jt], ax[tt][jt], 0, 0, 0); } }
#pragma unroll
    for (int jt = 0; jt < 2; ++jt) { const int c = n * 64 + 32 * jh + 16 * jt + ti; const float ba = W.ba[c], bx = W.bx[c], sp = 0.6931471805599453f * flog2(1.f + fexp(-W.lam[c]));
        float Ac = 1.f, Hc = 0.f;
#pragma unroll
        for (int tt = 0; tt < 4; ++tt) { float Al[4], Hl[4]; float A = 1.f, H = 0.f;
#pragma unroll
            for (int r = 0; r < 4; ++r) { const int t = 16 * tt + 4 * g + r; const float rg = sigmoidf_(aa[tt][jt][r] + ba), ig = sigmoidf_(ax[tt][jt][r] + bx); const float la = -8.0f * rg * sp, av = fexp(la);
                const float u = fsqrt(1.f - fexp(2.f * la)) * (ig * xc[t * 256 + c]); H = av * H + u; A *= av; Al[r] = A; Hl[r] = H; }
            float Ai = A, Hi = H;
            { const float Ap = bperm_(Ai, lane - 16), Hp = bperm_(Hi, lane - 16); if (g >= 1) { Hi = Ai * Hp + Hi; Ai = Ai * Ap; } }
            { const float Ap = bperm_(Ai, lane - 32), Hp = bperm_(Hi, lane - 32); if (g >= 2) { Hi = Ai * Hp + Hi; Ai = Ai * Ap; } }
            float Ae = bperm_(Ai, lane - 16), He = bperm_(Hi, lane - 16); if (g == 0) { Ae = 1.f; He = 0.f; }
            const float Hin = Ae * Hc + He, Ain = Ae * Ac;
#pragma unroll
            for (int r = 0; r < 4; ++r) { const int t = 16 * tt + 4 * g + r; ACUM[(size_t)(row0 + t) * 256 + c] = Al[r] * Ain; HLOC[(size_t)(row0 + t) * 256 + c] = Al[r] * Hin + Hl[r]; }
            const float At = bperm_(Ai, 48 + ti), Ht = bperm_(Hi, 48 + ti); Hc = At * Hc + Ht; Ac = At * Ac; }
        if (g == 0) { ((float*)(ws + WS_CA))[(size_t)task * 256 + c] = Ac; ((float*)(ws + WS_CH))[(size_t)task * 256 + c] = Hc; } }
    WG_SYNC();
}

constexpr int PH_PRO = 0, PH_MEM = 1, PH_L0 = 2, PH_PER_L = 13, PH_FIN = PH_L0 + NL * PH_PER_L, N_PHASES = PH_FIN + 1;

__device__ __forceinline__ const float* ain(const Args& a, int i) { asm volatile("" : "+s"(i)); return (const float*)(const GAS float*)(unsigned long long)a.in[i]; }
#define AIN(i) ain(a, (i))
#define WSL unsigned long long wsi_ = (unsigned long long)ws0; asm volatile("" : "+s"(wsi_)); unsigned char* ws = (unsigned char*)(GAS unsigned char*)wsi_
__global__ void __launch_bounds__(NTHR, 2) fwd(Args a) {
    extern __shared__ __attribute__((aligned(16))) unsigned char lds_raw[];
    Frame F0; Frame& F = F0;
    F.lds = (LAS unsigned char*)lds_raw;
    F.tid = 0; F.lane = 0; F.wave = __builtin_amdgcn_readfirstlane(threadIdx.x >> 6);
    F.G = gridDim.x; F.wg = blockIdx.x;
    unsigned char* ws0 = a.ws;
    gu32* ctl = (gu32*)(GAS unsigned char*)(unsigned long long)(ws0 + WS_CTL);
    for (int u = threadIdx.x; u < (LDS_BYTES - LDSCTL_OFF) / 4; u += NTHR) ((LAS unsigned*)(F.lds + LDSCTL_OFF))[u] = 0u;
    __syncthreads();
    XcdBarrier bar = xcd_barrier_post((unsigned*)(ctl + CW_BAR), (volatile LAS unsigned*)(F.lds + LDSCTL_OFF + 64));
#define IN(k) true
#ifdef DBGT
    if (blockIdx.x == 0 && threadIdx.x == 0) *(volatile LAS unsigned long long*)(F0.lds + LDSCTL_OFF + 128) = __builtin_amdgcn_s_memrealtime();
#endif
#if defined(DBGT) && DBGT == 4
#define TT0() unsigned long long tt0_ = __builtin_amdgcn_s_memrealtime(); const unsigned long long ttp_ = tt0_
#define TTA(k, wv) do { const unsigned long long t1_ = __builtin_amdgcn_s_memrealtime(); if (F.lane == 0) { if ((k) == 5) { atomicMax((unsigned*)(ctl + CW_DBG + 96 + 3), (unsigned)(t1_ - ttp_)); atomicAdd((unsigned*)(ctl + CW_DBG + 96 + 4), (unsigned)(t1_ - ttp_) >> 5); } \
        else if ((k) >= 2 && (k) <= 4) atomicMax((unsigned*)(ctl + CW_DBG + 96 + (k) - 2), (unsigned)(t1_ - tt0_)); } tt0_ = t1_; } while (0)
#elif defined(DBGT) && DBGT == 3
#define TT0() unsigned long long tt0_ = __builtin_amdgcn_s_memrealtime()
#define TTA(k, wv) do { const unsigned long long t1_ = __builtin_amdgcn_s_memrealtime(); if (blockIdx.x == 0 && F.wave == (wv) && F.lane == 0) atomicAdd((unsigned*)(ctl + CW_DBG + 96 + (k)), (unsigned)(t1_ - tt0_)); tt0_ = t1_; } while (0)
#else
#define TT0() do { } while (0)
#define TTA(k, wv) do { } while (0)
#endif
#ifdef DBGT
#define STAMP(k) do { if (blockIdx.x == 0 && threadIdx.x == 0) { const unsigned long long t_ = __builtin_amdgcn_s_memrealtime(); const int ty_ = (k) < 2 ? (k) : ((k) == PH_FIN ? 15 : 2 + ((k) - 2) % 13); \
        atomicAdd((unsigned*)(ctl + CW_DBG + 64 + ty_), (unsigned)(t_ - *(volatile LAS unsigned long long*)(F0.lds + LDSCTL_OFF + 128))); *(volatile LAS unsigned long long*)(F0.lds + LDSCTL_OFF + 128) = t_; } } while (0)
#else
#define STAMP(k) do { } while (0)
#endif
#define SEAM(k) do { if (IN(k) && IN((k) + 1)) { XcdBarrier b_ = bar; unsigned long long bi_ = (unsigned long long)bar.bar; asm volatile("" : "+s"(bi_), "+s"(b_.x)); b_.bar = (unsigned*)(GAS unsigned*)bi_; xcd_barrier(b_); STAMP(k); } } while (0)
#define FRESH(Fn) Frame Fn = F0; asm volatile("" : "+s"(Fn.wave), "+s"(Fn.G), "+s"(Fn.wg)); Fn.lane = (int)__builtin_amdgcn_mbcnt_hi(~0u, __builtin_amdgcn_mbcnt_lo(~0u, 0u)); asm volatile("" : "+v"(Fn.lane)); Fn.tid = Fn.wave * 64 + Fn.lane

#ifdef DBG
#define OUTL float* OUTS = (float*)(ws + WS_SHADOW); float* XP = OUTS + O_YP; float* XS = OUTS + O_YS; (void)XP; (void)XS
#else
#define OUTL unsigned long long outi_ = (unsigned long long)a.out; asm volatile("" : "+s"(outi_)); float* OUTS = (float*)(GAS float*)outi_; float* XP = OUTS + O_YP; float* XS = OUTS + O_YS; (void)XP; (void)XS
#endif
    if (IN(PH_PRO)) { FRESH(F); WSL; OUTL; p0_prologue(F, a);
        for (int e = F.wg * NTHR + F.tid; e < MS * D / 4; e += F.G * NTHR) ((f32x4*)XS)[e] = ((const f32x4*)AIN(I_XS))[e]; }
    SEAM(PH_PRO);
    if (IN(PH_MEM)) { FRESH(F); WSL;
        pg8::Gemm g{(const bf16_t*)(ws + WS_MEMB), (const bf16_t*)(ws + WS_WKV), D, D, D, 0, 0, 256 * D};
        pg8::StaticOrder S; S.init(512, 8192, F.G, F.G == 256 ? (F.wg >= 128 ? F.wg - 128 : 4096) : F.wg);
        EpiMem E{a.out + O_PMK, a.out + O_PMV, (bf16_t*)(ws + WS_MEMK), (bf16_t*)(ws + WS_MEMVT), (float*)(ws + WS_KMAX)};
        pg8::gemm_phase<EpiMem, pg8::StaticOrder, false, true>(F.lds, g, S, E, F.wave);
        if (F.G != 256) p1_cache_copy(F, a);
    }
    if (F0.G != 256) SEAM(PH_MEM);
#if defined(DBG) && !defined(DBGT)
    if (0 && IN(PH_MEM) && F.wg == F.G - 1) { FRESH(F); WSL;
        for (int i = 0; i < 16; ++i) { const unsigned hsh = (unsigned)(i * 8 + F.wave) * 2654435761u; const int l = hsh & 3, kv = (hsh >> 2) & 1, b = (hsh >> 3) & 1, m = (hsh >> 4) & 255, n = (hsh >> 12) & 1023;
            const float* A = AIN(I_MEMP) + (size_t)(b * 256 + m) * D; const float* W = AIN(kv ? I_XWV : I_XWK) + (size_t)l * D * D + n;
            const float ref = ndot([&](int k) { return A[k]; }, W, D, D, F.lane);
            const float got = (a.out + (kv ? O_PMV : O_PMK))[((size_t)((l * 2 + b) * 256 + m)) * 1024 + n];
            const float gb = kv ? bf2f(((const bf16_t*)(ws + WS_MEMVT))[((size_t)(l * 2 + b) * 1024 + n) * 256 + m]) : bf2f(((const bf16_t*)(ws + WS_MEMK))[((size_t)((l * 2 + b) * 256 + m)) * 1024 + n]);
            if (F.lane == 0) { atomicAdd((float*)(ctl + CW_DBG + 0), (got - ref) * (got - ref)); atomicAdd((float*)(ctl + CW_DBG + 1), ref * ref);
                               atomicAdd((float*)(ctl + CW_DBG + 2), (gb - ref) * (gb - ref)); atomicAdd((float*)(ctl + CW_DBG + 3), ref * ref); } }
    }
#endif
#pragma unroll 1
    for (int l = 0; l < NL; ++l) {
        const int pb = PH_L0 + l * PH_PER_L;
        if (IN(pb + 0)) { FRESH(F); WSL; OUTL; phase_ffn_up(F, ws, (const bf16_t*)(ws + WS_W) + (size_t)l * LW_SZ + LW_1U, XS); }
        SEAM(pb + 0);
#if defined(DBG) && !defined(DBGT)
        if (l == 0 && IN(pb + 0) && F.wg == F.G - 1) { FRESH(F); WSL; OUTL;
            for (int i = 0; i < 8; ++i) { const unsigned hsh = (unsigned)(i * 8 + F.wave + 1) * 2654435761u; int row = (hsh >> 4) % MT; if (i == 7) row = M + (hsh >> 4) % MS; const int c = (hsh >> 19) % FF;
                const float* x = row < M ? AIN(I_XP) + (size_t)row * D : AIN(I_XS) + (size_t)(row - M) * D; const float* gn = AIN(I_NF1);
                const float ss = ndot([&](int k) { return x[k]; }, x, D, 1, F.lane); const float rs = frsq(ss / D + EPS);
                const float gv = ndot([&](int k) { return x[k] * rs * gn[k]; }, AIN(I_F1G) + c, D, FF, F.lane), uv = ndot([&](int k) { return x[k] * rs * gn[k]; }, AIN(I_F1U) + c, D, FF, F.lane);
                const float ref = gv / (1.f + fexp(-gv)) * uv, got = bf2f(((const bf16_t*)(ws + WS_ACT))[(size_t)row * FF + c]);
                if (F.lane == 0) { atomicAdd((float*)(ctl + CW_DBG + 4), (got - ref) * (got - ref)); atomicAdd((float*)(ctl + CW_DBG + 5), ref * ref); } }
        }
#endif
        if (IN(pb + 1)) { FRESH(F); WSL; OUTL; phase_resid(F, ws, (const bf16_t*)(ws + WS_ACT), FF, (const bf16_t*)(ws + WS_W) + (size_t)l * LW_SZ + LW_1D, l == 0 ? AIN(I_XP) : nullptr, XS, 0.5f); }
        SEAM(pb + 1);
#if defined(DBG) && !defined(DBGT)
        if (l == 0 && IN(pb + 1) && F.wg == F.G - 1) { FRESH(F); WSL; OUTL;
            for (int i = 0; i < 8; ++i) { const unsigned hsh = (unsigned)(i * 8 + F.wave + 77) * 2654435761u; int row = (hsh >> 4) % MT; if (i == 7) row = M + (hsh >> 4) % MS; const int n = (hsh >> 19) % D;
                const float xo = row < M ? AIN(I_XP)[(size_t)row * D + n] : AIN(I_XS)[(size_t)(row - M) * D + n]; const bf16_t* ar = (const bf16_t*)(ws + WS_ACT) + (size_t)row * FF;
                const float ref = xo + 0.5f * ndot([&](int k) { return bf2f(ar[k]); }, AIN(I_F1D) + n, FF, D, F.lane);
                const float* xr = row < M ? XP + (size_t)row * D : XS + (size_t)(row - M) * D; const float got = xr[n];
                const float ss = ndot([&](int k) { return xr[k]; }, xr, D, 1, F.lane);
                float sp = 0.f; if (row < M) { if (F.lane < 16) sp = ((const float*)(ws + WS_SSQ))[(size_t)row * 16 + F.lane]; } else sp = ((const float*)(ws + WS_SSQS))[(size_t)(row - M) * 64 + F.lane]; sp = wave_sum(sp);
                const float xbv = bf2f(((const bf16_t*)(ws + WS_XB))[(size_t)row * D + n]);
                if (F.lane == 0) { atomicAdd((float*)(ctl + CW_DBG + 6), (got - ref) * (got - ref) + (xbv - got) * (xbv - got)); atomicAdd((float*)(ctl + CW_DBG + 7), ref * ref);
                                   atomicAdd((float*)(ctl + CW_DBG + 8), (sp - ss) * (sp - ss)); atomicAdd((float*)(ctl + CW_DBG + 9), ss * ss); } }
        }
#endif
        if (IN(pb + 2)) { FRESH(F); WSL; OUTL; phase_win(F, ws, (const bf16_t*)(ws + WS_W) + (size_t)l * LW_SZ + LW_IN, OUTS + O_PSK + (size_t)l * NB * WINDOW * 512, XS); }
        SEAM(pb + 2);
#if defined(DBG) && !defined(DBGT)
        if (l == 0 && IN(pb + 2) && F.wg == F.G - 1) { FRESH(F); WSL; OUTL;
            for (int i = 0; i < 12; ++i) { const unsigned hsh = (unsigned)(i * 8 + F.wave + 177) * 2654435761u; int row = (hsh >> 4) % M; if (i >= 10) row = M + (hsh >> 4) % MS; if (i == 8 || i == 9) row = (row & 8191) | 6144 | (row & 8192 ? 8192 : 0);
                int n = (hsh >> 19) % DIN; if (i == 8) n = 2048 + n % 512; if (i == 9) n = 2560 + n % 512;
                const float* xr = row < M ? XP + (size_t)row * D : XS + (size_t)(row - M) * D; const float* gn = AIN(I_NMIX);
                const float ss = ndot([&](int k) { return xr[k]; }, xr, D, 1, F.lane); const float rs = frsq(ss / D + EPS);
                const float ref = ndot([&](int k) { return xr[k] * rs * gn[k]; }, AIN(I_WIN) + n, D, DIN, F.lane);
                float got, got2 = ref;
                if (row >= M) got = ((const float*)(ws + WS_ZS))[(size_t)(row - M) * DIN + n];
                else if (n < 1536) got = ((const float*)(ws + WS_ZF))[(size_t)row * 1536 + n];
                else { const int gsel = (n - 1536) / 512, c512 = (n - 1536) % 512, h = c512 >> 6, d = c512 & 63, b = row >> 13, t = row & 8191;
                    const bf16_t* src = (const bf16_t*)(ws + (gsel == 0 ? WS_QA : (gsel == 1 ? WS_KA : WS_VA))); got = bf2f(src[((size_t)(b * 8 + h) * SEQ + t) * 64 + d]);
                    if (gsel >= 1 && t >= SEQ - WINDOW) got2 = (OUTS + (gsel == 1 ? O_PSK : O_PSV))[((size_t)(b * WINDOW + t - (SEQ - WINDOW)) * 8 + h) * 64 + d]; }
                if (F.lane == 0) { atomicAdd((float*)(ctl + CW_DBG + 10), (got - ref) * (got - ref) + (got2 - ref) * (got2 - ref)); atomicAdd((float*)(ctl + CW_DBG + 11), ref * ref); } }
        }
#endif
        if (IN(pb + 3)) { FRESH(F); WSL; OUTL; const LruW LW{AIN(I_CONVW) + l * 1024, AIN(I_CONVB) + l * 256, AIN(I_LWA) + (size_t)l * 16384, AIN(I_LBA) + l * 256, AIN(I_LWX) + (size_t)l * 16384, AIN(I_LBX) + l * 256, AIN(I_LAM) + l * 256, AIN(I_GNA) + l * 256};
            const float* LBP = AIN(I_HLB); const float* HNORM = AIN(I_HNORM) + l * 64; bf16_t* Ybuf = (bf16_t*)(ws + WS_Y); float* ZS = (float*)(ws + WS_ZS); (void)LW; (void)LBP; (void)HNORM; (void)Ybuf; (void)ZS;
            TT0();
            for (int task = F.wg; task < 256; task += F.G) lru_local_mfma(F, ws, LW, l, task, OUTS + O_PLC + (size_t)l * NB * 768);
            TTA(0, 3);
            { HgLocPre Pa, Pb; hgrn_local_load(F, ws, F.wg & 1023, Pa);
#pragma unroll 1
              for (int task = F.wg; task < 1024; task += 2 * F.G) { const int n1 = task + F.G, n2 = task + 2 * F.G;
                  hgrn_local_load(F, ws, n1 < 1024 ? n1 : task, Pb); hgrn_local_mfma(F, ws, LBP, l, task, Pa, lc_chunk(AIN(I_CSK), a.out, F.G == 256 ? l * 2048 + F.wg * 8 + (task >> 8) : LC_NCHUNK));
                  if (n1 < 1024) { hgrn_local_load(F, ws, n2 < 1024 ? n2 : n1, Pa); hgrn_local_mfma(F, ws, LBP, l, n1, Pb, lc_chunk(AIN(I_CSK), a.out, F.G == 256 ? l * 2048 + F.wg * 8 + (n1 >> 8) : LC_NCHUNK)); } } }
            TTA(1, 3);
            for (int s = F.G - 1 - F.wg; s < 160; s += F.G) {
                if (s < 32) lru_seq<0>(F, LW, ZS + (size_t)s * 4 * DIN, DIN, 4, AIN(I_SLC) + (size_t)(l * 32 + s) * 768, AIN(I_SLH) + (size_t)(l * 32 + s) * 256, Ybuf + (size_t)(M + s * 4) * D,
                                       OUTS + O_SLH + (size_t)(l * 32 + s) * 256, OUTS + O_SLC + (size_t)(l * 32 + s) * 768, ctl, 0);
                else { const int sb = (s - 32) >> 2, hh = (s - 32) & 3; const size_t so = ((size_t)(l * 32 + sb) * 4 + hh) * 4096;
                    hgrn_seq<0>(F, LBP, HNORM, l, hh, ZS + (size_t)sb * 4 * DIN, DIN, 4, AIN(I_SHG) + so, Ybuf + (size_t)(M + sb * 4) * D, OUTS + O_SHG + so, ctl, 0); }
            }
        }
        SEAM(pb + 3);
        if (IN(pb + 4)) { FRESH(F); WSL; OUTL; const LruW LW{AIN(I_CONVW) + l * 1024, AIN(I_CONVB) + l * 256, AIN(I_LWA) + (size_t)l * 16384, AIN(I_LBA) + l * 256, AIN(I_LWX) + (size_t)l * 16384, AIN(I_LBX) + l * 256, AIN(I_LAM) + l * 256, AIN(I_GNA) + l * 256};
            const float* LBP = AIN(I_HLB); const float* HNORM = AIN(I_HNORM) + l * 64; bf16_t* Ybuf = (bf16_t*)(ws + WS_Y); float* ZS = (float*)(ws + WS_ZS); (void)LW; (void)LBP; (void)HNORM; (void)Ybuf; (void)ZS;
            if (F.tid == 0) { *(volatile LAS unsigned*)(F.lds + LDSCTL_OFF + 192) = 0u; *(volatile LAS unsigned*)(F.lds + LDSCTL_OFF + 196) = 0u; }
            WG_SYNC();
            TT0();
            if (F.wave < 2) { for (int chain = F.wg * 2 + F.wave; chain < 512; chain += F.G * 2) { const int bh = chain >> 6, dr = chain & 63; float S = 0.f;
                    const float* KV = (const float*)(ws + WS_HKV) + (size_t)bh * 128 * 4096 + dr * 64 + F.lane; const float* DEC = (const float*)(ws + WS_HDEC) + (size_t)bh * 128 * 64 + dr; float* SP = (float*)(ws + WS_HSP) + (size_t)bh * 128 * 4096 + dr * 64 + F.lane;
#pragma unroll 1
                    for (int cb = 0; cb < 128; cb += 16) { float kvv[16], dcv[16];
#pragma unroll
                        for (int i = 0; i < 16; ++i) { kvv[i] = KV[(size_t)(cb + i) * 4096]; dcv[i] = DEC[(cb + i) * 64]; }
#pragma unroll
                        for (int i = 0; i < 16; ++i) { SP[(size_t)(cb + i) * 4096] = S; S = dcv[i] * S + kvv[i]; } }
                    (OUTS + O_PHG)[((size_t)(l * 8 + bh)) * 4096 + dr * 64 + F.lane] = S; } TTA(2, 0); }
            else if (F.wave == 2) { for (int t = F.wg; t < 8; t += F.G) { const int b = t >> 2, ch = (t & 3) * 64 + F.lane; float hc = 0.f;
                    const float* CA = (const float*)(ws + WS_CA) + (size_t)b * 128 * 256 + ch; const float* CH = (const float*)(ws + WS_CH) + (size_t)b * 128 * 256 + ch; float* HIN = (float*)(ws + WS_HIN) + (size_t)b * 128 * 256 + ch;
#pragma unroll 1
                    for (int cb = 0; cb < 128; cb += 16) { float cav[16], chv[16];
#pragma unroll
                        for (int i = 0; i < 16; ++i) { cav[i] = CA[(cb + i) * 256]; chv[i] = CH[(cb + i) * 256]; }
#pragma unroll
                        for (int i = 0; i < 16; ++i) { HIN[(cb + i) * 256] = hc; hc = cav[i] * hc + chv[i]; } }
                    (OUTS + O_PLH)[(l * 2 + b) * 256 + ch] = hc; } }
            { volatile LAS unsigned* qctr = (volatile LAS unsigned*)(F.lds + LDSCTL_OFF + 192);
              const bool g256 = F.G == 256;
              const int nunits = (512 - F.wg + F.G - 1) / F.G, nsamp = (1024 - F.wg + F.G - 1) / F.G, nq1 = g256 ? 6 : nunits * 4, n1 = nsamp + nq1;
              int stage = 1;
              for (;;) { Frame Ft = F; asm volatile("" : "+v"(Ft.lane)); Ft.tid = Ft.wave * 64 + Ft.lane;
                  int kind = -1, ta = 0, tb = 0;
                  if (stage == 1) { unsigned id = 0; if (Ft.lane == 0) id = atomicAdd((unsigned*)qctr, 1u); id = __builtin_amdgcn_readfirstlane(id);
                      if ((int)id < nsamp) { kind = 0; ta = g256 ? F.wg + (int)id * F.G : F.wg + (int)id * F.G; }
                      else if ((int)id < n1) { const int id2 = (int)id - nsamp; kind = 1;
                          if (g256) { const int uk = id2 / 3; ta = ((F.wg & 7) + 8 * uk) * 32 + (F.wg >> 3); tb = id2 % 3; } else { ta = F.wg + (id2 >> 2) * F.G; tb = id2 & 3; } }
                      else stage = g256 ? 2 : 5; }
                  if (stage == 2) { unsigned id = 0; if (Ft.lane == 0) id = atomicAdd((unsigned*)(ctl + CW_XQ + 64 * (l * 8 + (F.wg & 7))), 1u); id = __builtin_amdgcn_readfirstlane(id);
                      if (id < 64u) { kind = 1; ta = ((F.wg & 7) + 8 * (int)(id & 1u)) * 32 + (int)(id >> 1); tb = 3; } else stage = 3; }
                  if (stage == 3) { unsigned id = 0; if (Ft.lane == 0) id = atomicAdd((unsigned*)(qctr + 1), 1u); id = __builtin_amdgcn_readfirstlane(id);
                      if (id < 7u) { kind = 2; ta = 3584 + l * 3200 + F.wg + 256 * (int)id; } else stage = 4; }
                  if (stage == 4) { unsigned id = 0; if (Ft.lane == 0) id = atomicAdd((unsigned*)(ctl + CW_CPQ + 64 * l), 1u); id = __builtin_amdgcn_readfirstlane(id);
                      if (id < 1408u) { kind = 2; ta = 3584 + l * 3200 + 1792 + (int)id; } else stage = 5; }
                  if (kind < 0) { if (stage >= 5) break; continue; }
                  if (kind == 2) cache_copy_block_wave(Ft.lane, AIN(I_CSK), AIN(I_CSV), a.out, ta);
                  else if (kind == 1) { const int b = ta >> 8, h = (ta >> 5) & 7, P = ta & 31; attn_wave_task4(Ft, ws, b, h, P, tb, F.lds + F.wave * ATT_WAVE_LDS); TTA(3, 3); }
                  else { const int sid = ta; const int t = sid & 3, h = (sid >> 2) & 7, sb = sid >> 5, row = sb * 4 + t, part = Ft.lane & 3;
                      float q[16], o[16];
#pragma unroll
                      for (int i = 0; i < 16; ++i) q[i] = ZS[(size_t)row * DIN + ZC_QC + h * 64 + part * 16 + i];
                      KVDecode kv{AIN(I_CSK) + (size_t)(l * 32 + sb) * WINDOW * 512, AIN(I_CSV) + (size_t)(l * 32 + sb) * WINDOW * 512, ZS + (size_t)sb * 4 * DIN, h};
                      attn_naive(kv, q, WINDOW + t, h, Ft.lane, o);
                      if (Ft.lane < 4) { float* yc = (float*)(ws + WS_YC) + (size_t)(M + row) * 512 + h * 64 + part * 16;
#pragma unroll
                          for (int i = 0; i < 16; ++i) yc[i] = o[i]; } TTA(4, 3); } }
              TTA(5, 3); }
            { FRESH(Fe);
            for (int e = Fe.wg * NTHR + Fe.tid; e < MS * 256; e += Fe.G * NTHR) { const int row = e >> 8, c4 = (e & 255) * 4, kvs = c4 >> 9, cc = c4 & 511, sb = row >> 2, t = row & 3;
                *(f32x4*)(a.out + (kvs ? O_SSV : O_SSK) + ((size_t)(l * 32 + sb) * WINDOW + (WINDOW - STOK) + t) * 512 + cc) = *(const f32x4*)(ZS + (size_t)row * DIN + ZC_KC + kvs * 512 + cc); } }
        }
        SEAM(pb + 4);
        if (IN(pb + 5)) { FRESH(F); WSL; OUTL; const LruW LW{AIN(I_CONVW) + l * 1024, AIN(I_CONVB) + l * 256, AIN(I_LWA) + (size_t)l * 16384, AIN(I_LBA) + l * 256, AIN(I_LWX) + (size_t)l * 16384, AIN(I_LBX) + l * 256, AIN(I_LAM) + l * 256, AIN(I_GNA) + l * 256};
            const float* LBP = AIN(I_HLB); const float* HNORM = AIN(I_HNORM) + l * 64; bf16_t* Ybuf = (bf16_t*)(ws + WS_Y); float* ZS = (float*)(ws + WS_ZS); (void)LW; (void)LBP; (void)HNORM; (void)Ybuf; (void)ZS;
            TT0();
            { HgOutPre Pa, Pb; hgrn_out_load(F, ws, F.wg & 1023, Pa);
#pragma unroll 1
              for (int task = F.wg; task < 1024; task += 2 * F.G) { const int n1 = task + F.G, n2 = task + 2 * F.G;
                  hgrn_out_load(F, ws, n1 < 1024 ? n1 : task, Pb); hgrn_out_mfma(F, ws, LBP, HNORM, l, task, Pa, lc_chunk(AIN(I_CSK), a.out, F.G == 256 ? l * 2048 + F.wg * 8 + 4 + (task >> 8) : LC_NCHUNK));
                  if (n1 < 1024) { hgrn_out_load(F, ws, n2 < 1024 ? n2 : n1, Pa); hgrn_out_mfma(F, ws, LBP, HNORM, l, n1, Pb, lc_chunk(AIN(I_CSK), a.out, F.G == 256 ? l * 2048 + F.wg * 8 + 4 + (n1 >> 8) : LC_NCHUNK)); } } }
            TTA(6, 3);
            const float* GNC = AIN(I_GNC) + l * 512; const bf16_t* ZF = (const bf16_t*)(ws + WS_ZF);
            { const int NROWW = F.G * NWAVES, gw = F.wg * NWAVES + F.wave, c4 = 4 * F.lane;
              const f32x4 gn = *(const f32x4*)(LW.gna + c4), g0 = *(const f32x4*)(GNC + 8 * F.lane), g1 = *(const f32x4*)(GNC + 8 * F.lane + 4);
#pragma unroll 1
              for (int rb = gw; rb < M; rb += 4 * NROWW) {
                  f32x4 ac[4], hl[4], hi[4], ga[4], y0[4], y1[4];
#pragma unroll
                  for (int i = 0; i < 4; ++i) { const int rr = rb + i * NROWW, row = rr < M ? rr : M - 1; const int b = row >> 13, ck = (row & 8191) >> 6;
                      ac[i] = *(const f32x4*)((const float*)(ws + WS_ACUM) + (size_t)row * 256 + c4); hl[i] = *(const f32x4*)((const float*)(ws + WS_HLOC) + (size_t)row * 256 + c4);
                      hi[i] = *(const f32x4*)((const float*)(ws + WS_HIN) + (size_t)(b * 128 + ck) * 256 + c4); ga[i] = ldbf4(ZF + (size_t)row * 1536 + ZC_GA + c4);
                      const float* yc = (const float*)(ws + WS_YC) + (size_t)row * 512 + 8 * F.lane; y0[i] = *(const f32x4*)yc; y1[i] = *(const f32x4*)(yc + 4); }
#pragma unroll
                  for (int i = 0; i < 4; ++i) { const int row = rb + i * NROWW; f32x4 y; float ss = 0.f;
#pragma unroll
                      for (int e = 0; e < 4; ++e) { y[e] = (ac[i][e] * hi[i][e] + hl[i][e]) * gelu_tanh(ga[i][e]); ss += y[e] * y[e]; }
                      ss = wave_sum(ss); const float rs = frsq(ss * (1.f / 256.f) + EPS);
                      const float s2 = wave_sum(sq4(y0[i]) + sq4(y1[i])); const float r2 = frsq(s2 * (1.f / 512.f) + EPS);
                      if (row < M) { u32x2v w; w.x = pk2(y[0] * rs * gn[0], y[1] * rs * gn[1]); w.y = pk2(y[2] * rs * gn[2], y[3] * rs * gn[3]); *(u32x2v*)(Ybuf + (size_t)row * D + c4) = w;
                          *(u32x4*)(Ybuf + (size_t)row * D + 512 + 8 * F.lane) = pack8(y0[i] * g0 * r2, y1[i] * g1 * r2); } } }
              for (int row = M + gw; row < MT; row += NROWW) { const float* yc = (const float*)(ws + WS_YC) + (size_t)row * 512 + 8 * F.lane; const f32x4 v0 = *(const f32x4*)yc, v1 = *(const f32x4*)(yc + 4);
                  const float ss = wave_sum(sq4(v0) + sq4(v1)); const float rs = frsq(ss * (1.f / 512.f) + EPS);
                  *(u32x4*)(Ybuf + (size_t)row * D + 512 + 8 * F.lane) = pack8(v0 * g0 * rs, v1 * g1 * rs); } }
            TTA(7, 3);
        }
        SEAM(pb + 5);
#if defined(DBG) && !defined(DBGT)
        if (l == 0 && IN(pb + 5)) { FRESH(F); WSL; OUTL; const LruW LW{AIN(I_CONVW) + l * 1024, AIN(I_CONVB) + l * 256, AIN(I_LWA) + (size_t)l * 16384, AIN(I_LBA) + l * 256, AIN(I_LWX) + (size_t)l * 16384, AIN(I_LBX) + l * 256, AIN(I_LAM) + l * 256, AIN(I_GNA) + l * 256};
            const float* LBP = AIN(I_HLB); const float* HNORM = AIN(I_HNORM) + l * 64; bf16_t* Ybuf = (bf16_t*)(ws + WS_Y); float* ZS = (float*)(ws + WS_ZS); (void)LW; (void)LBP; (void)HNORM; (void)Ybuf; (void)ZS;
            if (F.wg == F.G - 1) lru_seq<1>(F, LW, (const float*)(ws + WS_ZF) + (size_t)SEQ * 1536, 1536, 136, nullptr, nullptr, Ybuf + (size_t)SEQ * D, nullptr, nullptr, ctl, 6);
            if (F.wg == F.G - 2) hgrn_seq<1>(F, LBP, HNORM, l, 2, (const float*)(ws + WS_ZF) + (size_t)SEQ * 1536, 1536, 136, nullptr, Ybuf + (size_t)SEQ * D, nullptr, ctl, 7);
            if (F.wg == F.G - 3) { for (int i = 0; i < 6; ++i) { const unsigned hsh = (unsigned)(i * 8 + F.wave + 301) * 2654435761u; const int b = (hsh >> 3) & 1, h = (hsh >> 4) & 7; int pos = (hsh >> 8) % SEQ; if (i == 0) pos = (hsh >> 8) % 100; if (i == 1) pos = 128 + (hsh >> 8) % 1900;
                    const int part = F.lane & 3; float q[16], o[16];
                    const bf16_t* qp = (const bf16_t*)(ws + WS_QA) + ((size_t)(b * 8 + h) * SEQ + pos) * 64 + part * 16;
#pragma unroll
                    for (int e = 0; e < 16; ++e) q[e] = bf2f(qp[e]);
                    KVPrompt kv{(const bf16_t*)(ws + WS_KA) + (size_t)(b * 8 + h) * SEQ * 64, (const bf16_t*)(ws + WS_VA) + (size_t)(b * 8 + h) * SEQ * 64};
                    attn_naive(kv, q, pos, h, F.lane, o);
                    float dn = 0.f, dd = 0.f; if (F.lane < 4) { const float* yc = (const float*)(ws + WS_YC) + (size_t)(b * SEQ + pos) * 512 + h * 64 + part * 16;
#pragma unroll
                        for (int e = 0; e < 16; ++e) { dn += (yc[e] - o[e]) * (yc[e] - o[e]); dd += o[e] * o[e]; } }
                    dbg_acc(ctl, 8, dn, dd, F.lane); } }
        }
#endif
        if (IN(pb + 6)) { FRESH(F); WSL; OUTL; { const int e = F.wg * NTHR + F.tid; float z0 = 0.f; asm volatile("" : "+v"(z0)); if (e < MS * D / 4) ((f32x4*)(ws + WS_QXS))[e] = (f32x4){z0, z0, z0, z0}; }
            phase_resid(F, ws, (const bf16_t*)(ws + WS_Y), D, (const bf16_t*)(ws + WS_W) + (size_t)l * LW_SZ + LW_OUT, nullptr, XS, 1.0f); }
        SEAM(pb + 6);
        if (IN(pb + 7)) { FRESH(F); WSL; OUTL; const bf16_t* LWb = (const bf16_t*)(ws + WS_W) + (size_t)l * LW_SZ;
            bf16_t* XB = (bf16_t*)(ws + WS_XB); bf16_t* QX = (bf16_t*)(ws + WS_QX);
            pg8::Gemm g{XB, LWb + LW_Q, D, D, D, 0, 0, 256 * D}; pg8::StaticOrder S; S.init(M, D, F.G, F.wg);
            EpiQx E{QX, (float*)(ws + WS_QSS), (const float*)(ws + WS_SSQ)};
            pg8::gemm_phase<EpiQx, pg8::StaticOrder, false, true>(F.lds, g, S, E, F.wave);
            int lane = F.lane; asm volatile("" : "+v"(lane));
            for (int t = F.wg; t < 256; t += F.G) { const int n0 = 16 * (t >> 2), k0 = 256 * (t & 3);
                const f32x4 ac = slab_f32a_q(XS + k0, LWb + LW_Q + (size_t)n0 * D + k0, F.wave, lane);
                float* qp = (float*)(ws + WS_QXS) + (size_t)(16 * F.wave + (lane & 15)) * D + n0 + 4 * (lane >> 4);
#pragma unroll
                for (int e = 0; e < 4; ++e) atomicAdd(qp + e, ac[e]); }
        }
        SEAM(pb + 7);
        if (IN(pb + 8)) { FRESH(F); WSL; OUTL;
            pg8::Gemm g{(const bf16_t*)(ws + WS_QX), (const bf16_t*)(ws + WS_MEMK) + (size_t)l * 2 * 256 * 1024, D, D, 256, 256, 256 * 1024, 256}; pg8::StaticOrder S; S.init(M, D, F.G, F.wg);
            EpiS E{(bf16_t*)(ws + WS_PB), (float*)(ws + WS_LS), (const float*)(ws + WS_QSS), (const float*)(ws + WS_KMAX) + l * 64};
            pg8::gemm_phase<EpiS, pg8::StaticOrder, false, true>(F.lds, g, S, E, F.wave);
            asm volatile("s_waitcnt vmcnt(0)" ::: "memory"); __syncthreads();
            { pg8::Gemm g2{(const bf16_t*)(ws + WS_PB), (const bf16_t*)(ws + WS_MEMVT) + (size_t)l * 2 * 1024 * 256, D, 256, 256, 256, 1024 * 256, 256 * 256}; pg8::StaticOrder S2; S2.init(M, D, F.G, F.wg);
              EpiPV E2{(bf16_t*)(ws + WS_OB), (const float*)(ws + WS_LS)};
              pg8::gemm_phase<EpiPV, pg8::StaticOrder, false, true>(F.lds, g2, S2, E2, F.wave); }
            FRESH(F2);
            for (int s = F.G - 1 - F.wg; s < 128; s += F.G) xattn_sample(F2, ws, AIN(I_CMK) + (size_t)l * 32 * 256 * 1024, AIN(I_CMV) + (size_t)l * 32 * 256 * 1024, s >> 2, s & 3, XS);
        }
        SEAM(pb + 9);
#if defined(DBG) && !defined(DBGT)
        if (l == 0 && IN(pb + 9) && F.wg == F.G - 1) { FRESH(F); WSL; OUTL;
            for (int i = 0; i < 6; ++i) { const unsigned hsh = (unsigned)(i * 8 + F.wave + 501) * 2654435761u; int row = (hsh >> 4) % M; if (i == 5) row = M + (hsh >> 4) % MS; const int h = (hsh >> 19) & 3, d = (hsh >> 21) & 255;
                const bf16_t* qr = (const bf16_t*)(ws + WS_QX) + (size_t)row * D + h * 256; float sv[4], mx = -INFINITY;
                for (int e = 0; e < 4; ++e) { const int m = F.lane * 4 + e; float s = 0.f;
                    if (row < M) { const bf16_t* kr = (const bf16_t*)(ws + WS_MEMK) + ((size_t)(l * 2 + (row >> 13)) * 256 + m) * 1024 + h * 256; for (int k = 0; k < 256; ++k) s += bf2f(qr[k]) * bf2f(kr[k]); }
                    else { const float* kr = AIN(I_CMK) + (((size_t)(l * 32 + ((row - M) >> 2)) * 256 + m) * 4 + h) * 256; for (int k = 0; k < 256; ++k) s += bf2f(qr[k]) * kr[k]; }
                    sv[e] = s / 16.f; mx = fmaxf(mx, sv[e]); }
                mx = wave_max(mx); float ps = 0.f, o = 0.f;
                for (int e = 0; e < 4; ++e) { const int m = F.lane * 4 + e; const float p = fexp(sv[e] - mx); ps += p;
                    const float v = row < M ? bf2f(((const bf16_t*)(ws + WS_MEMVT))[((size_t)(l * 2 + (row >> 13)) * 1024 + h * 256 + d) * 256 + m]) : AIN(I_CMV)[(((size_t)(l * 32 + ((row - M) >> 2)) * 256 + m) * 4 + h) * 256 + d];
                    o += p * v; }
                ps = wave_sum(ps); o = wave_sum(o) / ps; const float got = bf2f(((const bf16_t*)(ws + WS_OB))[(size_t)row * D + h * 256 + d]);
                const int n = (hsh >> 9) & 1023; const float* xr = row < M ? XP + (size_t)row * D : XS + (size_t)(row - M) * D; const float* gn = AIN(I_NCROSS);
                const float ss = ndot([&](int k) { return xr[k]; }, xr, D, 1, F.lane); const float rs = frsq(ss / D + EPS);
                const float qref = ndot([&](int k) { return xr[k] * rs * gn[k]; }, AIN(I_XWQ) + n, D, D, F.lane), qgot = bf2f(((const bf16_t*)(ws + WS_QX))[(size_t)row * D + n]);
                if (F.lane == 0) { atomicAdd((float*)(ctl + CW_DBG + 0), (got - o) * (got - o)); atomicAdd((float*)(ctl + CW_DBG + 1), o * o);
                                   atomicAdd((float*)(ctl + CW_DBG + 2), (qgot - qref) * (qgot - qref)); atomicAdd((float*)(ctl + CW_DBG + 3), qref * qref); } }
        }
#endif
        if (IN(pb + 10)) { FRESH(F); WSL; OUTL; phase_resid(F, ws, (const bf16_t*)(ws + WS_OB), D, (const bf16_t*)(ws + WS_W) + (size_t)l * LW_SZ + LW_O, nullptr, XS, 1.0f); }
        SEAM(pb + 10);
        if (IN(pb + 11)) { FRESH(F); WSL; OUTL; phase_ffn_up(F, ws, (const bf16_t*)(ws + WS_W) + (size_t)l * LW_SZ + LW_2U, XS); }
        SEAM(pb + 11);
        if (IN(pb + 12)) { FRESH(F); WSL; OUTL; phase_resid(F, ws, (const bf16_t*)(ws + WS_ACT), FF, (const bf16_t*)(ws + WS_W) + (size_t)l * LW_SZ + LW_2D, nullptr, XS, 0.5f); }
        SEAM(pb + 12);
    }
    if (IN(PH_FIN)) { FRESH(F); WSL; OUTL;
        const float* NF = AIN(I_NFIN);
        for (int row = F.wg * NWAVES + F.wave; row < MT; row += F.G * NWAVES) {
            float* xr = row < M ? XP + (size_t)row * D : XS + (size_t)(row - M) * D;
            f32x4 xv[4]; float ss = 0.f;
            if (row < M) { const u32x2v* hp = (const u32x2v*)((const bf16_t*)(ws + WS_XB) + (size_t)row * D) + F.lane; const u32x2v* lp = (const u32x2v*)((const bf16_t*)(ws + WS_XL) + (size_t)row * D) + F.lane;
#pragma unroll
                for (int jj = 0; jj < 4; ++jj) { const u32x2v hw = hp[64 * jj], lw = RESID_PAIR ? lp[64 * jj] : (u32x2v){0u, 0u};
                    xv[jj][0] = __builtin_bit_cast(float, hw.x << 16) + __builtin_bit_cast(float, lw.x << 16); xv[jj][1] = __builtin_bit_cast(float, hw.x & 0xffff0000u) + __builtin_bit_cast(float, lw.x & 0xffff0000u);
                    xv[jj][2] = __builtin_bit_cast(float, hw.y << 16) + __builtin_bit_cast(float, lw.y << 16); xv[jj][3] = __builtin_bit_cast(float, hw.y & 0xffff0000u) + __builtin_bit_cast(float, lw.y & 0xffff0000u); ss += sq4(xv[jj]); }
            } else {
#pragma unroll
                for (int jj = 0; jj < 4; ++jj) { xv[jj] = *((const f32x4*)xr + F.lane + 64 * jj); ss += sq4(xv[jj]); } }
            ss = wave_sum(ss); const float rs = frsq(ss * (1.0f / D) + EPS);
#pragma unroll
            for (int jj = 0; jj < 4; ++jj) { const f32x4 g = *((const f32x4*)NF + F.lane + 64 * jj); *((f32x4*)xr + F.lane + 64 * jj) = xv[jj] * g * rs; } }
    }
#ifdef DBG
    __syncthreads(); { XcdBarrier b_ = bar; unsigned long long bi_ = (unsigned long long)bar.bar; asm volatile("" : "+s"(bi_), "+s"(b_.x)); b_.bar = (unsigned*)(GAS unsigned*)bi_; xcd_barrier(b_); STAMP(PH_FIN); }
    __syncthreads(); { XcdBarrier b_ = bar; unsigned long long bi_ = (unsigned long long)bar.bar; asm volatile("" : "+s"(bi_), "+s"(b_.x)); b_.bar = (unsigned*)(GAS unsigned*)bi_; xcd_barrier(b_); }
    { FRESH(Fd); dbg_finish(Fd, a, ctl); }
#endif
#undef IN
#undef SEAM
}

extern "C" void kernel_launch(void* const* d_in, const int* in_sizes, int n_in, void* d_out, int out_size, void* d_ws, size_t ws_size, hipStream_t stream) {
    static int grid = 0;
    if (grid == 0) {
        if (n_in != N_IN || (size_t)out_size != O_END || ws_size < WS_TOTAL) { fprintf(stderr, "kernel_launch: unexpected shapes: n_in %d out %d ws %zu (need %zu)\n", n_in, out_size, ws_size, (size_t)WS_TOTAL); grid = -1; return; }
        int dev = 0, cus = 0, per_cu = 0;
        if (hipGetDevice(&dev) != hipSuccess || hipDeviceGetAttribute(&cus, hipDeviceAttributeMultiprocessorCount, dev) != hipSuccess) { grid = -1; return; }
        if (hipFuncSetAttribute((const void*)fwd, hipFuncAttributeMaxDynamicSharedMemorySize, LDS_BYTES) != hipSuccess) { fprintf(stderr, "kernel_launch: hipFuncSetAttribute failed\n"); grid = -1; return; }
        if (hipOccupancyMaxActiveBlocksPerMultiprocessor(&per_cu, (const void*)fwd, NTHR, LDS_BYTES) != hipSuccess || per_cu < 1) { fprintf(stderr, "kernel_launch: occupancy query says %d\n", per_cu); }
        (void)hipGetLastError();
        grid = cus;
    }
    if (grid < 0) return;
    (void)in_sizes;
    if (hipMemsetAsync((char*)d_ws + WS_CTL, 0, CTL_BYTES, stream) != hipSuccess) return;
    Args a{};
    for (int i = 0; i < N_IN; ++i) a.in[i] = (const float*)d_in[i];
    a.out = (float*)d_out; a.ws = (unsigned char*)d_ws; a.ph_lo = 0; a.ph_hi = N_PHASES;
    hipLaunchKernelGGL(fwd, dim3(grid), dim3(NTHR), LDS_BYTES, stream, a);
}
```

```cpp
#include <hip/hip_runtime.h>
#include <cstdio>
#include <cstdint>
namespace pg8 {
#define PG8_LAS __attribute__((address_space(3)))
typedef unsigned short bf16_t;
typedef short bf16x8 __attribute__((ext_vector_type(8)));
typedef float f32x4 __attribute__((ext_vector_type(4)));
typedef unsigned u32x4 __attribute__((ext_vector_type(4)));
constexpr int BM = 256, BK = 64, HALF = 128, HTB = HALF * BK * 2  , STAGE_BYTES = 8 * HTB, NXCD = 8, WGM = 8;

__host__ __device__ __forceinline__ int lds_byte(int r, int c) { const int st = (r >> 4) * 2 + (c >> 5), rr = r & 15, cc = c & 31, ob = rr * 64 + cc * 2; return st * 1024 + (ob ^ (((ob >> 9) & 1) << 5)); }
__host__ __device__ __forceinline__ void stage_rc(int b, int& R, int& C) { const int st = b / 1024, sb = b % 1024, swz = sb ^ (((sb >> 9) & 1) << 5); R = (st >> 1) * 16 + swz / 64; C = (st & 1) * 32 + (swz % 64) / 2; }
__host__ __device__ __forceinline__ int perm32(int rho) { const int n = rho >> 4, i = rho & 15; return 8 * (i >> 2) + 4 * n + (i & 3); }

struct Unit { int pm, pn; };
struct Gemm { const bf16_t* A; const bf16_t* Bt; int lda, ldb, K; int acs; int bbs, bps;
    __device__ __forceinline__ const char* aptr(const Unit& u) const { return (const char*)(A + (size_t)u.pm * 256 * lda + (size_t)u.pn * acs); }
    __device__ __forceinline__ const char* bptr(const Unit& u) const { return (const char*)(Bt + (size_t)(u.pm >> 5) * bbs + (size_t)u.pn * bps); } };

struct StaticOrder {
    int nM, nN, nwg, G, c;
    __host__ __device__ void init(int M, int N, int G_, int c_) { nM = M / BM; nN = N / BM; nwg = nM * nN; G = G_; c = c_; }
    __host__ __device__ bool next(int i, Unit& u) const {
        const long L = (long)i * G + c; if (L >= nwg) return false;
        int wgid = (int)L; { const int q = nwg / NXCD, r = nwg % NXCD, xcd = wgid % NXCD, off = wgid / NXCD; wgid = (xcd < r ? xcd * (q + 1) : r * (q + 1) + (xcd - r) * q) + off; }
        const int nig = WGM * nN, gid = wgid / nig, fm = gid * WGM, gsz = (nM - fm) < WGM ? (nM - fm) : WGM;
        u.pm = fm + ((wgid % nig) % gsz); u.pn = (wgid % nig) / gsz; return true;
    }
    __device__ __forceinline__ void a_ready(const Unit&) const {}
    __device__ __forceinline__ void done(const Unit&) const {}
};

__device__ __forceinline__ unsigned cvt_pk_bf16(float lo, float hi) { unsigned r; asm volatile("v_cvt_pk_bf16_f32 %0, %1, %2" : "=v"(r) : "v"(lo), "v"(hi)); return r; }
typedef float f32x2 __attribute__((ext_vector_type(2)));
template <class Epi, class Sched, bool ALIGN_EPI = false, bool SP2 = false>
__device__ __forceinline__ void gemm_phase(PG8_LAS unsigned char* lds, const Gemm g, const Sched& S, const Epi& E, int wave_in  ) {
    int wv_ = wave_in; asm volatile("" : "+s"(wv_));
    int lane_ = (int)__builtin_amdgcn_mbcnt_hi(~0u, __builtin_amdgcn_mbcnt_lo(~0u, 0u)); asm volatile("" : "+v"(lane_)); const int lane = lane_;
    const int wid = wv_, tid = wid * 64 + lane, wr = wid >> 2, wc = wid & 3, fr = lane & 15, fq = lane >> 4;
    int K_ = g.K; asm volatile("" : "+s"(K_)); const int K = K_, nt = K / BK, lda = g.lda, ldb = g.ldb;
    unsigned voffA[2], voffB[2];
#pragma unroll
    for (int i = 0; i < 2; ++i) { int R, C; stage_rc(tid * 16 + i * 8192, R, C); const int Rb = Epi::PERM ? ((R & ~31) + perm32(R & 31)) : R;
        voffA[i] = (unsigned)(R * lda + C) * 2u; voffB[i] = (unsigned)(Rb * ldb + C) * 2u; }
    const size_t kstep = (size_t)(BK * 2);
    const size_t hstepA = (size_t)HALF * lda * 2, hstepB = (size_t)HALF * ldb * 2;
    const unsigned ldsw = (unsigned)wid * 1024u;
    const int aoff = lds_byte(wr * 64 + fr, fq * 8), boff = lds_byte(wc * 32 + fr, fq * 8);
#define PG8_SA(b, h) (((b) * 2 + (h)) * HTB)
#define PG8_SB(b, h) ((4 + (b) * 2 + (h)) * HTB)
#define PG8_STAGE(bufoff, gbase, voff) do { _Pragma("unroll") for (int _i = 0; _i < 2; ++_i) \
        __builtin_amdgcn_global_load_lds((const unsigned*)((const char*)(gbase) + (voff)[_i]), (PG8_LAS unsigned*)(lds + (bufoff) + ldsw + _i * 8192), 16, 0, 0); } while (0)
#define PG8_LDA(dst, b, h) do { _Pragma("unroll") for (int m = 0; m < 4; ++m) _Pragma("unroll") for (int k = 0; k < 2; ++k) dst[m][k] = *(const PG8_LAS bf16x8*)(lds + PG8_SA(b, h) + aoff + m * 2048 + k * 1024); } while (0)
#define PG8_LDB(dst, b, h) do { _Pragma("unroll") for (int n = 0; n < 2; ++n) _Pragma("unroll") for (int k = 0; k < 2; ++k) dst[n][k] = *(const PG8_LAS bf16x8*)(lds + PG8_SB(b, h) + boff + n * 2048 + k * 1024); } while (0)
#define PG8_MMA(ai, bj, At, Bt) do { __builtin_amdgcn_s_setprio(1); _Pragma("unroll") for (int m = 0; m < 4; ++m) _Pragma("unroll") for (int n = 0; n < 2; ++n) _Pragma("unroll") for (int k = 0; k < 2; ++k) \
        acc[ai][bj][m][n] = __builtin_amdgcn_mfma_f32_16x16x32_bf16(Bt[n][k], At[m][k], acc[ai][bj][m][n], 0, 0, 0); __builtin_amdgcn_s_setprio(0); } while (0)
#define PG8_WAIT_V(n) asm volatile("s_waitcnt vmcnt(" #n ")" ::: "memory")
#define PG8_WAIT_L(n) asm volatile("s_waitcnt lgkmcnt(" #n ")" ::: "memory")
#define PG8_BAR __builtin_amdgcn_s_barrier()
#define PG8_SCHED __builtin_amdgcn_sched_barrier(0)
    Unit cur, nxt; int ui = 0;
    if (!S.next(0, cur)) return;
    f32x4 acc[2][2][4][2];
#pragma unroll
    for (int a = 0; a < 2; ++a)
#pragma unroll
        for (int b = 0; b < 2; ++b)
#pragma unroll
            for (int m = 0; m < 4; ++m)
#pragma unroll
                for (int n = 0; n < 2; ++n) acc[a][b][m][n] = (f32x4){0.f, 0.f, 0.f, 0.f};
    bf16x8 At[4][2], B0[2][2], B1[2][2];
    const char* cA = g.aptr(cur); const char* cB = g.bptr(cur);
    S.a_ready(cur);
    if constexpr (SP2) {
        PG8_STAGE(PG8_SB(0, 0), cB, voffB); PG8_STAGE(PG8_SB(0, 1), cB + hstepB, voffB); PG8_STAGE(PG8_SA(0, 0), cA, voffA); PG8_STAGE(PG8_SA(0, 1), cA + hstepA, voffA);
        if (wr == 1) PG8_BAR;
        PG8_WAIT_V(2); PG8_BAR;
        PG8_STAGE(PG8_SB(1, 0), cB + kstep, voffB); PG8_STAGE(PG8_SA(1, 0), cA + kstep, voffA); PG8_STAGE(PG8_SB(1, 1), cB + hstepB + kstep, voffB);
        PG8_WAIT_V(6); PG8_BAR;
    } else {
        PG8_STAGE(PG8_SB(0, 0), cB, voffB); PG8_STAGE(PG8_SA(0, 0), cA, voffA); PG8_STAGE(PG8_SB(0, 1), cB + hstepB, voffB); PG8_STAGE(PG8_SA(0, 1), cA + hstepA, voffA);
        if (wr == 1) PG8_BAR;
        PG8_WAIT_V(4); PG8_BAR;
        PG8_STAGE(PG8_SB(1, 0), cB + kstep, voffB); PG8_STAGE(PG8_SA(1, 0), cA + kstep, voffA); PG8_STAGE(PG8_SB(1, 1), cB + hstepB + kstep, voffB);
        PG8_WAIT_V(6); PG8_BAR;
    }
    for (;;) {
        const bool has_next = S.next(ui + 1, nxt);
        const char* nA = has_next ? g.aptr(nxt) : cA; const char* nB = has_next ? g.bptr(nxt) : cB;
        for (int t = 0; t < nt; t += 2) {
            const bool last = (t == nt - 2);
            const char* a1 = cA + (size_t)(t + 1) * kstep;
            const char* a2 = last ? nA : cA + (size_t)(t + 2) * kstep; const char* b2 = last ? nB : cB + (size_t)(t + 2) * kstep;
            const char* a3 = a2 + kstep; const char* b3 = b2 + kstep;
            if (last && has_next) S.a_ready(nxt);
            if constexpr (SP2) {
            PG8_LDB(B0, 0, 0); PG8_LDB(B1, 0, 1); PG8_SCHED; PG8_LDA(At, 0, 0); PG8_STAGE(PG8_SA(1, 1), a1 + hstepA, voffA);
            PG8_WAIT_V(8); PG8_WAIT_L(0); PG8_BAR; PG8_MMA(0, 0, At, B0); PG8_MMA(0, 1, At, B1); PG8_BAR; PG8_SCHED;
            PG8_LDA(At, 0, 1); PG8_STAGE(PG8_SB(0, 0), b2, voffB); PG8_STAGE(PG8_SB(0, 1), b2 + hstepB, voffB); PG8_STAGE(PG8_SA(0, 0), a2, voffA);
            PG8_WAIT_V(8); PG8_WAIT_L(0); PG8_BAR; PG8_MMA(1, 0, At, B0); PG8_MMA(1, 1, At, B1); PG8_BAR; PG8_SCHED;
            PG8_LDB(B0, 1, 0); PG8_LDB(B1, 1, 1); PG8_SCHED; PG8_LDA(At, 1, 0); PG8_STAGE(PG8_SA(0, 1), a2 + hstepA, voffA);
            PG8_WAIT_V(8); PG8_WAIT_L(0); PG8_BAR; PG8_MMA(0, 0, At, B0); PG8_MMA(0, 1, At, B1); PG8_BAR; PG8_SCHED;
            PG8_LDA(At, 1, 1); PG8_STAGE(PG8_SB(1, 0), b3, voffB); PG8_STAGE(PG8_SB(1, 1), b3 + hstepB, voffB); PG8_STAGE(PG8_SA(1, 0), a3, voffA);
            PG8_WAIT_V(8); PG8_WAIT_L(0); PG8_BAR; PG8_MMA(1, 0, At, B0); PG8_MMA(1, 1, At, B1); PG8_BAR; PG8_SCHED;
            } else {
            PG8_LDB(B0, 0, 0); PG8_SCHED; PG8_LDA(At, 0, 0); PG8_STAGE(PG8_SA(1, 1), a1 + hstepA, voffA);
            PG8_WAIT_L(8); PG8_BAR; PG8_WAIT_L(0); PG8_MMA(0, 0, At, B0); PG8_BAR; PG8_SCHED;
            PG8_LDB(B1, 0, 1); PG8_STAGE(PG8_SB(0, 0), b2, voffB);
            PG8_BAR; PG8_WAIT_L(0); PG8_MMA(0, 1, At, B1); PG8_BAR;
            PG8_LDA(At, 0, 1); PG8_STAGE(PG8_SA(0, 0), a2, voffA);
            PG8_BAR; PG8_WAIT_L(0); PG8_MMA(1, 0, At, B0); PG8_BAR; PG8_SCHED;
            PG8_STAGE(PG8_SB(0, 1), b2 + hstepB, voffB);
            PG8_WAIT_V(6); PG8_BAR; PG8_MMA(1, 1, At, B1); PG8_BAR;
            PG8_LDB(B0, 1, 0); PG8_SCHED; PG8_LDA(At, 1, 0); PG8_STAGE(PG8_SA(0, 1), a2 + hstepA, voffA);
            PG8_WAIT_L(8); PG8_BAR; PG8_WAIT_L(0); PG8_MMA(0, 0, At, B0); PG8_BAR; PG8_SCHED;
            PG8_LDB(B1, 1, 1); PG8_STAGE(PG8_SB(1, 0), b3, voffB);
            PG8_BAR; PG8_WAIT_L(0); PG8_MMA(0, 1, At, B1); PG8_BAR;
            PG8_LDA(At, 1, 1); PG8_STAGE(PG8_SA(1, 0), a3, voffA);
            PG8_BAR; PG8_WAIT_L(0); PG8_MMA(1, 0, At, B0); PG8_BAR; PG8_SCHED;
            PG8_STAGE(PG8_SB(1, 1), b3 + hstepB, voffB);
            PG8_WAIT_V(6); PG8_BAR; PG8_MMA(1, 1, At, B1); PG8_BAR;
            }
        }
        if constexpr (ALIGN_EPI) { if (wr == 0) PG8_BAR; }
        if constexpr (!Epi::AFTER_DRAIN) { int l2 = (int)__builtin_amdgcn_mbcnt_hi(~0u, __builtin_amdgcn_mbcnt_lo(~0u, 0u)); asm volatile("" : "+v"(l2)); const int fr2 = l2 & 15, fq2 = l2 >> 4; E(acc, cur, wr, wc, fr2, fq2); S.done(cur); }
        if (!has_next) break;
#pragma unroll
        for (int a = 0; a < 2; ++a)
#pragma unroll
            for (int b = 0; b < 2; ++b)
#pragma unroll
                for (int m = 0; m < 4; ++m)
#pragma unroll
                    for (int n = 0; n < 2; ++n) acc[a][b][m][n] = (f32x4){0.f, 0.f, 0.f, 0.f};
        cur = nxt; cA = nA; cB = nB; ++ui;
        if constexpr (ALIGN_EPI) { if (wr == 1) PG8_BAR; }
    }
    PG8_WAIT_V(0);
    if constexpr (!ALIGN_EPI) { if (wr == 0) PG8_BAR; }
    PG8_BAR;
    if constexpr (Epi::AFTER_DRAIN) { E.fused(acc, cur, wr, wc, fr, fq, lds, wid, lane); S.done(cur); }
#undef PG8_SA
#undef PG8_SB
#undef PG8_STAGE
#undef PG8_LDA
#undef PG8_LDB
#undef PG8_MMA
#undef PG8_WAIT_V
#undef PG8_WAIT_L
#undef PG8_BAR
#undef PG8_SCHED
}
}
#define GAS __attribute__((address_space(1)))
#define LAS __attribute__((address_space(3)))
#define XB_TMO      128
#define XB_XCNT(j)  (256  + 64 * (j))
#define XB_XSUB(j)  (1280 + 64 * (j))
#define XB_XGEN(j)  (2304 + 64 * (j))
#define XB_TOP      3328
#define XB_TOPGEN   3392
#define XCD_BAR_WORDS 3456
#define XB_SPIN_CAP (1u << 18)

__device__ __forceinline__ unsigned xb_ld(unsigned* p)              { return __hip_atomic_load(p, __ATOMIC_RELAXED, __HIP_MEMORY_SCOPE_AGENT); }
__device__ __forceinline__ unsigned xb_add(unsigned* p, unsigned v) { return __hip_atomic_fetch_add(p, v, __ATOMIC_RELAXED, __HIP_MEMORY_SCOPE_AGENT); }
__device__ __forceinline__ unsigned xb_xcc_id() { return (unsigned)__builtin_amdgcn_s_getreg((3 << 11) | 20) & 0xFu; }
#define XB_SPIN(cond, bar) do { unsigned _sp = 0; while (cond) { __builtin_amdgcn_s_sleep(1); \
    if ((++_sp & 255u) == 0u) { if (xb_ld(&(bar)[XB_TMO])) break; if (_sp > XB_SPIN_CAP) { atomicAdd(&(bar)[XB_TMO], 1u); break; } } } } while (0)

struct XcdBarrier {
    unsigned* bar; unsigned x;
    volatile LAS unsigned* st;
};

__device__ __forceinline__ XcdBarrier xcd_barrier_post(unsigned* bar, volatile LAS unsigned* st) {
    XcdBarrier b; b.bar = bar; b.x = xb_xcc_id(); b.st = st;
    if (threadIdx.x == 0) (void)xb_add(&bar[XB_XCNT(b.x)], 1u);
    return b;
}
__device__ __forceinline__ void xcd_barrier_complete(unsigned* bar, unsigned x, unsigned& nloc, unsigned& nx) {
    const unsigned G = gridDim.x * gridDim.y * gridDim.z;
    unsigned sum, cnt, mine, sp = 0u;
    for (;;) {
        sum = 0u; cnt = 0u; mine = 0u;
#pragma unroll
        for (unsigned j = 0; j < 16; ++j) { const unsigned c = xb_ld(&bar[XB_XCNT(j)]); sum += c; cnt += (c > 0u) ? 1u : 0u; mine = (j == x) ? c : mine; }
        if (sum == G) break;
        __builtin_amdgcn_s_sleep(1);
        if ((++sp & 255u) == 0u) { if (xb_ld(&bar[XB_TMO])) break; if (sp > XB_SPIN_CAP) { atomicAdd(&bar[XB_TMO], 1u); break; } }
    }
    nloc = mine > 0u ? mine : 1u; nx = cnt > 0u ? cnt : 1u;
}

__device__ __forceinline__ void xcd_barrier(const XcdBarrier& b) {
    asm volatile("s_waitcnt vmcnt(0)" ::: "memory");
    __syncthreads();
    if (threadIdx.x == 0) {
        unsigned* bar = b.bar;
        __builtin_amdgcn_s_waitcnt(0);
        unsigned nloc = b.st[0], nx = b.st[1];
        if (nloc == 0u) { xcd_barrier_complete(bar, b.x, nloc, nx); b.st[0] = nloc; b.st[1] = nx; }
        const unsigned old = xb_add(&bar[XB_XSUB(b.x)], 1u);
        const unsigned gen = old / nloc;
        if (old + 1u == (gen + 1u) * nloc) {
            __builtin_amdgcn_fence(__ATOMIC_RELEASE, "agent");
            asm volatile("s_waitcnt vmcnt(0)" ::: "memory");
            const unsigned og = xb_add(&bar[XB_TOP], 1u);
            const unsigned tg = og / nx;
            if (og + 1u == (tg + 1u) * nx) xb_add(&bar[XB_TOPGEN], 1u);
            else XB_SPIN(xb_ld(&bar[XB_TOPGEN]) == tg, bar);
            __builtin_amdgcn_fence(__ATOMIC_ACQUIRE, "agent");
            xb_add(&bar[XB_XGEN(b.x)], 1u);
            asm volatile("s_waitcnt vmcnt(0)" ::: "memory");
        } else {
            XB_SPIN(xb_ld(&bar[XB_XGEN(b.x)]) == gen, bar);
            __builtin_amdgcn_fence(__ATOMIC_ACQUIRE, "agent");
            asm volatile("s_waitcnt vmcnt(0)" ::: "memory");
        }
    }
    __syncthreads();
}

using pg8::bf16_t; using pg8::f32x4; using pg8::u32x4; using pg8::bf16x8; using pg8::Unit;
typedef GAS unsigned gu32;
typedef float f32x2v __attribute__((ext_vector_type(2)));
typedef unsigned u32x2v __attribute__((ext_vector_type(2)));
constexpr int NB = 2, SEQ = 8192, D = 1024, M = NB * SEQ, NL = 4;
constexpr int SBATCH = 32, STOK = 4, MS = SBATCH * STOK, MT = M + MS;
constexpr int FF = 2816, DIN = 3072, WINDOW = 2048;
constexpr float EPS = 1e-6f, LOG2E = 1.4426950408889634f;
constexpr int NWAVES = 8, NTHR = 512;

constexpr size_t O_YP = 0, O_YS = O_YP + (size_t)M * D, O_PLH = O_YS + (size_t)MS * D, O_PLC = O_PLH + NL * NB * 256, O_PHG = O_PLC + NL * NB * 3 * 256,
    O_PSK = O_PHG + (size_t)NL * NB * 4 * 4096, O_PSV = O_PSK + (size_t)NL * NB * 2048 * 512, O_PMK = O_PSV + (size_t)NL * NB * 2048 * 512,
    O_PMV = O_PMK + (size_t)NL * NB * 256 * 1024, O_SLH = O_PMV + (size_t)NL * NB * 256 * 1024, O_SLC = O_SLH + NL * 32 * 256, O_SHG = O_SLC + NL * 32 * 3 * 256,
    O_SSK = O_SHG + (size_t)NL * 32 * 4 * 4096, O_SSV = O_SSK + (size_t)NL * 32 * 2048 * 512, O_END = O_SSV + (size_t)NL * 32 * 2048 * 512;
static_assert(O_END == 308682752ull, "output size");

enum { I_XP = 0, I_XS, I_SLH, I_SLC, I_SHG, I_CSK, I_CSV, I_CMK, I_CMV, I_MEMP, I_NF1, I_F1G, I_F1U, I_F1D, I_NMIX, I_WIN, I_CONVW, I_CONVB, I_LWA, I_LBA, I_LWX, I_LBX,
       I_LAM, I_HLB, I_HNORM, I_GNA, I_GNC, I_WOUT, I_NCROSS, I_XWQ, I_XWK, I_XWV, I_XWO, I_NF2, I_F2G, I_F2U, I_F2D, I_NFIN, N_IN };
static_assert(N_IN == 38, "inputs");

constexpr size_t al4k(size_t x) { return (x + 4095) & ~(size_t)4095; }
constexpr size_t SZ_UP = (size_t)2 * FF * D, SZ_DN = (size_t)D * FF, SZ_IN = (size_t)DIN * D, SZ_SQ = (size_t)D * D;
constexpr size_t LW_1U = 0, LW_1D = LW_1U + SZ_UP, LW_IN = LW_1D + SZ_DN, LW_OUT = LW_IN + SZ_IN, LW_Q = LW_OUT + SZ_SQ, LW_O = LW_Q + SZ_SQ, LW_2U = LW_O + SZ_SQ,
    LW_2D = LW_2U + SZ_UP, LW_SZ = LW_2D + SZ_DN;
constexpr size_t WS_CTL = 0, CTL_BYTES = 1u << 20;
constexpr size_t WS_W = CTL_BYTES;
constexpr size_t WS_WKV = al4k(WS_W + NL * LW_SZ * 2);
constexpr size_t WS_XB = al4k(WS_WKV + 8 * SZ_SQ * 2);
constexpr size_t WS_SSQ = al4k(WS_XB + (size_t)MT * D * 2);
constexpr size_t WS_SSQS = al4k(WS_SSQ + (size_t)M * 16 * 4);
constexpr size_t WS_ACT = al4k(WS_SSQS + (size_t)MS * 64 * 4);
constexpr size_t WS_ZF = al4k(WS_ACT + (size_t)MT * FF * 2);
constexpr size_t WS_ZS = al4k(WS_ZF + (size_t)M * 1536 * 4);
constexpr size_t WS_QA = al4k(WS_ZS + (size_t)MS * 3072 * 4);
constexpr size_t WS_KA = al4k(WS_QA + (size_t)M * 512 * 2);
constexpr size_t WS_VA = al4k(WS_KA + (size_t)M * 512 * 2);
constexpr size_t WS_ACUM = al4k(WS_VA + (size_t)M * 512 * 2);
constexpr size_t WS_HLOC = al4k(WS_ACUM + (size_t)M * 256 * 4);
constexpr size_t WS_CA = al4k(WS_HLOC + (size_t)M * 256 * 4);
constexpr size_t WS_CH = al4k(WS_CA + 2 * 128 * 256 * 4);
constexpr size_t WS_HIN = al4k(WS_CH + 2 * 128 * 256 * 4);
constexpr size_t WS_HKV = al4k(WS_HIN + 2 * 128 * 256 * 4);
constexpr size_t WS_HDEC = al4k(WS_HKV + (size_t)1024 * 4096 * 4);
constexpr size_t WS_HSP = al4k(WS_HDEC + 1024 * 64 * 4);
constexpr size_t WS_YC = al4k(WS_HSP + (size_t)1024 * 4096 * 4);
constexpr size_t WS_Y = al4k(WS_YC + (size_t)MT * 512 * 4);
constexpr size_t WS_QX = al4k(WS_Y + (size_t)MT * D * 2);
constexpr size_t WS_QSS = al4k(WS_QX + (size_t)MT * D * 2);
constexpr size_t WS_PB = al4k(WS_QSS + (size_t)M * 16 * 4);
constexpr size_t WS_LS = al4k(WS_PB + (size_t)M * D * 2);
constexpr size_t WS_OB = al4k(WS_LS + (size_t)M * 16 * 4);
constexpr size_t WS_MEMB = al4k(WS_OB + (size_t)MT * D * 2);
constexpr size_t WS_MEMK = al4k(WS_MEMB + 512 * D * 2);
constexpr size_t WS_MEMVT = al4k(WS_MEMK + (size_t)NL * 2 * 256 * 1024 * 2);
constexpr size_t WS_KMAX = al4k(WS_MEMVT + (size_t)NL * 2 * 256 * 1024 * 2);
constexpr size_t WS_LRUW = al4k(WS_KMAX + NL * 2 * 4 * 8 * 4);
constexpr size_t WS_QXS = al4k(WS_LRUW + (size_t)NL * 2 * 4 * 4096 * 2);
constexpr size_t WS_XL = al4k(WS_QXS + (size_t)MS * D * 4);
constexpr size_t WS_END = al4k(WS_XL + (size_t)M * D * 2);
constexpr size_t WS_SHADOW = WS_END, WS_TOTAL = WS_SHADOW + O_SSK * 4;
constexpr size_t QKV_STRIDE = (WS_KA - WS_QA) / 2, PSKV_STRIDE = O_PSV - O_PSK;
static_assert(WS_VA - WS_KA == WS_KA - WS_QA, "q k v equally spaced");
constexpr int CW_CPQ = 12288;
constexpr int CW_BAR = 4096;

constexpr int RING_BYTES = 131072, LDSCTL_OFF = RING_BYTES, LDS_BYTES = 147456;


template <int CTRL> __device__ __forceinline__ float dpp_(float v) { return __builtin_bit_cast(float, __builtin_amdgcn_update_dpp(0, __builtin_bit_cast(int, v), CTRL, 0xF, 0xF, true)); }
__device__ __forceinline__ float x1_(float v) { return dpp_<0xB1>(v); }
__device__ __forceinline__ float x2_(float v) { return dpp_<0x4E>(v); }
__device__ __forceinline__ float sw4_(float v) { return __builtin_bit_cast(float, __builtin_amdgcn_ds_swizzle(__builtin_bit_cast(int, v), 0x101F)); }
__device__ __forceinline__ float sw8_(float v) { return __builtin_bit_cast(float, __builtin_amdgcn_ds_swizzle(__builtin_bit_cast(int, v), 0x201F)); }
__device__ __forceinline__ float sum_g(float v) {
    { const unsigned u = __builtin_bit_cast(unsigned, v); const auto r = __builtin_amdgcn_permlane16_swap(u, u, false, false); v = __builtin_bit_cast(float, (unsigned)r[0]) + __builtin_bit_cast(float, (unsigned)r[1]); }
    { const unsigned u = __builtin_bit_cast(unsigned, v); const auto r = __builtin_amdgcn_permlane32_swap(u, u, false, false); v = __builtin_bit_cast(float, (unsigned)r[0]) + __builtin_bit_cast(float, (unsigned)r[1]); }
    return v; }
__device__ __forceinline__ float max_g(float v) {
    { const unsigned u = __builtin_bit_cast(unsigned, v); const auto r = __builtin_amdgcn_permlane16_swap(u, u, false, false); v = fmaxf(__builtin_bit_cast(float, (unsigned)r[0]), __builtin_bit_cast(float, (unsigned)r[1])); }
    { const unsigned u = __builtin_bit_cast(unsigned, v); const auto r = __builtin_amdgcn_permlane32_swap(u, u, false, false); v = fmaxf(__builtin_bit_cast(float, (unsigned)r[0]), __builtin_bit_cast(float, (unsigned)r[1])); }
    return v; }
__device__ __forceinline__ float row_sum(float v) { v += x1_(v); v += x2_(v); v += dpp_<0x141>(v); v += dpp_<0x140>(v); return v; }
__device__ __forceinline__ float row_max(float v) { v = fmaxf(v, x1_(v)); v = fmaxf(v, x2_(v)); v = fmaxf(v, dpp_<0x141>(v)); v = fmaxf(v, dpp_<0x140>(v)); return v; }
__device__ __forceinline__ float bperm_(float v, int src_lane) { return __builtin_bit_cast(float, __builtin_amdgcn_ds_bpermute(src_lane << 2, __builtin_bit_cast(int, v))); }
__device__ __forceinline__ float wave_sum(float v) { return sum_g(row_sum(v)); }
__device__ __forceinline__ float wave_max(float v) { return max_g(row_max(v)); }
__device__ __forceinline__ unsigned f2bf(float f) { unsigned u = __builtin_bit_cast(unsigned, f); return (u + 0x7fffu + ((u >> 16) & 1u)) >> 16; }
typedef float f32x2_t __attribute__((ext_vector_type(2))); typedef __bf16 bf16x2_t __attribute__((ext_vector_type(2)));
__device__ __forceinline__ unsigned pk2(float lo, float hi) { f32x2_t v = {lo, hi}; bf16x2_t b = __builtin_convertvector(v, bf16x2_t); return __builtin_bit_cast(unsigned, b); }
__device__ __forceinline__ float bf2f(unsigned short h) { return __builtin_bit_cast(float, (unsigned)h << 16); }
__device__ __forceinline__ u32x4 pack8(f32x4 a, f32x4 b) { u32x4 w; w.x = pk2(a[0], a[1]); w.y = pk2(a[2], a[3]); w.z = pk2(b[0], b[1]); w.w = pk2(b[2], b[3]); return w; }
__device__ __forceinline__ float fast_exp2(float x) { return __builtin_amdgcn_exp2f(x); }
__device__ __forceinline__ float fast_rcp(float x) { return __builtin_amdgcn_rcpf(x); }
__device__ __forceinline__ float fexp(float x) { return __builtin_amdgcn_exp2f(x * LOG2E); }
__device__ __forceinline__ float flog2(float x) { return __builtin_amdgcn_logf(x); }
__device__ __forceinline__ float fsqrt(float x) { return __builtin_amdgcn_sqrtf(x); }
__device__ __forceinline__ float frsq(float x) { return __builtin_amdgcn_rsqf(x); }
__device__ __forceinline__ float sigmoidf_(float x) { return fast_rcp(1.f + fast_exp2(-x * LOG2E)); }
__device__ __forceinline__ float siluf_(float x) { return x * sigmoidf_(x); }
__device__ __forceinline__ float gelu_tanh(float x) {
    const float u = 0.7978845608028654f * (x + 0.044715f * x * x * x);
    return x * sigmoidf_(2.f * u);
}
__device__ __forceinline__ f32x4 ldbf4(const bf16_t* p) { const u32x2v w = *(const u32x2v*)p; f32x4 r; r[0] = __builtin_bit_cast(float, w.x << 16); r[1] = __builtin_bit_cast(float, w.x & 0xffff0000u); r[2] = __builtin_bit_cast(float, w.y << 16); r[3] = __builtin_bit_cast(float, w.y & 0xffff0000u); return r; }
__device__ __forceinline__ float sum4(f32x4 a) { return (a[0] + a[1]) + (a[2] + a[3]); }
__device__ __forceinline__ float sq4(f32x4 a) { return (a[0] * a[0] + a[1] * a[1]) + (a[2] * a[2] + a[3] * a[3]); }
__device__ __forceinline__ float rstd16(const float* ssq, int row) {
    const f32x4* p = (const f32x4*)(ssq + (size_t)row * 16);
    const f32x4 a = p[0], b = p[1], c = p[2], d = p[3];
    const float s = (sum4(a) + sum4(b)) + (sum4(c) + sum4(d));
    return frsq(s * (1.0f / D) + EPS);
}
__device__ __forceinline__ void rstd16x4(const float* ssq, int row0  , float (&rs)[4]) {
    f32x4 t[4][4];
#pragma unroll
    for (int m = 0; m < 4; ++m)
#pragma unroll
        for (int i = 0; i < 4; ++i) t[m][i] = *((const f32x4*)(ssq + (size_t)(row0 + 16 * m) * 16) + i);
#pragma unroll
    for (int m = 0; m < 4; ++m) rs[m] = frsq(((sum4(t[m][0]) + sum4(t[m][1])) + (sum4(t[m][2]) + sum4(t[m][3]))) * (1.0f / D) + EPS);
}
__device__ __forceinline__ float rstd64(const float* ssq, int row) {
    const f32x4* p = (const f32x4*)(ssq + (size_t)row * 64);
    float s = 0.f;
#pragma unroll
    for (int i = 0; i < 16; ++i) s += sum4(p[i]);
    return frsq(s * (1.0f / D) + EPS);
}

#define EPI_FOR_ROWS _Pragma("unroll") for (int ai = 0; ai < 2; ++ai) _Pragma("unroll") for (int m = 0; m < 4; ++m)
#define EPI_FENCE asm volatile("" ::: "memory")

struct EpiUp {
    static constexpr bool PERM = true, AFTER_DRAIN = false;
    bf16_t* act; const float* ssq;
    __device__ __forceinline__ void operator()(const f32x4 (&acc)[2][2][4][2], const Unit& u, int wr, int wc, int fr, int fq) const {
        const int col0 = u.pn * 128 + wc * 32 + 8 * fq;
#pragma unroll
        for (int ai = 0; ai < 2; ++ai) { EPI_FENCE; float rs4[4]; rstd16x4(ssq, u.pm * 256 + ai * 128 + wr * 64 + fr, rs4);
#pragma unroll
          for (int m = 0; m < 4; ++m) { const int row = u.pm * 256 + ai * 128 + wr * 64 + m * 16 + fr; const float rs = rs4[m];
            f32x4 o[2];
#pragma unroll
            for (int n = 0; n < 2; ++n) { const f32x4 g = acc[ai][0][m][n] * rs, up = acc[ai][1][m][n] * rs;
#pragma unroll
                for (int e = 0; e < 4; ++e) o[n][e] = siluf_(g[e]) * up[e]; }
            *(u32x4*)(act + (size_t)row * FF + col0) = pack8(o[0], o[1]); } }
    }
};
constexpr bool RESID_PAIR = false;
struct EpiResid {
    static constexpr bool PERM = true, AFTER_DRAIN = false;
    const float* xin; bf16_t* xb; bf16_t* xl; float* ssq; float alpha;
    __device__ __forceinline__ void operator()(const f32x4 (&acc)[2][2][4][2], const Unit& u, int wr, int wc, int fr, int fq) const {
#pragma unroll
        for (int ai = 0; ai < 2; ++ai) { EPI_FENCE;
            f32x4 xv[4][2][2];
            if (xin) {
#pragma unroll
                for (int m = 0; m < 4; ++m)
#pragma unroll
                    for (int bj = 0; bj < 2; ++bj) { const size_t off = (size_t)(u.pm * 256 + ai * 128 + wr * 64 + m * 16 + fr) * D + u.pn * 256 + bj * 128 + wc * 32 + 8 * fq;
                        xv[m][bj][0] = *(const f32x4*)(xin + off); xv[m][bj][1] = *(const f32x4*)(xin + off + 4); }
            } else if constexpr (RESID_PAIR) { u32x4 hv[4][2], lv[4][2];
#pragma unroll
                for (int m = 0; m < 4; ++m)
#pragma unroll
                    for (int bj = 0; bj < 2; ++bj) { const size_t off = (size_t)(u.pm * 256 + ai * 128 + wr * 64 + m * 16 + fr) * D + u.pn * 256 + bj * 128 + wc * 32 + 8 * fq;
                        hv[m][bj] = *(const u32x4*)(xb + off); lv[m][bj] = *(const u32x4*)(xl + off); }
#pragma unroll
                for (int m = 0; m < 4; ++m)
#pragma unroll
                    for (int bj = 0; bj < 2; ++bj)
#pragma unroll
                        for (int e = 0; e < 4; ++e) { const unsigned hw = hv[m][bj][e], lw = lv[m][bj][e];
                            const float x0 = __builtin_bit_cast(float, hw << 16) + __builtin_bit_cast(float, lw << 16), x1 = __builtin_bit_cast(float, hw & 0xffff0000u) + __builtin_bit_cast(float, lw & 0xffff0000u);
                            xv[m][bj][e >> 1][(e & 1) * 2] = x0; xv[m][bj][e >> 1][(e & 1) * 2 + 1] = x1; }
            } else { u32x4 hv[4][2];
#pragma unroll
                for (int m = 0; m < 4; ++m)
#pragma unroll
                    for (int bj = 0; bj < 2; ++bj) hv[m][bj] = *(const u32x4*)(xb + (size_t)(u.pm * 256 + ai * 128 + wr * 64 + m * 16 + fr) * D + u.pn * 256 + bj * 128 + wc * 32 + 8 * fq);
#pragma unroll
                for (int m = 0; m < 4; ++m)
#pragma unroll
                    for (int bj = 0; bj < 2; ++bj)
#pragma unroll
                        for (int e = 0; e < 4; ++e) { const unsigned hw = hv[m][bj][e]; xv[m][bj][e >> 1][(e & 1) * 2] = __builtin_bit_cast(float, hw << 16); xv[m][bj][e >> 1][(e & 1) * 2 + 1] = __builtin_bit_cast(float, hw & 0xffff0000u); } }
#pragma unroll
            for (int m = 0; m < 4; ++m) { const int row = u.pm * 256 + ai * 128 + wr * 64 + m * 16 + fr; float s = 0.f;
#pragma unroll
                for (int bj = 0; bj < 2; ++bj) { const size_t off = (size_t)row * D + u.pn * 256 + bj * 128 + wc * 32 + 8 * fq;
                    const f32x4 v0 = xv[m][bj][0] + acc[ai][bj][m][0] * alpha, v1 = xv[m][bj][1] + acc[ai][bj][m][1] * alpha;
                    const u32x4 hw = pack8(v0, v1); f32x4 r0, r1;
                    r0[0] = v0[0] - __builtin_bit_cast(float, hw.x << 16); r0[1] = v0[1] - __builtin_bit_cast(float, hw.x & 0xffff0000u); r0[2] = v0[2] - __builtin_bit_cast(float, hw.y << 16); r0[3] = v0[3] - __builtin_bit_cast(float, hw.y & 0xffff0000u);
                    r1[0] = v1[0] - __builtin_bit_cast(float, hw.z << 16); r1[1] = v1[1] - __builtin_bit_cast(float, hw.z & 0xffff0000u); r1[2] = v1[2] - __builtin_bit_cast(float, hw.w << 16); r1[3] = v1[3] - __builtin_bit_cast(float, hw.w & 0xffff0000u);
                    *(u32x4*)(xb + off) = hw; if (RESID_PAIR) *(u32x4*)(xl + off) = pack8(r0, r1);
                    s += sq4(v0) + sq4(v1); }
                s = sum_g(s);
                if (fq == 0) ssq[(size_t)row * 16 + u.pn * 4 + wc] = s; } }
    }
};
struct EpiZ {
    static constexpr bool PERM = true, AFTER_DRAIN = false;
    bf16_t* zf; bf16_t* qa; float* psk; const float* ssq;
    __device__ __forceinline__ void operator()(const f32x4 (&acc)[2][2][4][2], const Unit& u, int wr, int wc, int fr, int fq) const {
#pragma unroll
        for (int ai = 0; ai < 2; ++ai) { EPI_FENCE; float rs4[4]; rstd16x4(ssq, u.pm * 256 + ai * 128 + wr * 64 + fr, rs4);
#pragma unroll
          for (int m = 0; m < 4; ++m) { const int row = u.pm * 256 + ai * 128 + wr * 64 + m * 16 + fr; const float rs = rs4[m];
#pragma unroll
            for (int bj = 0; bj < 2; ++bj) { const int cc = bj * 128 + wc * 32 + 8 * fq;
                const f32x4 v0 = acc[ai][bj][m][0] * rs, v1 = acc[ai][bj][m][1] * rs;
                if (u.pn < 6) { *(u32x4*)(zf + (size_t)row * 1536 + u.pn * 256 + cc) = pack8(v0, v1); }
                else { const int g = (u.pn - 6) >> 1, c512 = ((u.pn - 6) & 1) * 256 + cc, h = c512 >> 6, d = c512 & 63, b = row >> 13, t = row & 8191;
                    bf16_t* dst = qa + (size_t)g * QKV_STRIDE + ((size_t)(b * 8 + h) * SEQ + t) * 64 + d;
                    *(u32x4*)dst = pack8(v0, v1);
                    if (g >= 1 && t >= SEQ - WINDOW) { float* o = psk + (size_t)(g - 1) * PSKV_STRIDE + ((size_t)(b * WINDOW + (t - (SEQ - WINDOW))) * 8 + h) * 64 + d; *(f32x4*)o = v0; *(f32x4*)(o + 4) = v1; } } } } }
    }
};
struct EpiQx {
    static constexpr bool PERM = true, AFTER_DRAIN = false;
    bf16_t* qx; float* qss; const float* ssq;
    __device__ __forceinline__ void operator()(const f32x4 (&acc)[2][2][4][2], const Unit& u, int wr, int wc, int fr, int fq) const {
#pragma unroll
        for (int ai = 0; ai < 2; ++ai) { EPI_FENCE; float rs4[4]; rstd16x4(ssq, u.pm * 256 + ai * 128 + wr * 64 + fr, rs4);
#pragma unroll
          for (int m = 0; m < 4; ++m) { const int row = u.pm * 256 + ai * 128 + wr * 64 + m * 16 + fr; const float rs = rs4[m]; float s = 0.f;
#pragma unroll
            for (int bj = 0; bj < 2; ++bj) { const size_t off = (size_t)row * D + u.pn * 256 + bj * 128 + wc * 32 + 8 * fq;
                const f32x4 v0 = acc[ai][bj][m][0] * rs, v1 = acc[ai][bj][m][1] * rs;
                const u32x4 w = pack8(v0, v1); *(u32x4*)(qx + off) = w;
                s += sq4(v0) + sq4(v1); }
            s = sum_g(s);
            if (fq == 0) qss[(size_t)row * 16 + u.pn * 4 + wc] = s; } }
    }
};
struct EpiS {
    static constexpr bool PERM = true, AFTER_DRAIN = false;
    bf16_t* pb; float* ls; const float* qss; const float* kmaxp;
    __device__ __forceinline__ void operator()(const f32x4 (&acc)[2][2][4][2], const Unit& u, int wr, int wc, int fr, int fq) const {
        const int b = u.pm >> 5, h = u.pn; const float* kp = kmaxp + (b * 4 + h) * 8;
        float k2 = 0.f;
#pragma unroll
        for (int c = 0; c < 4; ++c) k2 += fmaxf(kp[c], kp[4 + c]);
        const float sc = LOG2E * (1.0f / 16.0f);
        EPI_FOR_ROWS { EPI_FENCE; const int row = u.pm * 256 + ai * 128 + wr * 64 + m * 16 + fr;
            const f32x4 q4 = *(const f32x4*)(qss + (size_t)row * 16 + h * 4); const float bound = fsqrt(sum4(q4) * k2) * sc; float s = 0.f;
#pragma unroll
            for (int bj = 0; bj < 2; ++bj) { const size_t off = (size_t)row * D + h * 256 + bj * 128 + wc * 32 + 8 * fq; f32x4 p0, p1;
#pragma unroll
                for (int e = 0; e < 4; ++e) { p0[e] = fast_exp2(acc[ai][bj][m][0][e] * sc - bound); p1[e] = fast_exp2(acc[ai][bj][m][1][e] * sc - bound); }
                const u32x4 w = pack8(p0, p1); *(u32x4*)(pb + off) = w;
                s += (bf2f(w.x & 0xffff) + bf2f(w.x >> 16)) + (bf2f(w.y & 0xffff) + bf2f(w.y >> 16)) + (bf2f(w.z & 0xffff) + bf2f(w.z >> 16)) + (bf2f(w.w & 0xffff) + bf2f(w.w >> 16)); }
            s = sum_g(s);
            if (fq == 0) ls[(size_t)row * 16 + h * 4 + wc] = s; }
    }
};
struct EpiPV {
    static constexpr bool PERM = true, AFTER_DRAIN = false;
    bf16_t* ob; const float* ls;
    __device__ __forceinline__ void operator()(const f32x4 (&acc)[2][2][4][2], const Unit& u, int wr, int wc, int fr, int fq) const {
        EPI_FOR_ROWS { EPI_FENCE; const int row = u.pm * 256 + ai * 128 + wr * 64 + m * 16 + fr;
            const f32x4 l4 = *(const f32x4*)(ls + (size_t)row * 16 + u.pn * 4); const float inv = 1.0f / sum4(l4);
#pragma unroll
            for (int bj = 0; bj < 2; ++bj) { const size_t off = (size_t)row * D + u.pn * 256 + bj * 128 + wc * 32 + 8 * fq;
                *(u32x4*)(ob + off) = pack8(acc[ai][bj][m][0] * inv, acc[ai][bj][m][1] * inv); } }
    }
};
struct EpiMem {
    static constexpr bool PERM = true, AFTER_DRAIN = false;
    float* out_k; float* out_v; bf16_t* memk; bf16_t* memvt; float* kmaxp;
    __device__ __forceinline__ void operator()(const f32x4 (&acc)[2][2][4][2], const Unit& u, int wr, int wc, int fr, int fq) const {
        const int l = u.pn >> 3, kv = (u.pn >> 2) & 1, h = u.pn & 3, b = u.pm; float rmax = 0.f;
        EPI_FOR_ROWS { EPI_FENCE; const int mrow = ai * 128 + wr * 64 + m * 16 + fr; float s = 0.f;
#pragma unroll
            for (int bj = 0; bj < 2; ++bj) { const int c = h * 256 + bj * 128 + wc * 32 + 8 * fq; const f32x4 v0 = acc[ai][bj][m][0], v1 = acc[ai][bj][m][1];
                float* o = (kv ? out_v : out_k) + ((size_t)((l * 2 + b) * 256 + mrow)) * 1024 + c; *(f32x4*)o = v0; *(f32x4*)(o + 4) = v1;
                if (kv == 0) { *(u32x4*)(memk + ((size_t)((l * 2 + b) * 256 + mrow)) * 1024 + c) = pack8(v0, v1); s += sq4(v0) + sq4(v1); }
                else { bf16_t* t = memvt + ((size_t)(l * 2 + b) * 1024 + c) * 256 + mrow;
#pragma unroll
                    for (int e = 0; e < 4; ++e) { t[(size_t)e * 256] = (bf16_t)f2bf(v0[e]); t[(size_t)(4 + e) * 256] = (bf16_t)f2bf(v1[e]); } } }
            s = sum_g(s); rmax = fmaxf(rmax, s); }
        if (kv == 0) {
            rmax = row_max(rmax);
            if ((threadIdx.x & 63) == 0) kmaxp[((l * 2 + b) * 4 + h) * 8 + wr * 4 + wc] = rmax; }
    }
};

struct Args { const float* in[N_IN]; float* out; unsigned char* ws; int ph_lo, ph_hi; };
struct Frame {
    LAS unsigned char* lds; int tid, lane, wave, G, wg;
};

struct TrItem { const float* W; int K, N; bf16_t* WT; const float* gain; int mode, k0, n0; };
__device__ __forceinline__ void tr_load(const TrItem& t, int item, float (&tv)[32], int lane, TrItem& o) {
    o = t; const int nblk = t.N / 32, kb = item / nblk, nb = item % nblk; o.k0 = 64 * kb; o.n0 = 32 * nb;
#pragma unroll
    for (int i = 0; i < 32; ++i) tv[i] = t.W[(size_t)(o.k0 + 2 * i + (lane >> 5)) * t.N + o.n0 + (lane & 31)];
}
__device__ __forceinline__ void tr_finish(const TrItem& t, float (&tv)[32], LAS float* scr, int lane) {
    if (t.gain) {
#pragma unroll
        for (int i = 0; i < 32; ++i) tv[i] *= t.gain[t.k0 + 2 * i + (lane >> 5)]; }
#pragma unroll
    for (int i = 0; i < 32; ++i) scr[(2 * i + (lane >> 5)) * 33 + (lane & 31)] = tv[i];
    asm volatile("s_waitcnt lgkmcnt(0)" ::: "memory");
    const int c = lane & 7;
#pragma unroll
    for (int j = 0; j < 4; ++j) { const int n = (lane >> 3) + 8 * j; const LAS float* s = scr + (8 * c) * 33 + n;
        u32x4 o; o.x = pk2(s[0 * 33], s[1 * 33]); o.y = pk2(s[2 * 33], s[3 * 33]); o.z = pk2(s[4 * 33], s[5 * 33]); o.w = pk2(s[6 * 33], s[7 * 33]);
        const int ng = t.n0 + n; const int drow = t.mode == 0 ? ng : ((ng >> 7) * 256 + (t.mode == 2 ? 128 : 0) + (ng & 127));
        *(u32x4*)(t.WT + (size_t)drow * t.K + t.k0 + 8 * c) = o; }
    asm volatile("s_waitcnt lgkmcnt(0)" ::: "memory");
}
__device__ __forceinline__ void row_init(const float* xrow, bf16_t* orow, float* slots, int nslots, int lane) {
    const f32x4* xr = (const f32x4*)xrow + lane; f32x4 v[4]; float s = 0.f;
#pragma unroll
    for (int j = 0; j < 4; ++j) { v[j] = xr[64 * j]; s += sq4(v[j]); }
    s = wave_sum(s);
    u32x2v* o8 = (u32x2v*)orow + lane;
#pragma unroll
    for (int j = 0; j < 4; ++j) { u32x2v w; w.x = pk2(v[j][0], v[j][1]); w.y = pk2(v[j][2], v[j][3]); o8[64 * j] = w; }
    if (slots && lane < nslots) slots[lane] = (lane == 0) ? s : 0.f;
}

__device__ __forceinline__ void p0_prologue(const Frame& F, const Args& a) {
    unsigned char* ws = a.ws;
    LAS float* scr = (LAS float*)(F.lds + F.wave * 16384);
    const int gw = F.wg * NWAVES + F.wave, NGW = F.G * NWAVES;
    constexpr int I_UP = (D / 64) * (FF / 32), I_DN = (FF / 64) * (D / 32), I_INP = (D / 64) * (DIN / 32), I_SQ = (D / 64) * (D / 32);
    constexpr int PER_L = 6 * I_UP + I_INP + 5 * I_SQ;
    static_assert(I_UP == 1408 && I_DN == 1408 && I_INP == 1536 && I_SQ == 512 && PER_L == 12544, "items");
    auto decode = [&](int it, TrItem& t, int& r) {
        const int l = it / PER_L; r = it % PER_L;
        bf16_t* LWb = (bf16_t*)(ws + WS_W) + (size_t)l * LW_SZ; bf16_t* KV = (bf16_t*)(ws + WS_WKV) + (size_t)l * 2 * SZ_SQ;
        const size_t oUP = (size_t)l * D * FF, oDN = (size_t)l * FF * D, oSQ = (size_t)l * D * D;
        if (r < I_UP) { t = TrItem{a.in[I_F1G] + oUP, D, FF, LWb + LW_1U, a.in[I_NF1] + l * D, 1, 0, 0}; return; } r -= I_UP;
        if (r < I_UP) { t = TrItem{a.in[I_F1U] + oUP, D, FF, LWb + LW_1U, a.in[I_NF1] + l * D, 2, 0, 0}; return; } r -= I_UP;
        if (r < I_DN) { t = TrItem{a.in[I_F1D] + oDN, FF, D, LWb + LW_1D, nullptr, 0, 0, 0}; return; } r -= I_DN;
        if (r < I_INP) { t = TrItem{a.in[I_WIN] + (size_t)l * D * DIN, D, DIN, LWb + LW_IN, a.in[I_NMIX] + l * D, 0, 0, 0}; return; } r -= I_INP;
        if (r < I_SQ) { t = TrItem{a.in[I_WOUT] + oSQ, D, D, LWb + LW_OUT, nullptr, 0, 0, 0}; return; } r -= I_SQ;
        if (r < I_SQ) { t = TrItem{a.in[I_XWQ] + oSQ, D, D, LWb + LW_Q, a.in[I_NCROSS] + l * D, 0, 0, 0}; return; } r -= I_SQ;
        if (r < I_SQ) { t = TrItem{a.in[I_XWK] + oSQ, D, D, KV, nullptr, 0, 0, 0}; return; } r -= I_SQ;
        if (r < I_SQ) { t = TrItem{a.in[I_XWV] + oSQ, D, D, KV + SZ_SQ, nullptr, 0, 0, 0}; return; } r -= I_SQ;
        if (r < I_SQ) { t = TrItem{a.in[I_XWO] + oSQ, D, D, LWb + LW_O, nullptr, 0, 0, 0}; return; } r -= I_SQ;
        if (r < I_UP) { t = TrItem{a.in[I_F2G] + oUP, D, FF, LWb + LW_2U, a.in[I_NF2] + l * D, 1, 0, 0}; return; } r -= I_UP;
        if (r < I_UP) { t = TrItem{a.in[I_F2U] + oUP, D, FF, LWb + LW_2U, a.in[I_NF2] + l * D, 2, 0, 0}; return; } r -= I_UP;
        t = TrItem{a.in[I_F2D] + oDN, FF, D, LWb + LW_2D, nullptr, 0, 0, 0}; };
    { float tvA[32], tvB[32]; TrItem tA, tB, td; int r; int it = gw;
      if (it < NL * PER_L) { decode(it, td, r); tr_load(td, r, tvA, F.lane, tA); }
      while (it < NL * PER_L) {
          const int itn = it + NGW; if (itn < NL * PER_L) { decode(itn, td, r); tr_load(td, r, tvB, F.lane, tB); }
          tr_finish(tA, tvA, scr, F.lane);
          it = itn; if (it >= NL * PER_L) break;
          const int itn2 = it + NGW; if (itn2 < NL * PER_L) { decode(itn2, td, r); tr_load(td, r, tvA, F.lane, tA); }
          tr_finish(tB, tvB, scr, F.lane);
          it = itn2; } }
    { bf16_t* LW = (bf16_t*)(ws + WS_LRUW);
      for (int idx = F.wg * NTHR + F.tid; idx < NL * 2 * 4 * 4096; idx += F.G * NTHR) { const int k = idx & 63, j = (idx >> 6) & 63, n = (idx >> 12) & 3, ax = (idx >> 14) & 1, l = idx >> 15;
          LW[idx] = (bf16_t)f2bf((ax ? a.in[I_LWX] : a.in[I_LWA])[(size_t)((l * 4 + n) * 64 + k) * 64 + j]); } }
    bf16_t* XB = (bf16_t*)(ws + WS_XB); float* SSQ = (float*)(ws + WS_SSQ); float* SSQS = (float*)(ws + WS_SSQS); bf16_t* MEMB = (bf16_t*)(ws + WS_MEMB);
#pragma unroll 1
    for (int mb = gw; mb < M; mb += 4 * NGW) { f32x4 v[4][4];
#pragma unroll
        for (int i = 0; i < 4; ++i) { const int m = mb + i * NGW < M ? mb + i * NGW : M - 1; const f32x4* xr = (const f32x4*)(a.in[I_XP] + (size_t)m * D) + F.lane;
#pragma unroll
            for (int j = 0; j < 4; ++j) v[i][j] = xr[64 * j]; }
#pragma unroll
        for (int i = 0; i < 4; ++i) { const int m = mb + i * NGW; float sq = 0.f;
#pragma unroll
            for (int j = 0; j < 4; ++j) sq += sq4(v[i][j]);
            sq = wave_sum(sq);
            if (m < M) { u32x2v* o8 = (u32x2v*)(XB + (size_t)m * D) + F.lane;
#pragma unroll
                for (int j = 0; j < 4; ++j) { u32x2v w; w.x = pk2(v[i][j][0], v[i][j][1]); w.y = pk2(v[i][j][2], v[i][j][3]); o8[64 * j] = w; }
                if (F.lane < 16) SSQ[(size_t)m * 16 + F.lane] = (F.lane == 0) ? sq : 0.f; } } }
    for (int m = M + gw; m < MT + 512; m += NGW) {
        if (m < MT) row_init(a.in[I_XS] + (size_t)(m - M) * D, XB + (size_t)m * D, SSQS + (size_t)(m - M) * 64, 64, F.lane);
        else row_init(a.in[I_MEMP] + (size_t)(m - MT) * D, MEMB + (size_t)(m - MT) * D, nullptr, 0, F.lane);
    }
}
__device__ __forceinline__ void p1_cache_copy(const Frame& F, const Args& a) {
    constexpr int HALFP = (WINDOW - STOK) * 128 / 2;
#pragma unroll 1
    for (int kv = 0; kv < 2; ++kv) {
        const f32x4* src = (const f32x4*)a.in[kv ? I_CSV : I_CSK]; f32x4* dst = (f32x4*)(a.out + (kv ? O_SSV : O_SSK));
#pragma unroll 1
        for (int pp = F.wg; pp < NL * SBATCH * 2; pp += F.G) {
            const int p = pp >> 1, hf = pp & 1;
            const f32x4* s = src + (size_t)p * (WINDOW * 128) + STOK * 128 + (size_t)hf * HALFP; f32x4* d = dst + (size_t)p * (WINDOW * 128) + (size_t)hf * HALFP;
#pragma unroll 8
            for (int e = F.tid; e < HALFP; e += NTHR) { const f32x4 v = __builtin_nontemporal_load(s + e); __builtin_nontemporal_store(v, d + e); }
        }
    }
}

constexpr int CP_BLK = 4088, CP_NBLK = 2 * NL * SBATCH * 64;
static_assert((WINDOW - STOK) * 128 == 64 * CP_BLK, "copy blocks");
__device__ __forceinline__ void cache_copy_block_wave(int lane, const float* csk, const float* csv, float* out, int blk) {
    const int kv = blk >> 13, p = (blk >> 6) & 127, q = blk & 63;
    const f32x4* s = (const f32x4*)(kv ? csv : csk) + (size_t)p * (WINDOW * 128) + STOK * 128 + (size_t)q * CP_BLK; f32x4* d = (f32x4*)(out + (kv ? O_SSV : O_SSK)) + (size_t)p * (WINDOW * 128) + (size_t)q * CP_BLK;
#pragma unroll 1
    for (int it = 0; it < 4; ++it) { f32x4 v[16];
#pragma unroll
        for (int i = 0; i < 16; ++i) { const int e = lane + 64 * (16 * it + i); v[i] = __builtin_nontemporal_load(s + (e < CP_BLK ? e : CP_BLK - 1)); }
#pragma unroll
        for (int i = 0; i < 16; ++i) { const int e = lane + 64 * (16 * it + i); if (e < CP_BLK) __builtin_nontemporal_store(v[i], d + e); } }
}

template <int NBT> __device__ __forceinline__ void slab_mma(const bf16_t* A, int lda, const bf16_t* B0, const bf16_t* B1, int ldb, int K, int wave, int lane, f32x4& acc0, f32x4& acc1) {
    const int fr = lane & 15, g = lane >> 4;
    const bf16_t* ap = A + (size_t)(16 * wave + fr) * lda + 8 * g;
    const bf16_t* b0 = B0 + (size_t)fr * ldb + 8 * g; const bf16_t* b1 = B1 + (size_t)fr * ldb + 8 * g;
    acc0 = (f32x4){0.f, 0.f, 0.f, 0.f}; acc1 = (f32x4){0.f, 0.f, 0.f, 0.f};
    constexpr int NS = NBT == 2 ? 11 : 16;
#pragma unroll 1
    for (int kb = 0; kb < K; kb += 32 * NS) {
        bf16x8 af[NS], bf0[NS], bf1[NBT == 2 ? NS : 1];
#pragma unroll
        for (int i = 0; i < NS; ++i) { const int k0 = kb + 32 * i; if (k0 < K) { af[i] = *(const bf16x8*)(ap + k0); bf0[i] = *(const bf16x8*)(b0 + k0); if (NBT == 2) bf1[i] = *(const bf16x8*)(b1 + k0); } }
#pragma unroll
        for (int i = 0; i < NS; ++i) { const int k0 = kb + 32 * i; if (k0 < K) { acc0 = __builtin_amdgcn_mfma_f32_16x16x32_bf16(bf0[i], af[i], acc0, 0, 0, 0);
                if (NBT == 2) acc1 = __builtin_amdgcn_mfma_f32_16x16x32_bf16(bf1[i], af[i], acc1, 0, 0, 0); } }
    }
}

template <int NBT> __device__ __forceinline__ void slab_mma_f32a(const float* A, const bf16_t* B0, const bf16_t* B1, int ldb, int wave, int lane, f32x4& acc0, f32x4& acc1, float& rs) {
    const int fr = lane & 15, g = lane >> 4;
    const float* ap = A + (size_t)(16 * wave + fr) * D + 8 * g;
    const bf16_t* b0 = B0 + (size_t)fr * ldb + 8 * g; const bf16_t* b1 = B1 + (size_t)fr * ldb + 8 * g;
    acc0 = (f32x4){0.f, 0.f, 0.f, 0.f}; acc1 = (f32x4){0.f, 0.f, 0.f, 0.f}; float ss = 0.f;
    constexpr int NS = 8;
#pragma unroll 1
    for (int kb = 0; kb < D; kb += 32 * NS) {
        f32x4 a0[NS], a1[NS]; bf16x8 bf0[NS], bf1[NBT == 2 ? NS : 1];
#pragma unroll
        for (int i = 0; i < NS; ++i) { const int k0 = kb + 32 * i; a0[i] = *(const f32x4*)(ap + k0); a1[i] = *(const f32x4*)(ap + k0 + 4); bf0[i] = *(const bf16x8*)(b0 + k0); if (NBT == 2) bf1[i] = *(const bf16x8*)(b1 + k0); }
#pragma unroll
        for (int i = 0; i < NS; ++i) { ss += sq4(a0[i]) + sq4(a1[i]); const bf16x8 af = __builtin_bit_cast(bf16x8, pack8(a0[i], a1[i]));
            acc0 = __builtin_amdgcn_mfma_f32_16x16x32_bf16(bf0[i], af, acc0, 0, 0, 0);
            if (NBT == 2) acc1 = __builtin_amdgcn_mfma_f32_16x16x32_bf16(bf1[i], af, acc1, 0, 0, 0); }
    }
    ss = sum_g(ss);
    rs = frsq(ss * (1.0f / D) + EPS);
}

__device__ __forceinline__ void slab_up32_f32a(const float* A, const bf16_t* Bg  , int wave, int lane, f32x4 (&ag)[2], f32x4 (&au)[2], float& rs) {
    const int fr = lane & 15, g = lane >> 4;
    const float* ap = A + (size_t)(16 * wave + fr) * D + 8 * g;
    const bf16_t* bg = Bg + (size_t)fr * D + 8 * g;
#pragma unroll
    for (int j = 0; j < 2; ++j) { ag[j] = (f32x4){0.f, 0.f, 0.f, 0.f}; au[j] = (f32x4){0.f, 0.f, 0.f, 0.f}; }
    float ss = 0.f;
    constexpr int NS = 5;
#pragma unroll 1
    for (int kb = 0; kb < D; kb += 32 * NS) {
        f32x4 a0[NS], a1[NS]; bf16x8 bq[NS][4];
#pragma unroll
        for (int i = 0; i < NS; ++i) { const int k0 = kb + 32 * i; if (k0 < D) { a0[i] = *(const f32x4*)(ap + k0); a1[i] = *(const f32x4*)(ap + k0 + 4);
                bq[i][0] = *(const bf16x8*)(bg + k0); bq[i][1] = *(const bf16x8*)(bg + (size_t)16 * D + k0); bq[i][2] = *(const bf16x8*)(bg + (size_t)128 * D + k0); bq[i][3] = *(const bf16x8*)(bg + (size_t)144 * D + k0); } }
#pragma unroll
        for (int i = 0; i < NS; ++i) if (kb + 32 * i < D) { ss += sq4(a0[i]) + sq4(a1[i]); const bf16x8 af = __builtin_bit_cast(bf16x8, pack8(a0[i], a1[i]));
            ag[0] = __builtin_amdgcn_mfma_f32_16x16x32_bf16(bq[i][0], af, ag[0], 0, 0, 0); ag[1] = __builtin_amdgcn_mfma_f32_16x16x32_bf16(bq[i][1], af, ag[1], 0, 0, 0);
            au[0] = __builtin_amdgcn_mfma_f32_16x16x32_bf16(bq[i][2], af, au[0], 0, 0, 0); au[1] = __builtin_amdgcn_mfma_f32_16x16x32_bf16(bq[i][3], af, au[1], 0, 0, 0); }
    }
    ss = sum_g(ss);
    rs = frsq(ss * (1.0f / D) + EPS);
}

__device__ __forceinline__ f32x4 slab_f32a_q(const float* A, const bf16_t* B, int wave, int lane) {
    const int fr = lane & 15, g = lane >> 4;
    const float* ap = A + (size_t)(16 * wave + fr) * D + 8 * g; const bf16_t* bp = B + (size_t)fr * D + 8 * g;
    f32x4 a0[8], a1[8]; bf16x8 bf[8]; f32x4 acc = {0.f, 0.f, 0.f, 0.f};
#pragma unroll
    for (int i = 0; i < 8; ++i) { a0[i] = *(const f32x4*)(ap + 32 * i); a1[i] = *(const f32x4*)(ap + 32 * i + 4); bf[i] = *(const bf16x8*)(bp + 32 * i); }
#pragma unroll
    for (int i = 0; i < 8; ++i) acc = __builtin_amdgcn_mfma_f32_16x16x32_bf16(bf[i], __builtin_bit_cast(bf16x8, pack8(a0[i], a1[i])), acc, 0, 0, 0);
    return acc;
}

__device__ __forceinline__ void phase_ffn_up(const Frame& F, unsigned char* ws, const bf16_t* Wu, const float* xs  ) {
    bf16_t* XB = (bf16_t*)(ws + WS_XB); bf16_t* ACT = (bf16_t*)(ws + WS_ACT); const float* SSQ = (const float*)(ws + WS_SSQ);
    pg8::Gemm g{XB, Wu, D, D, D, 0, 0, 256 * D}; pg8::StaticOrder S; S.init(M, 2 * FF, F.G, F.wg);
    EpiUp E{ACT, SSQ};
    pg8::gemm_phase<EpiUp, pg8::StaticOrder, true, true>(F.lds, g, S, E, F.wave);
    int lane = F.lane; asm volatile("" : "+v"(lane));
    for (int s = F.wg - F.G / 2; s >= 0 && s < FF / 32; s += F.G / 2) {
        const int n0 = 32 * s; const bf16_t* Bg = Wu + (size_t)((n0 >> 7) * 256 + (n0 & 127)) * D;
        f32x4 ag[2], au[2]; float rs; slab_up32_f32a(xs, Bg, F.wave, lane, ag, au, rs);
        const int row = 16 * F.wave + (lane & 15);
#pragma unroll
        for (int j = 0; j < 2; ++j) { u32x2v w; w.x = pk2(siluf_(ag[j][0] * rs) * (au[j][0] * rs), siluf_(ag[j][1] * rs) * (au[j][1] * rs)); w.y = pk2(siluf_(ag[j][2] * rs) * (au[j][2] * rs), siluf_(ag[j][3] * rs) * (au[j][3] * rs));
            *(u32x2v*)(ACT + (size_t)(M + row) * FF + n0 + 16 * j + 4 * (lane >> 4)) = w; }
    }
}
__device__ __forceinline__ void phase_resid(const Frame& F, unsigned char* ws, const bf16_t* A, int K, const bf16_t* W, const float* xin  , float* xsout  , float alpha) {
    bf16_t* XB = (bf16_t*)(ws + WS_XB); float* SSQ = (float*)(ws + WS_SSQ);
    pg8::Gemm g{A, W, K, K, K, 0, 0, 256 * K}; pg8::StaticOrder S; S.init(M, D, F.G, F.wg);
    EpiResid E{xin, XB, (bf16_t*)(ws + WS_XL), SSQ, alpha};
    pg8::gemm_phase<EpiResid, pg8::StaticOrder, false, true>(F.lds, g, S, E, F.wave);
    int lane = F.lane; asm volatile("" : "+v"(lane));
    for (int t = F.wg; t < 256; t += F.G) {
        const int sl = t >> 2, kq = t & 3, n0 = 16 * sl, k0 = kq * (K / 4); f32x4 ac, dum; slab_mma<1>(A + (size_t)M * K + k0, K, W + (size_t)n0 * K + k0, W, K, K / 4, F.wave, lane, ac, dum);
        const int row = 16 * F.wave + (lane & 15), c = n0 + 4 * (lane >> 4); float* xp = xsout + (size_t)row * D + c;
#pragma unroll
        for (int e = 0; e < 4; ++e) atomicAdd(xp + e, ac[e] * alpha);
    }
}
__device__ __forceinline__ void phase_win(const Frame& F, unsigned char* ws, const bf16_t* W, float* psk, const float* xs) {
    bf16_t* XB = (bf16_t*)(ws + WS_XB); const float* SSQ = (const float*)(ws + WS_SSQ); float* ZS = (float*)(ws + WS_ZS);
    pg8::Gemm g{XB, W, D, D, D, 0, 0, 256 * D}; pg8::StaticOrder S; S.init(M, DIN, F.G, F.wg);
    EpiZ E{(bf16_t*)(ws + WS_ZF), (bf16_t*)(ws + WS_QA), psk, SSQ};
    pg8::gemm_phase<EpiZ, pg8::StaticOrder, true, true>(F.lds, g, S, E, F.wave);
    int lane = F.lane; asm volatile("" : "+v"(lane));
    for (int s = F.G - 1 - F.wg; s < DIN / 16; s += F.G) {
        const int n0 = 16 * s; f32x4 ac, dum; float rs; slab_mma_f32a<1>(xs, W + (size_t)n0 * D, W, D, F.wave, lane, ac, dum, rs);
        const int row = 16 * F.wave + (lane & 15);
        *(f32x4*)(ZS + (size_t)row * DIN + n0 + 4 * (lane >> 4)) = ac * rs;
    }
}

constexpr int CW_DBG = 8192;
#ifdef DBG
constexpr int N_CH = 9;
__device__ __forceinline__ void dbg_acc(gu32* ctl, int c, float num, float den, int lane) {
    num = wave_sum(num); den = wave_sum(den);
    if (lane == 0) { atomicAdd((float*)(ctl + CW_DBG + 2 * c), num); atomicAdd((float*)(ctl + CW_DBG + 2 * c + 1), den); }
}
template <class FA> __device__ __forceinline__ float ndot(FA fa, const float* W, int K, size_t ldw, int lane) {
    float s = 0.f; for (int k = lane; k < K; k += 64) s += fa(k) * W[(size_t)k * ldw]; return wave_sum(s);
}
__device__ __forceinline__ void dbg_finish(const Frame& F, const Args& a, gu32* ctl) {
    const size_t ooff[N_CH] = {O_YS, O_PLH, O_PLC, O_PHG, O_PSK, O_PSV, O_SLH, O_SLC, O_SHG};
    const size_t osz[N_CH] = {(size_t)MS * D, NL * NB * 256, NL * NB * 768, (size_t)NL * NB * 16384, (size_t)NL * NB * 2048 * 512, (size_t)NL * NB * 2048 * 512, NL * 32 * 256, NL * 32 * 768, (size_t)NL * 32 * 16384};
    const size_t gt = (size_t)F.wg * NTHR + F.tid, NT = (size_t)F.G * NTHR;
    for (size_t e = gt; e < (size_t)M * D; e += NT) a.out[O_YP + e] = 0.f;
    for (int c = 0; c < N_CH; ++c) {
        const float num = __hip_atomic_load((float*)(ctl + CW_DBG + 2 * c), __ATOMIC_RELAXED, __HIP_MEMORY_SCOPE_AGENT), den = __hip_atomic_load((float*)(ctl + CW_DBG + 2 * c + 1), __ATOMIC_RELAXED, __HIP_MEMORY_SCOPE_AGENT);
        size_t n = 0; if (den > 0.f) { float r = 1e4f * fsqrt(num / den); if (!(r < 90000.f)) r = 90000.f; n = 1 + (size_t)(r + 0.5f); }
#ifdef DBGT
        { const int sel1[N_CH] = {2, 15, 0, 3, 4, 5, 6, 7, 8}, sel2[N_CH] = {9, 1, 10, 11, 12, 13, 14, 16, 16}; const int ty = (DBGT == 1 ? sel1 : sel2)[c];
          unsigned tk = 0; if (DBGT == 3 || DBGT == 4) tk = __hip_atomic_load((unsigned*)(ctl + CW_DBG + 96 + c), __ATOMIC_RELAXED, __HIP_MEMORY_SCOPE_AGENT); else if (ty < 16) tk = __hip_atomic_load((unsigned*)(ctl + CW_DBG + 64 + ty), __ATOMIC_RELAXED, __HIP_MEMORY_SCOPE_AGENT); n = 1 + tk / 100; }
#endif
        size_t cap = osz[c] < 99999 ? osz[c] : 99999; if (n > cap) n = cap;
        for (size_t e = n + gt; e < osz[c]; e += NT) a.out[ooff[c] + e] = 0.f;
    }
    for (int p = F.wg * NTHR + F.tid; p < 2 * NL * SBATCH * 4 * 128; p += F.G * NTHR) { const int kv = p / (NL * SBATCH * 512), r = p % (NL * SBATCH * 512), pr = r / 512, e = r % 512;
        ((f32x4*)(a.out + (kv ? O_SSV : O_SSK)))[(size_t)pr * (WINDOW * 128) + (WINDOW - STOK) * 128 + e] = (f32x4){0.f, 0.f, 0.f, 0.f}; }
}
#endif

constexpr int ZC_XA = 0, ZC_GA = 256, ZC_QB = 512, ZC_FB = 768, ZC_VB = 1024, ZC_GB = 1280, ZC_QC = 1536, ZC_KC = 2048, ZC_VC = 2560;
constexpr float LN2 = 0.6931471805599453f;
#define WG_SYNC() __syncthreads()
#define WG_SYNC_LDS() asm volatile("s_waitcnt lgkmcnt(0)\n\ts_barrier" ::: "memory")

constexpr int LC_OFF = 102400, LC_PIECES = 28;
struct LdsCopy { const char* src; char* dst; };
__device__ __forceinline__ void lc_issue(const Frame& F, const LdsCopy& c) { if (!c.src) return;
    for (int j = F.wave; j < LC_PIECES; j += NWAVES) __builtin_amdgcn_global_load_lds((const unsigned*)(c.src + j * 1024 + F.lane * 16), (LAS unsigned*)(F.lds + LC_OFF + j * 1024), 16, 0, 0); }
__device__ __forceinline__ void lc_store(const Frame& F, const LdsCopy& c) { if (!c.src) return;
    asm volatile("s_waitcnt vmcnt(0)" ::: "memory");
    for (int j = F.wave; j < LC_PIECES; j += NWAVES) { const f32x4 v = *(const LAS f32x4*)(F.lds + LC_OFF + j * 1024 + F.lane * 16); __builtin_nontemporal_store(v, (f32x4*)(c.dst + j * 1024 + F.lane * 16)); } }
constexpr int LC_NCHUNK = 128 * 146;
__device__ __forceinline__ LdsCopy lc_chunk(const float* csk, float* out, int cidx) { LdsCopy c; c.src = nullptr; c.dst = nullptr;
    if (cidx < LC_NCHUNK) { const int p = cidx / 146, q = cidx % 146; c.src = (const char*)(csk + (size_t)p * (WINDOW * 512) + STOK * 512) + (size_t)q * 28672; c.dst = (char*)(out + O_SSK + (size_t)p * (WINDOW * 512)) + (size_t)q * 28672; }
    return c; }

__device__ __forceinline__ float hgrn_lb(const float* lbp, int l, int c) {
    const float v0 = lbp[c], v1 = lbp[256 + c], v2 = lbp[512 + c], v3 = lbp[768 + c];
    const float mx = fmaxf(fmaxf(v0, v1), fmaxf(v2, v3));
    const float e0 = fexp(v0 - mx), e1 = fexp(v1 - mx), e2 = fexp(v2 - mx), e3 = fexp(v3 - mx);
    const float inv = 1.0f / ((e0 + e1) + (e2 + e3));
    float s = 0.f; if (l >= 1) s += e1; if (l >= 2) s += e2; if (l >= 3) s += e3;
    return s * inv;
}

struct LruW { const float* convw; const float* convb; const float* wa; const float* ba; const float* wx; const float* bx; const float* lam; const float* gna; };
template <int MODE> __device__ __forceinline__ void lru_seq(const Frame& F, const LruW& W, const float* z, int zld, int T, const float* buf3  , const float* h0  ,
                                                            bf16_t* Y  , float* out_h, float* out_conv, gu32* ctl, int dch) {
    LAS float* xc = (LAS float*)F.lds;
    LAS float* red = xc + 1024;
    const int c = F.tid, n = (c >> 6) & 3, j = c & 63; const bool act = c < 256;
    float xm3 = 0.f, xm2 = 0.f, xm1 = 0.f, h = 0.f;
    float w0 = 0.f, w1 = 0.f, w2 = 0.f, w3 = 0.f, cb = 0.f, ba = 0.f, bx = 0.f, sp = 0.f, gn = 0.f;
    if (act) { if (buf3) { xm3 = buf3[c]; xm2 = buf3[256 + c]; xm1 = buf3[512 + c]; } if (h0) h = h0[c];
        w0 = W.convw[c]; w1 = W.convw[256 + c]; w2 = W.convw[512 + c]; w3 = W.convw[768 + c]; cb = W.convb[c]; ba = W.ba[c]; bx = W.bx[c]; gn = W.gna[c];
        sp = 0.6931471805599453f * flog2(1.f + fexp(-W.lam[c])); }
    float dn = 0.f, dd = 0.f;
    for (int t0 = 0; t0 < T; t0 += 4) {
        float xv[4], xcv[4];
        if (act) {
#pragma unroll
            for (int t = 0; t < 4; ++t) xv[t] = z[(size_t)(t0 + t) * zld + ZC_XA + c];
            xcv[0] = cb + w0 * xm3 + w1 * xm2 + w2 * xm1 + w3 * xv[0];
            xcv[1] = cb + w0 * xm2 + w1 * xm1 + w2 * xv[0] + w3 * xv[1];
            xcv[2] = cb + w0 * xm1 + w1 * xv[0] + w2 * xv[1] + w3 * xv[2];
            xcv[3] = cb + w0 * xv[0] + w1 * xv[1] + w2 * xv[2] + w3 * xv[3];
            xm3 = xv[1]; xm2 = xv[2]; xm1 = xv[3];
#pragma unroll
            for (int t = 0; t < 4; ++t) xc[t * 256 + c] = xcv[t];
        }
        WG_SYNC();
        float y[4] = {0.f, 0.f, 0.f, 0.f};
        if (act) {
            float ra[4] = {0.f, 0.f, 0.f, 0.f}, ri[4] = {0.f, 0.f, 0.f, 0.f};
#pragma unroll 1
            for (int kb = 0; kb < 64; kb += 16) { float wa[16], wx[16];
#pragma unroll
                for (int k = 0; k < 16; ++k) { wa[k] = W.wa[(size_t)(n * 64 + kb + k) * 64 + j]; wx[k] = W.wx[(size_t)(n * 64 + kb + k) * 64 + j]; }
#pragma unroll
                for (int k = 0; k < 16; ++k) {
#pragma unroll
                    for (int t = 0; t < 4; ++t) { const float x = xc[t * 256 + n * 64 + kb + k]; ra[t] += x * wa[k]; ri[t] += x * wx[k]; } } }
#pragma unroll
            for (int t = 0; t < 4; ++t) { const float r = sigmoidf_(ra[t] + ba), ig = sigmoidf_(ri[t] + bx);
                const float la = -8.0f * r * sp, av = fexp(la), u = fsqrt(1.f - fexp(2.f * la)) * (ig * xcv[t]);
                h = av * h + u; const float ga = z[(size_t)(t0 + t) * zld + ZC_GA + c]; y[t] = h * gelu_tanh(ga); }
        }
#pragma unroll
        for (int t = 0; t < 4; ++t) { const float s = wave_sum(y[t] * y[t]); if (F.lane == 0 && F.wave < 4) red[t * 4 + F.wave] = s; }
        WG_SYNC();
        if (act) {
#pragma unroll
            for (int t = 0; t < 4; ++t) { const float tot = (red[t * 4] + red[t * 4 + 1]) + (red[t * 4 + 2] + red[t * 4 + 3]); const float o = y[t] * frsq(tot * (1.f / 256.f) + EPS) * gn;
                if (MODE == 0) Y[(size_t)(t0 + t) * D + c] = (bf16_t)f2bf(o);
                else { const float got = bf2f(Y[(size_t)(t0 + t) * D + c]); dn += (got - o) * (got - o); dd += o * o; } }
        }
        WG_SYNC();
    }
    if (MODE == 0 && act) { out_h[c] = h; out_conv[c] = xm3; out_conv[256 + c] = xm2; out_conv[512 + c] = xm1; }
#ifdef DBG
    if (MODE == 1) dbg_acc(ctl, dch, dn, dd, F.lane);
#endif
}

template <int MODE> __device__ __forceinline__ void hgrn_seq(const Frame& F, const float* lbp, const float* hnorm, int l, int hh, const float* z, int zld, int T, const float* s0  ,
                                                             bf16_t* Y, float* out_s, gu32* ctl, int dch) {
    LAS float* red = (LAS float*)F.lds + 2048;
    const int v = F.lane, d0 = F.wave * 8;
    float S[8], lb[8];
#pragma unroll
    for (int i = 0; i < 8; ++i) { S[i] = s0 ? s0[(size_t)(d0 + i) * 64 + v] : 0.f; lb[i] = hgrn_lb(lbp, l, hh * 64 + d0 + i); }
    const float ng = hnorm[v]; float dn = 0.f, dd = 0.f;
    for (int t = 0; t < T; ++t) {
        const float* zr = z + (size_t)t * zld; const float vv = zr[ZC_VB + hh * 64 + v]; float op = 0.f;
#pragma unroll
        for (int i = 0; i < 8; ++i) { const float fp = zr[ZC_FB + hh * 64 + d0 + i], q = zr[ZC_QB + hh * 64 + d0 + i];
            const float f = lb[i] + (1.f - lb[i]) * sigmoidf_(fp);
            S[i] = f * S[i] + (1.f - f) * vv; op += q * S[i]; }
        red[F.wave * 64 + v] = op;
        WG_SYNC();
        float o = 0.f;
#pragma unroll
        for (int w = 0; w < 8; ++w) o += red[w * 64 + v];
        const float ss = wave_sum(o * o); const float gg = zr[ZC_GB + hh * 64 + v];
        const float y = o * frsq(ss * (1.f / 64.f) + EPS) * ng * siluf_(gg);
        if (F.wave == 0) { if (MODE == 0) Y[(size_t)t * D + 256 + hh * 64 + v] = (bf16_t)f2bf(y);
            else { const float got = bf2f(Y[(size_t)t * D + 256 + hh * 64 + v]); dn += (got - y) * (got - y); dd += y * y; } }
        WG_SYNC();
    }
    if (MODE == 0) {
#pragma unroll
        for (int i = 0; i < 8; ++i) out_s[(size_t)(d0 + i) * 64 + v] = S[i]; }
#ifdef DBG
    if (MODE == 1 && F.wave == 0) dbg_acc(ctl, dch, dn, dd, F.lane);
#endif
}

template <class KV> __device__ __forceinline__ void attn_naive(const KV& kv, const float (&q)[16], int qpos, int h, int lane, float (&o)[16]) {
    const int slot = lane >> 2; const float slope = fast_exp2(-(float)(h + 1)) * LOG2E, sc = 0.125f * LOG2E;
    float m = -1e30f, lsum = 0.f;
#pragma unroll
    for (int i = 0; i < 16; ++i) o[i] = 0.f;
#pragma unroll 1
    for (int pat = 0; pat < 3; ++pat) { const int dil = pat == 0 ? 1 : (pat == 1 ? 4 : 16);
#pragma unroll 3
        for (int j0 = 0; j0 < 129; j0 += 16) { const int jj = j0 + slot; const int kp = qpos - jj * dil; const bool valid = jj <= 128 && kp >= 0;
            float kf[16], vf[16]; kv(valid ? kp : qpos, lane & 3, kf, vf);
            float s = 0.f;
#pragma unroll
            for (int i = 0; i < 16; ++i) s += q[i] * kf[i];
            s += x1_(s); s += x2_(s);
            s = valid ? s * sc - slope * (float)(jj * dil) : -INFINITY;
            float mx = s;
            mx = fmaxf(mx, sw4_(mx)); mx = fmaxf(mx, sw8_(mx)); mx = max_g(mx);
            const float mn = fmaxf(m, mx), alpha = fast_exp2(m - mn), p = fast_exp2(s - mn); m = mn;
            lsum = lsum * alpha + p;
#pragma unroll
            for (int i = 0; i < 16; ++i) o[i] = o[i] * alpha + p * vf[i]; } }
    lsum += sw4_(lsum); lsum += sw8_(lsum); lsum = sum_g(lsum);
#pragma unroll
    for (int i = 0; i < 16; ++i) { o[i] += sw4_(o[i]); o[i] += sw8_(o[i]); o[i] = sum_g(o[i]); }
    const float inv = 1.f / lsum;
#pragma unroll
    for (int i = 0; i < 16; ++i) o[i] *= inv;
}
struct KVDecode {
    const float* ck; const float* cv; const float* zs; int h;
    __device__ __forceinline__ void operator()(int kp, int part, float (&kf)[16], float (&vf)[16]) const {
        const float* kr; const float* vr;
        if (kp < WINDOW) { kr = ck + ((size_t)kp * 8 + h) * 64; vr = cv + ((size_t)kp * 8 + h) * 64; } else { kr = zs + (size_t)(kp - WINDOW) * DIN + ZC_KC + h * 64; vr = zs + (size_t)(kp - WINDOW) * DIN + ZC_VC + h * 64; }
#pragma unroll
        for (int i = 0; i < 4; ++i) { const f32x4 a = *(const f32x4*)(kr + part * 16 + 4 * i), b = *(const f32x4*)(vr + part * 16 + 4 * i);
#pragma unroll
            for (int e = 0; e < 4; ++e) { kf[4 * i + e] = a[e]; vf[4 * i + e] = b[e]; } }
    }
};
struct KVPrompt {
    const bf16_t* k; const bf16_t* v;
    __device__ __forceinline__ void operator()(int kp, int part, float (&kf)[16], float (&vf)[16]) const {
#pragma unroll
        for (int i = 0; i < 16; ++i) { kf[i] = bf2f(k[(size_t)kp * 64 + part * 16 + i]); vf[i] = bf2f(v[(size_t)kp * 64 + part * 16 + i]); }
    }
};

__device__ __forceinline__ void lru_local(const Frame& F, unsigned char* ws, const LruW& W, int task, float* out_conv  ) {
    const float* ZF = (const float*)(ws + WS_ZF); float* ACUM = (float*)(ws + WS_ACUM); float* HLOC = (float*)(ws + WS_HLOC);
    const int b = task >> 7, ck = task & 127, t0 = ck * 64, row0 = b * SEQ + t0;
    LAS float* xc = (LAS float*)F.lds;
    LAS float* exch = xc + 64 * 256;
    for (int idx = F.tid; idx < 64 * 64; idx += NTHR) { const int t = idx >> 6, c4 = (idx & 63) * 4;
        f32x4 acc = *(const f32x4*)(W.convb + c4);
#pragma unroll
        for (int tap = 0; tap < 4; ++tap) { const int tt = t0 + t - 3 + tap; if (tt >= 0) acc += *(const f32x4*)(W.convw + tap * 256 + c4) * *(const f32x4*)(ZF + (size_t)(b * SEQ + tt) * 1536 + ZC_XA + c4); }
        *(LAS f32x4*)(xc + t * 256 + c4) = acc; }
    WG_SYNC();
    const int c = F.tid & 255, th = F.tid >> 8, n = c >> 6, j = c & 63;
    float ra[32], ri[32];
#pragma unroll
    for (int t = 0; t < 32; ++t) { ra[t] = 0.f; ri[t] = 0.f; }
#pragma unroll 1
    for (int k4 = 0; k4 < 16; ++k4) {
        float wa[4], wx[4];
#pragma unroll
        for (int e = 0; e < 4; ++e) { wa[e] = W.wa[(size_t)(n * 64 + 4 * k4 + e) * 64 + j]; wx[e] = W.wx[(size_t)(n * 64 + 4 * k4 + e) * 64 + j]; }
#pragma unroll
        for (int t = 0; t < 32; ++t) { const f32x4 x = *(const LAS f32x4*)(xc + (th * 32 + t) * 256 + n * 64 + 4 * k4);
            ra[t] += (x[0] * wa[0] + x[1] * wa[1]) + (x[2] * wa[2] + x[3] * wa[3]); ri[t] += (x[0] * wx[0] + x[1] * wx[1]) + (x[2] * wx[2] + x[3] * wx[3]); }
    }
    const float ba = W.ba[c], bx = W.bx[c], sp = 0.6931471805599453f * flog2(1.f + fexp(-W.lam[c]));
#pragma unroll
    for (int t = 0; t < 32; ++t) { const float r = sigmoidf_(ra[t] + ba), ig = sigmoidf_(ri[t] + bx);
        const float la = -8.0f * r * sp; ra[t] = fexp(la); ri[t] = fsqrt(1.f - fexp(2.f * la)) * (ig * xc[(th * 32 + t) * 256 + c]); }
    float A = 1.f, H = 0.f;
    if (th == 0) {
#pragma unroll
        for (int t = 0; t < 32; ++t) { H = ra[t] * H + ri[t]; A *= ra[t]; ACUM[(size_t)(row0 + t) * 256 + c] = A; HLOC[(size_t)(row0 + t) * 256 + c] = H; }
        exch[2 * c] = A; exch[2 * c + 1] = H; }
    WG_SYNC();
    if (th == 1) { A = exch[2 * c]; H = exch[2 * c + 1];
#pragma unroll
        for (int t = 0; t < 32; ++t) { H = ra[t] * H + ri[t]; A *= ra[t]; ACUM[(size_t)(row0 + 32 + t) * 256 + c] = A; HLOC[(size_t)(row0 + 32 + t) * 256 + c] = H; }
        ((float*)(ws + WS_CA))[(size_t)task * 256 + c] = A; ((float*)(ws + WS_CH))[(size_t)task * 256 + c] = H;
        if (ck == 127) {
#pragma unroll
            for (int q = 0; q < 3; ++q) out_conv[(b * 3 + q) * 256 + c] = ZF[(size_t)(row0 + 61 + q) * 1536 + ZC_XA + c]; } }
    WG_SYNC();
}

constexpr int HS = 68;
__device__ __forceinline__ void hgrn_cum(const Frame& F, const float* ZF, const float* lbp, int l, int b, int hh, int ck, LAS float* gt  , float (&cum8)[8], float (&kk8)[8], float& tot) {
    const int d = F.tid & 63, tg = F.tid >> 6; const float lb = hgrn_lb(lbp, l, hh * 64 + d); float run = 0.f;
#pragma unroll
    for (int i = 0; i < 8; ++i) { const float fp = ZF[(size_t)(b * SEQ + ck * 64 + tg * 8 + i) * 1536 + ZC_FB + hh * 64 + d]; const float f = lb + (1.f - lb) * sigmoidf_(fp);
        run += flog2(f); cum8[i] = run; kk8[i] = 1.f - f; }
    gt[tg * 64 + d] = run;
    WG_SYNC();
    float pre = 0.f; tot = 0.f;
#pragma unroll
    for (int g = 0; g < 8; ++g) { const float x = gt[g * 64 + d]; if (g < tg) pre += x; tot += x; }
#pragma unroll
    for (int i = 0; i < 8; ++i) cum8[i] += pre;
}
__device__ __forceinline__ void hgrn_local(const Frame& F, unsigned char* ws, const float* lbp, int l, int task) {
    const float* ZF = (const float*)(ws + WS_ZF);
    const int ck = task & 127, hh = (task >> 7) & 3, b = task >> 9;
    LAS float* kp = (LAS float*)F.lds; LAS float* vv = kp + 64 * HS; LAS float* gt = vv + 64 * HS;
    float cum8[8], kk8[8], tot; hgrn_cum(F, ZF, lbp, l, b, hh, ck, gt, cum8, kk8, tot);
    const int d = F.tid & 63, tg = F.tid >> 6;
#pragma unroll
    for (int i = 0; i < 8; ++i) { kp[(tg * 8 + i) * HS + d] = kk8[i] * fast_exp2(tot - cum8[i]); vv[(tg * 8 + i) * HS + d] = ZF[(size_t)(b * SEQ + ck * 64 + tg * 8 + i) * 1536 + ZC_VB + hh * 64 + d]; }
    if (tg == 0) ((float*)(ws + WS_HDEC))[(size_t)task * 64 + d] = fast_exp2(tot);
    WG_SYNC();
    const int dd0 = 2 * (F.tid >> 4), v0 = 4 * (F.tid & 15); f32x4 a0 = {0.f, 0.f, 0.f, 0.f}, a1 = {0.f, 0.f, 0.f, 0.f};
#pragma unroll 8
    for (int s = 0; s < 64; ++s) { const f32x2v kx = *(const LAS f32x2v*)(kp + s * HS + dd0); const f32x4 vx = *(const LAS f32x4*)(vv + s * HS + v0); a0 += vx * kx[0]; a1 += vx * kx[1]; }
    float* KV = (float*)(ws + WS_HKV) + (size_t)task * 4096;
    *(f32x4*)(KV + dd0 * 64 + v0) = a0; *(f32x4*)(KV + (dd0 + 1) * 64 + v0) = a1;
    WG_SYNC();
}
__device__ __forceinline__ void hgrn_out(const Frame& F, unsigned char* ws, const float* lbp, const float* hnorm, int l, int task) {
    const float* ZF = (const float*)(ws + WS_ZF); bf16_t* Y = (bf16_t*)(ws + WS_Y);
    const int ck = task & 127, hh = (task >> 7) & 3, b = task >> 9, row0 = b * SEQ + ck * 64;
    LAS float* q = (LAS float*)F.lds; LAS float* k = q + 64 * HS; LAS float* cu = k + 64 * HS; LAS float* vv = cu + 64 * HS; LAS float* sc = vv + 64 * HS; LAS float* sp = sc + 64 * HS; LAS float* gt = sp + 64 * HS;
    float cum8[8], kk8[8], tot; hgrn_cum(F, ZF, lbp, l, b, hh, ck, gt, cum8, kk8, tot);
    const int d = F.tid & 63, tg = F.tid >> 6;
#pragma unroll
    for (int i = 0; i < 8; ++i) { const int t = tg * 8 + i; const float* zr = ZF + (size_t)(row0 + t) * 1536;
        q[t * HS + d] = zr[ZC_QB + hh * 64 + d]; k[t * HS + d] = kk8[i]; cu[t * HS + d] = cum8[i]; vv[t * HS + d] = zr[ZC_VB + hh * 64 + d]; }
    { const float* SP = (const float*)(ws + WS_HSP) + (size_t)task * 4096;
#pragma unroll
      for (int i = 0; i < 2; ++i) { const int idx = F.tid + NTHR * i, r = idx >> 4, c4 = (idx & 15) * 4; *(LAS f32x4*)(sp + r * HS + c4) = *(const f32x4*)(SP + r * 64 + c4); } }
    WG_SYNC();
    { const int t = F.tid >> 3, sg = F.tid & 7; float accs[8];
#pragma unroll
      for (int i = 0; i < 8; ++i) accs[i] = 0.f;
#pragma unroll 1
      for (int hf = 0; hf < 2; ++hf) { f32x4 qv[8], ct[8];
#pragma unroll
          for (int d4 = 0; d4 < 8; ++d4) { qv[d4] = *(const LAS f32x4*)(q + t * HS + 32 * hf + 4 * d4); ct[d4] = *(const LAS f32x4*)(cu + t * HS + 32 * hf + 4 * d4); }
#pragma unroll
          for (int i = 0; i < 8; ++i) { const int s_ = sg + 8 * i;
              if (s_ <= t) { f32x4 kv[8], cs[8];
#pragma unroll
                  for (int d4 = 0; d4 < 8; ++d4) { kv[d4] = *(const LAS f32x4*)(k + s_ * HS + 32 * hf + 4 * d4); cs[d4] = *(const LAS f32x4*)(cu + s_ * HS + 32 * hf + 4 * d4); }
#pragma unroll
                  for (int d4 = 0; d4 < 8; ++d4)
#pragma unroll
                      for (int e = 0; e < 4; ++e) accs[i] += qv[d4][e] * kv[d4][e] * fast_exp2(ct[d4][e] - cs[d4][e]); } } }
#pragma unroll
      for (int i = 0; i < 8; ++i) sc[t * HS + sg + 8 * i] = accs[i]; }
    WG_SYNC();
    { const int t = F.tid >> 3, vg = F.tid & 7, v0 = 8 * vg; f32x4 a0 = {0.f, 0.f, 0.f, 0.f}, a1 = {0.f, 0.f, 0.f, 0.f};
      const int smax = 8 * (F.wave + 1);
#pragma unroll 8
      for (int s_ = 0; s_ < smax; ++s_) { const float w = sc[t * HS + s_]; a0 += *(const LAS f32x4*)(vv + s_ * HS + v0) * w; a1 += *(const LAS f32x4*)(vv + s_ * HS + v0 + 4) * w; }
#pragma unroll 8
      for (int dd = 0; dd < 64; ++dd) { const float w = q[t * HS + dd] * fast_exp2(cu[t * HS + dd]); a0 += *(const LAS f32x4*)(sp + dd * HS + v0) * w; a1 += *(const LAS f32x4*)(sp + dd * HS + v0 + 4) * w; }
      float ss = sq4(a0) + sq4(a1); ss += x1_(ss); ss += x2_(ss); ss += sw4_(ss);
      const float rs = frsq(ss * (1.f / 64.f) + EPS); const float* zr = ZF + (size_t)(row0 + t) * 1536 + ZC_GB + hh * 64 + v0;
      const f32x4 g0 = *(const f32x4*)zr, g1 = *(const f32x4*)(zr + 4), n0 = *(const f32x4*)(hnorm + v0), n1 = *(const f32x4*)(hnorm + v0 + 4);
#pragma unroll
      for (int e = 0; e < 4; ++e) { a0[e] = a0[e] * rs * n0[e] * siluf_(g0[e]); a1[e] = a1[e] * rs * n1[e] * siluf_(g1[e]); }
      *(u32x4*)(Y + (size_t)(row0 + t) * D + 256 + hh * 64 + v0) = pack8(a0, a1); }
    WG_SYNC();
}

typedef short s16x4 __attribute__((ext_vector_type(4)));
typedef short v4i16_t __attribute__((ext_vector_type(4)));
constexpr int VROW = 144;
constexpr int ATT_WAVE_LDS = 2 * 2 * 16 * VROW;
__device__ __forceinline__ void attn_wave_task2(const Frame& F, unsigned char* ws, int b, int h, int P, int r0, LAS unsigned char* wl) {
    const bf16_t* QA = (const bf16_t*)(ws + WS_QA) + (size_t)(b * 8 + h) * SEQ * 64; const bf16_t* KA = (const bf16_t*)(ws + WS_KA) + (size_t)(b * 8 + h) * SEQ * 64; const bf16_t* VA = (const bf16_t*)(ws + WS_VA) + (size_t)(b * 8 + h) * SEQ * 64;
    const int lane = F.lane, qi = lane & 15, g = lane >> 4, base = 256 * P;
    const float sc = 0.125f * LOG2E, slope = fast_exp2(-(float)(h + 1)) * LOG2E;
    bf16x8 qf[2][2]; f32x4 O[2][4]; float m[2], lsum[2]; bf16x8 kreg[2][4]; u32x4 vreg[2][4];
#pragma unroll
    for (int s = 0; s < 2; ++s) { const bf16_t* qp = QA + (size_t)(base + r0 + 8 * s + 16 * qi) * 64 + 8 * g; qf[s][0] = *(const bf16x8*)qp; qf[s][1] = *(const bf16x8*)(qp + 32);
#pragma unroll
        for (int i = 0; i < 4; ++i) O[s][i] = (f32x4){0.f, 0.f, 0.f, 0.f};
        m[s] = -1e30f; lsum[s] = 0.f; }
    auto step_geom = [&](int st, int r, int& dil, int& res, int& a0, int& aq0, int& aqs) {
        if (st < 5) { dil = 16; res = r; a0 = 16 * P - 128 + 32 * st; aq0 = 16 * P; aqs = 1; }
        else if (st < 11) { dil = 4; res = r & 3; a0 = 64 * P - 128 + 32 * (st - 5); aq0 = 64 * P + (r >> 2); aqs = 4; }
        else { dil = 1; res = 0; a0 = 256 * P - 128 + 32 * (st - 11); aq0 = 256 * P + r; aqs = 16; } };
#define ATT_PREFETCH(st_, s_) do { int dil, res, a0, aq0, aqs; step_geom((st_), r0 + 8 * (s_), dil, res, a0, aq0, aqs); \
        _Pragma("unroll") for (int tt = 0; tt < 2; ++tt) { int pk = dil * (a0 + 16 * tt + qi) + res; pk = pk < 0 ? 0 : (pk > SEQ - 1 ? SEQ - 1 : pk); \
            const bf16_t* kp = KA + (size_t)pk * 64 + 8 * g; kreg[s_][2 * tt] = *(const bf16x8*)kp; kreg[s_][2 * tt + 1] = *(const bf16x8*)(kp + 32); \
            int pv = dil * (a0 + 16 * tt + (lane >> 2)) + res; pv = pv < 0 ? 0 : (pv > SEQ - 1 ? SEQ - 1 : pv); \
            const bf16_t* vp = VA + (size_t)pv * 64 + 16 * (lane & 3); vreg[s_][2 * tt] = *(const u32x4*)vp; vreg[s_][2 * tt + 1] = *(const u32x4*)(vp + 8); } } while (0)
    ATT_PREFETCH(0, 0); ATT_PREFETCH(0, 1);
#pragma unroll 1
    for (int st = 0; st < 23; ++st) {
        const bool shared = st >= 5, nshared = st + 1 >= 5;
        f32x4 sA[2], sB[2];
#define ATT_QK(s_, k_) do { sA[s_] = (f32x4){0.f, 0.f, 0.f, 0.f}; sB[s_] = (f32x4){0.f, 0.f, 0.f, 0.f}; \
            sA[s_] = __builtin_amdgcn_mfma_f32_16x16x32_bf16(kreg[k_][0], qf[s_][0], sA[s_], 0, 0, 0); sA[s_] = __builtin_amdgcn_mfma_f32_16x16x32_bf16(kreg[k_][1], qf[s_][1], sA[s_], 0, 0, 0); \
            sB[s_] = __builtin_amdgcn_mfma_f32_16x16x32_bf16(kreg[k_][2], qf[s_][0], sB[s_], 0, 0, 0); sB[s_] = __builtin_amdgcn_mfma_f32_16x16x32_bf16(kreg[k_][3], qf[s_][1], sB[s_], 0, 0, 0); } while (0)
        if (shared) { ATT_QK(0, 0); ATT_QK(1, 0); } else { ATT_QK(0, 0); ATT_QK(1, 1); }
#undef ATT_QK
#pragma unroll
        for (int s = 0; s < 2; ++s) if (s == 0 || !shared) { LAS unsigned char* vb = wl + s * (2 * 16 * VROW);
#pragma unroll
            for (int tt = 0; tt < 2; ++tt) { LAS unsigned char* p = vb + tt * (16 * VROW) + (lane >> 2) * VROW + 32 * (lane & 3); *(LAS u32x4*)p = vreg[s][2 * tt]; *(LAS u32x4*)(p + 16) = vreg[s][2 * tt + 1]; } }
        if (st + 1 < 23) { ATT_PREFETCH(st + 1, 0); if (!nshared) ATT_PREFETCH(st + 1, 1); }
#pragma unroll
        for (int s = 0; s < 2; ++s) {
            int dil, res, a0, aq0, aqs; step_geom(st, r0 + 8 * s, dil, res, a0, aq0, aqs);
            LAS unsigned char* vb = wl + (shared ? 0 : s) * (2 * 16 * VROW);
            f32x4 s0 = sA[s], s1 = sB[s];
            const int aq = aq0 + aqs * qi, db = aq - a0 - 4 * g; const unsigned lim = (unsigned)(aq < 128 ? aq : 128); const float sd = slope * (float)dil, fb = sd * (float)db; float mx = -INFINITY;
#pragma unroll
            for (int e = 0; e < 4; ++e) { const unsigned d0 = (unsigned)(db - e), d1 = (unsigned)(db - e - 16);
                s0[e] = d0 <= lim ? s0[e] * sc - (fb - sd * (float)e) : -INFINITY;
                s1[e] = d1 <= lim ? s1[e] * sc - (fb - sd * (float)(e + 16)) : -INFINITY;
                mx = fmaxf(mx, fmaxf(s0[e], s1[e])); }
            mx = max_g(mx);
            const float mn = fmaxf(m[s], mx), alpha = fast_exp2(m[s] - mn); m[s] = mn;
            float ps = 0.f; f32x4 p0, p1;
#pragma unroll
            for (int e = 0; e < 4; ++e) { p0[e] = fast_exp2(s0[e] - mn); p1[e] = fast_exp2(s1[e] - mn); ps += p0[e] + p1[e]; }
            lsum[s] = lsum[s] * alpha + ps;
            const u32x4 pw = pack8(p0, p1); const bf16x8 pf = __builtin_bit_cast(bf16x8, pw);
#pragma unroll
            for (int dt = 0; dt < 4; ++dt) { O[s][dt] *= alpha;
                LAS unsigned char* a0p = vb + (4 * g + (qi >> 2)) * VROW + (16 * dt + 4 * (qi & 3)) * 2;
                const s16x4 lo = __builtin_bit_cast(s16x4, __builtin_amdgcn_ds_read_tr16_b64_v4i16((LAS v4i16_t*)a0p));
                const s16x4 hi = __builtin_bit_cast(s16x4, __builtin_amdgcn_ds_read_tr16_b64_v4i16((LAS v4i16_t*)(a0p + 16 * VROW)));
                O[s][dt] = __builtin_amdgcn_mfma_f32_16x16x32_bf16(__builtin_shufflevector(lo, hi, 0, 1, 2, 3, 4, 5, 6, 7), pf, O[s][dt], 0, 0, 0); }
        }
    }
#undef ATT_PREFETCH
#pragma unroll
    for (int s = 0; s < 2; ++s) { float ls = lsum[s]; ls = sum_g(ls);
        const float inv = 1.f / ls; float* yc = (float*)(ws + WS_YC) + (size_t)(b * SEQ + base + r0 + 8 * s + 16 * qi) * 512 + h * 64 + 4 * g;
#pragma unroll
        for (int dt = 0; dt < 4; ++dt) *(f32x4*)(yc + 16 * dt) = O[s][dt] * inv; }
}

__device__ __forceinline__ void attn_wave_task4(const Frame& F, unsigned char* ws, int b, int h, int P, int r0, LAS unsigned char* wl) {
    const bf16_t* QA = (const bf16_t*)(ws + WS_QA) + (size_t)(b * 8 + h) * SEQ * 64; const bf16_t* KA = (const bf16_t*)(ws + WS_KA) + (size_t)(b * 8 + h) * SEQ * 64; const bf16_t* VA = (const bf16_t*)(ws + WS_VA) + (size_t)(b * 8 + h) * SEQ * 64;
    const int lane = F.lane, qi = lane & 15, g = lane >> 4, base = 256 * P;
    const float sc = 0.125f * LOG2E, slope = fast_exp2(-(float)(h + 1)) * LOG2E;
    bf16x8 qf[4][2]; f32x4 O[4][4]; float m[4], lsum[4]; bf16x8 kA[4], kB[4]; u32x4 vA[4], vB[4];
#pragma unroll
    for (int s = 0; s < 4; ++s) { const bf16_t* qp = QA + (size_t)(base + r0 + 4 * s + 16 * qi) * 64 + 8 * g; qf[s][0] = *(const bf16x8*)qp; qf[s][1] = *(const bf16x8*)(qp + 32);
#pragma unroll
        for (int i = 0; i < 4; ++i) O[s][i] = (f32x4){0.f, 0.f, 0.f, 0.f};
        m[s] = -1e30f; lsum[s] = 0.f; }
#define A4_LOAD(kr, vr, dil_, res_, a0_) do { \
        _Pragma("unroll") for (int tt = 0; tt < 2; ++tt) { int pk = (dil_) * ((a0_) + 16 * tt + qi) + (res_); pk = pk < 0 ? 0 : (pk > SEQ - 1 ? SEQ - 1 : pk); \
            const char* kp = (const char*)KA + (unsigned)(pk * 128 + g * 16); kr[2 * tt] = *(const bf16x8*)kp; kr[2 * tt + 1] = *(const bf16x8*)(kp + 64); \
            int pv = (dil_) * ((a0_) + 16 * tt + (lane >> 2)) + (res_); pv = pv < 0 ? 0 : (pv > SEQ - 1 ? SEQ - 1 : pv); \
            const char* vp = (const char*)VA + (unsigned)(pv * 128 + (lane & 3) * 32); vr[2 * tt] = *(const u32x4*)vp; vr[2 * tt + 1] = *(const u32x4*)(vp + 16); } } while (0)
#define A4_VSTORE(vr, vb_) do { _Pragma("unroll") for (int tt = 0; tt < 2; ++tt) { LAS unsigned char* p = (vb_) + tt * (16 * VROW) + (lane >> 2) * VROW + 32 * (lane & 3); *(LAS u32x4*)p = vr[2 * tt]; *(LAS u32x4*)(p + 16) = vr[2 * tt + 1]; } } while (0)
#define A4_STATE(s_, kr, vb_, dil_, a0_, aq_) do { \
        f32x4 s0 = {0.f, 0.f, 0.f, 0.f}, s1 = {0.f, 0.f, 0.f, 0.f}; \
        s0 = __builtin_amdgcn_mfma_f32_16x16x32_bf16(kr[0], qf[s_][0], s0, 0, 0, 0); s0 = __builtin_amdgcn_mfma_f32_16x16x32_bf16(kr[1], qf[s_][1], s0, 0, 0, 0); \
        s1 = __builtin_amdgcn_mfma_f32_16x16x32_bf16(kr[2], qf[s_][0], s1, 0, 0, 0); s1 = __builtin_amdgcn_mfma_f32_16x16x32_bf16(kr[3], qf[s_][1], s1, 0, 0, 0); \
        const int aqq_ = (aq_), db = aqq_ - (a0_) - 4 * g; const unsigned lim = (unsigned)(aqq_ < 128 ? aqq_ : 128); const float sd = slope * (float)(dil_), fb = sd * (float)db; float mx = -INFINITY; \
        _Pragma("unroll") for (int e = 0; e < 4; ++e) { const unsigned d0 = (unsigned)(db - e), d1 = (unsigned)(db - e - 16); \
            s0[e] = d0 <= lim ? s0[e] * sc - (fb - sd * (float)e) : -INFINITY; \
            s1[e] = d1 <= lim ? s1[e] * sc - (fb - sd * (float)(e + 16)) : -INFINITY; \
            mx = fmaxf(mx, fmaxf(s0[e], s1[e])); } \
        mx = max_g(mx); \
        const float mn = fmaxf(m[s_], mx), alpha = fast_exp2(m[s_] - mn); m[s_] = mn; \
        float ps = 0.f; f32x4 p0, p1; \
        _Pragma("unroll") for (int e = 0; e < 4; ++e) { p0[e] = fast_exp2(s0[e] - mn); p1[e] = fast_exp2(s1[e] - mn); ps += p0[e] + p1[e]; } \
        lsum[s_] = lsum[s_] * alpha + ps; \
        const bf16x8 pf = __builtin_bit_cast(bf16x8, pack8(p0, p1)); \
        _Pragma("unroll") for (int dt = 0; dt < 4; ++dt) { O[s_][dt] *= alpha; \
            LAS unsigned char* a0p = (vb_) + (4 * g + (qi >> 2)) * VROW + (16 * dt + 4 * (qi & 3)) * 2; \
            const s16x4 lo = __builtin_bit_cast(s16x4, __builtin_amdgcn_ds_read_tr16_b64_v4i16((LAS v4i16_t*)a0p)); \
            const s16x4 hi = __builtin_bit_cast(s16x4, __builtin_amdgcn_ds_read_tr16_b64_v4i16((LAS v4i16_t*)(a0p + 16 * VROW))); \
            O[s_][dt] = __builtin_amdgcn_mfma_f32_16x16x32_bf16(__builtin_shufflevector(lo, hi, 0, 1, 2, 3, 4, 5, 6, 7), pf, O[s_][dt], 0, 0, 0); } } while (0)
    LAS unsigned char* vbA = wl; LAS unsigned char* vbB = wl + 2 * 16 * VROW;
    A4_LOAD(kA, vA, 16, r0, 16 * P - 128);
#pragma unroll 1
    for (int st = 0; st < 5; ++st) { const int a0 = 16 * P - 128 + 32 * st, aq = 16 * P + qi;
        A4_VSTORE(vA, vbA); A4_LOAD(kB, vB, 16, r0 + 4, a0);  A4_STATE(0, kA, vbA, 16, a0, aq);
        A4_VSTORE(vB, vbB); A4_LOAD(kA, vA, 16, r0 + 8, a0);  A4_STATE(1, kB, vbB, 16, a0, aq);
        A4_VSTORE(vA, vbA); A4_LOAD(kB, vB, 16, r0 + 12, a0); A4_STATE(2, kA, vbA, 16, a0, aq);
        A4_VSTORE(vB, vbB);
        if (st < 4) A4_LOAD(kA, vA, 16, r0, a0 + 32); else A4_LOAD(kA, vA, 4, r0, 64 * P - 128);
        A4_STATE(3, kB, vbB, 16, a0, aq); }
#pragma unroll 1
    for (int j = 0; j < 18; j += 2) {
        { const int st = j; const bool d4 = st < 6; const int dil = d4 ? 4 : 1, a0 = d4 ? 64 * P - 128 + 32 * st : 256 * P - 128 + 32 * (st - 6);
          const int sn = st + 1; const bool n4 = sn < 6; A4_VSTORE(vA, vbA);
          if (n4) A4_LOAD(kB, vB, 4, r0, 64 * P - 128 + 32 * sn); else A4_LOAD(kB, vB, 1, 0, 256 * P - 128 + 32 * (sn - 6));
          A4_STATE(0, kA, vbA, dil, a0, (d4 ? 64 * P + 4 * qi : 256 * P + r0 + 16 * qi));
          A4_STATE(1, kA, vbA, dil, a0, (d4 ? 64 * P + 1 + 4 * qi : 256 * P + r0 + 4 + 16 * qi));
          A4_STATE(2, kA, vbA, dil, a0, (d4 ? 64 * P + 2 + 4 * qi : 256 * P + r0 + 8 + 16 * qi));
          A4_STATE(3, kA, vbA, dil, a0, (d4 ? 64 * P + 3 + 4 * qi : 256 * P + r0 + 12 + 16 * qi)); }
        { const int st = j + 1; const bool d4 = st < 6; const int dil = d4 ? 4 : 1, a0 = d4 ? 64 * P - 128 + 32 * st : 256 * P - 128 + 32 * (st - 6);
          const int sn = st + 1 < 18 ? st + 1 : 17; const bool n4 = sn < 6; A4_VSTORE(vB, vbB);
          if (n4) A4_LOAD(kA, vA, 4, r0, 64 * P - 128 + 32 * sn); else A4_LOAD(kA, vA, 1, 0, 256 * P - 128 + 32 * (sn - 6));
          A4_STATE(0, kB, vbB, dil, a0, (d4 ? 64 * P + 4 * qi : 256 * P + r0 + 16 * qi));
          A4_STATE(1, kB, vbB, dil, a0, (d4 ? 64 * P + 1 + 4 * qi : 256 * P + r0 + 4 + 16 * qi));
          A4_STATE(2, kB, vbB, dil, a0, (d4 ? 64 * P + 2 + 4 * qi : 256 * P + r0 + 8 + 16 * qi));
          A4_STATE(3, kB, vbB, dil, a0, (d4 ? 64 * P + 3 + 4 * qi : 256 * P + r0 + 12 + 16 * qi)); } }
#undef A4_LOAD
#undef A4_VSTORE
#undef A4_STATE
#pragma unroll
    for (int s = 0; s < 4; ++s) { float ls = lsum[s]; ls = sum_g(ls);
        const float inv = 1.f / ls; float* yc = (float*)(ws + WS_YC) + (size_t)(b * SEQ + base + r0 + 4 * s + 16 * qi) * 512 + h * 64 + 4 * g;
#pragma unroll
        for (int dt = 0; dt < 4; ++dt) *(f32x4*)(yc + 16 * dt) = O[s][dt] * inv; }
}

__device__ __forceinline__ void xattn_sample(const Frame& F, unsigned char* ws, const float* cmk, const float* cmv  , int sb, int h, const float* xs) {
    bf16_t* OB = (bf16_t*)(ws + WS_OB) + (size_t)(M + sb * 4) * D + h * 256;
    LAS float* q = (LAS float*)F.lds;
    LAS float* sc = q + 1024;
    LAS float* part = sc + 1024;
    LAS float* rsq = part + 8 * 4 * 256;
    if (F.wave < 4) { const f32x4* xr = (const f32x4*)(xs + (size_t)(sb * 4 + F.wave) * D) + F.lane; float ss = 0.f;
#pragma unroll
        for (int j = 0; j < 4; ++j) ss += sq4(xr[64 * j]);
        ss = wave_sum(ss); if (F.lane == 0) rsq[F.wave] = frsq(ss * (1.0f / D) + EPS); }
    WG_SYNC();
    { const float* QS = (const float*)(ws + WS_QXS) + (size_t)(sb * 4) * D + h * 256;
      for (int i = F.tid; i < 1024; i += NTHR) q[i] = QS[(size_t)(i >> 8) * D + (i & 255)] * rsq[i >> 8]; }
    WG_SYNC();
    const int lane = F.lane, m0 = F.wave * 32;
    { f32x4 qv[4];
#pragma unroll
      for (int t = 0; t < 4; ++t) qv[t] = *(const LAS f32x4*)(q + t * 256 + 4 * lane);
      const float* kb = cmk + ((size_t)(sb * 256 + m0) * 4 + h) * 256 + 4 * lane;
#pragma unroll 1
      for (int mb = 0; mb < 32; mb += 16) { f32x4 kv[16];
#pragma unroll
          for (int i = 0; i < 16; ++i) kv[i] = *(const f32x4*)(kb + (size_t)(mb + i) * 1024);
#pragma unroll
          for (int i = 0; i < 16; ++i) { float a0 = (kv[i][0] * qv[0][0] + kv[i][1] * qv[0][1]) + (kv[i][2] * qv[0][2] + kv[i][3] * qv[0][3]), a1 = (kv[i][0] * qv[1][0] + kv[i][1] * qv[1][1]) + (kv[i][2] * qv[1][2] + kv[i][3] * qv[1][3]),
                                              a2 = (kv[i][0] * qv[2][0] + kv[i][1] * qv[2][1]) + (kv[i][2] * qv[2][2] + kv[i][3] * qv[2][3]), a3 = (kv[i][0] * qv[3][0] + kv[i][1] * qv[3][1]) + (kv[i][2] * qv[3][2] + kv[i][3] * qv[3][3]);
              const bool o1 = lane & 1, o2 = lane & 2;
              float b0 = o1 ? a2 : a0, b1 = o1 ? a3 : a1; const float s0 = o1 ? a0 : a2, s1 = o1 ? a1 : a3;
              b0 += x1_(s0); b1 += x1_(s1);
              float c = o2 ? b1 : b0; const float sd = o2 ? b0 : b1; c += x2_(sd);
              c += sw4_(c); c += sw8_(c); c = sum_g(c);
              if (lane < 4) sc[(2 * (lane & 1) + (lane >> 1)) * 256 + m0 + mb + i] = c * (LOG2E / 16.f); } } }
    WG_SYNC();
    if (F.wave < 4) { const f32x4 sv = *(const LAS f32x4*)(sc + F.wave * 256 + 4 * lane); const float mx = wave_max(fmaxf(fmaxf(sv[0], sv[1]), fmaxf(sv[2], sv[3])));
        f32x4 p; float ps = 0.f;
#pragma unroll
        for (int e = 0; e < 4; ++e) { p[e] = fast_exp2(sv[e] - mx); ps += p[e]; }
        ps = wave_sum(ps); *(LAS f32x4*)(sc + F.wave * 256 + 4 * lane) = p * (1.f / ps); }
    WG_SYNC();
    { f32x4 o[4];
#pragma unroll
      for (int t = 0; t < 4; ++t) o[t] = (f32x4){0.f, 0.f, 0.f, 0.f};
      const float* vb = cmv + ((size_t)(sb * 256 + m0) * 4 + h) * 256 + 4 * lane;
#pragma unroll 1
      for (int mb = 0; mb < 32; mb += 16) { f32x4 vv[16];
#pragma unroll
          for (int i = 0; i < 16; ++i) vv[i] = *(const f32x4*)(vb + (size_t)(mb + i) * 1024);
#pragma unroll
          for (int i = 0; i < 16; ++i) {
#pragma unroll
              for (int t = 0; t < 4; ++t) o[t] += vv[i] * sc[t * 256 + m0 + mb + i]; } }
#pragma unroll
      for (int t = 0; t < 4; ++t) *(LAS f32x4*)(part + (F.wave * 4 + t) * 256 + 4 * lane) = o[t]; }
    WG_SYNC();
    { const int t = F.tid >> 7, d2 = (F.tid & 127) * 2; float o0 = 0.f, o1 = 0.f;
#pragma unroll
      for (int w = 0; w < 8; ++w) { const f32x2v x = *(const LAS f32x2v*)(part + (w * 4 + t) * 256 + d2); o0 += x[0]; o1 += x[1]; }
      *(unsigned*)(OB + (size_t)t * D + d2) = pk2(o0, o1); }
    WG_SYNC();
}

constexpr int HB = 72;
struct HgOutPre { float fp[8], qv[8], vv[8]; f32x4 spv[2]; };
__device__ __forceinline__ void hgrn_out_load(const Frame& F, unsigned char* ws, int task, HgOutPre& P) {
    const bf16_t* ZF = (const bf16_t*)(ws + WS_ZF); const int ck = task & 127, hh = (task >> 7) & 3, b = task >> 9, row0 = b * SEQ + ck * 64, d = F.tid & 63, tg = F.tid >> 6;
#pragma unroll
    for (int i = 0; i < 8; ++i) { const bf16_t* zr = ZF + (size_t)(row0 + tg * 8 + i) * 1536 + hh * 64 + d; P.fp[i] = bf2f(zr[ZC_FB]); P.qv[i] = bf2f(zr[ZC_QB]); P.vv[i] = bf2f(zr[ZC_VB]); }
    const float* SP = (const float*)(ws + WS_HSP) + (size_t)task * 4096;
#pragma unroll
    for (int i = 0; i < 2; ++i) { const int idx = F.tid + NTHR * i; P.spv[i] = *(const f32x4*)(SP + (idx >> 4) * 64 + (idx & 15) * 4); }
}
__device__ __forceinline__ void hgrn_out_mfma(const Frame& F, unsigned char* ws, const float* lbp, const float* hnorm, int l, int task, const HgOutPre& P, const LdsCopy& lc) {
    const bf16_t* ZF = (const bf16_t*)(ws + WS_ZF); bf16_t* Y = (bf16_t*)(ws + WS_Y);
    const int ck = task & 127, hh = (task >> 7) & 3, b = task >> 9, row0 = b * SEQ + ck * 64;
    LAS bf16_t* tQs = (LAS bf16_t*)F.lds; LAS bf16_t* tQc = tQs + 64 * HB; LAS bf16_t* tKe = tQc + 64 * HB; LAS bf16_t* tKb = tKe + 64 * HB; LAS bf16_t* tV = tKb + 64 * HB; LAS bf16_t* tS = tV + 64 * HB;
    LAS float* gt = (LAS float*)(tS + 64 * HB);
    LAS float* red = gt + 512;
    const int d = F.tid & 63, tg = F.tid >> 6;
    float fp[8], qv[8], vv[8]; f32x4 spv[2];
#pragma unroll
    for (int i = 0; i < 8; ++i) { fp[i] = P.fp[i]; qv[i] = P.qv[i]; vv[i] = P.vv[i]; }
    spv[0] = P.spv[0]; spv[1] = P.spv[1];
    const float lb = hgrn_lb(lbp, l, hh * 64 + d);
    float cum8[8], kk8[8], run = 0.f;
#pragma unroll
    for (int i = 0; i < 8; ++i) { const float f = lb + (1.f - lb) * sigmoidf_(fp[i]); run += flog2(f); cum8[i] = run; kk8[i] = 1.f - f; }
    gt[tg * 64 + d] = run;
#pragma unroll
    for (int i = 0; i < 2; ++i) { const int idx = F.tid + NTHR * i, r = idx >> 4, c4 = (idx & 15) * 4; u32x2v w; w.x = pk2(spv[i][0], spv[i][1]); w.y = pk2(spv[i][2], spv[i][3]); *(LAS u32x2v*)(tS + r * HB + c4) = w; }
    WG_SYNC_LDS(); lc_issue(F, lc);
    float pre = 0.f, refI = 0.f, endJ = 0.f;
#pragma unroll
    for (int g = 0; g < 8; ++g) { const float x = gt[g * 64 + d]; if (g < tg) pre += x; if (g < (tg & ~1)) refI += x; if (g <= (tg | 1)) endJ += x; }
#pragma unroll
    for (int i = 0; i < 8; ++i) { const int t = tg * 8 + i; const float c = cum8[i] + pre;
        tQs[t * HB + d] = (bf16_t)f2bf(qv[i] * fast_exp2(c - refI)); tQc[t * HB + d] = (bf16_t)f2bf(qv[i] * fast_exp2(c));
        tKe[t * HB + d] = (bf16_t)f2bf(kk8[i] * fast_exp2(endJ - c)); tKb[t * HB + d] = (bf16_t)f2bf(kk8[i] * fast_exp2(fminf(refI - c, 100.f)));
        tV[t * HB + d] = (bf16_t)f2bf(vv[i]); }
    WG_SYNC_LDS();
    const int lane = F.lane, ti = lane & 15, g = lane >> 4, I = F.wave >> 1, vh = F.wave & 1;
    bf16x8 qf[2];
#pragma unroll
    for (int ks = 0; ks < 2; ++ks) qf[ks] = *(const LAS bf16x8*)(tQs + (16 * I + ti) * HB + 32 * ks + 8 * g);
    f32x4 sT[4];
#pragma unroll
    for (int J = 0; J < 4; ++J) { sT[J] = (f32x4){0.f, 0.f, 0.f, 0.f};
        if (J <= I) {
            bf16x8 qx[2];
            if (J < I) {
#pragma unroll
                for (int ks = 0; ks < 2; ++ks) { float dl[8];
#pragma unroll
                    for (int e = 0; e < 8; ++e) dl[e] = 0.f;
                    for (int gg = 2 * J + 2; gg < 2 * I; ++gg) {
#pragma unroll
                        for (int e = 0; e < 8; ++e) dl[e] += gt[gg * 64 + 32 * ks + 8 * g + e]; }
                    f32x4 lo, hi;
#pragma unroll
                    for (int e = 0; e < 4; ++e) { lo[e] = bf2f((unsigned short)qf[ks][e]) * fast_exp2(dl[e]); hi[e] = bf2f((unsigned short)qf[ks][4 + e]) * fast_exp2(dl[4 + e]); }
                    qx[ks] = __builtin_bit_cast(bf16x8, pack8(lo, hi)); }
            } else { qx[0] = qf[0]; qx[1] = qf[1]; }
            const LAS bf16_t* kt = (J < I ? tKe : tKb) + (16 * J + ti) * HB + 8 * g;
            const bf16x8 k0 = *(const LAS bf16x8*)kt, k1 = *(const LAS bf16x8*)(kt + 32);
            sT[J] = __builtin_amdgcn_mfma_f32_16x16x32_bf16(k0, qx[0], sT[J], 0, 0, 0); sT[J] = __builtin_amdgcn_mfma_f32_16x16x32_bf16(k1, qx[1], sT[J], 0, 0, 0);
            if (J == I) {
#pragma unroll
                for (int e = 0; e < 4; ++e) if (4 * g + e > ti) sT[J][e] = 0.f; } } }
    f32x4 O[2];
#pragma unroll
    for (int vt = 0; vt < 2; ++vt) O[vt] = (f32x4){0.f, 0.f, 0.f, 0.f};
#pragma unroll
    for (int pp = 0; pp < 2; ++pp) { if (2 * pp <= I) {
        const bf16x8 pf = __builtin_bit_cast(bf16x8, pack8(sT[2 * pp], sT[2 * pp + 1]));
#pragma unroll
        for (int vt = 0; vt < 2; ++vt) { const LAS bf16_t* ap = tV + (32 * pp + 4 * g + (ti >> 2)) * HB + 32 * vh + 16 * vt + 4 * (ti & 3);
            const s16x4 lo = __builtin_bit_cast(s16x4, __builtin_amdgcn_ds_read_tr16_b64_v4i16((LAS v4i16_t*)ap));
            const s16x4 hi = __builtin_bit_cast(s16x4, __builtin_amdgcn_ds_read_tr16_b64_v4i16((LAS v4i16_t*)(ap + 16 * HB)));
            O[vt] = __builtin_amdgcn_mfma_f32_16x16x32_bf16(__builtin_shufflevector(lo, hi, 0, 1, 2, 3, 4, 5, 6, 7), pf, O[vt], 0, 0, 0); } } }
#pragma unroll
    for (int ks = 0; ks < 2; ++ks) { const LAS bf16_t* qc = tQc + (16 * I + ti) * HB + 32 * ks + 4 * g;
        const s16x4 q0 = *(const LAS s16x4*)qc, q1 = *(const LAS s16x4*)(qc + 16);
        const bf16x8 qcf = __builtin_shufflevector(q0, q1, 0, 1, 2, 3, 4, 5, 6, 7);
#pragma unroll
        for (int vt = 0; vt < 2; ++vt) { const LAS bf16_t* ap = tS + (32 * ks + 4 * g + (ti >> 2)) * HB + 32 * vh + 16 * vt + 4 * (ti & 3);
            const s16x4 lo = __builtin_bit_cast(s16x4, __builtin_amdgcn_ds_read_tr16_b64_v4i16((LAS v4i16_t*)ap));
            const s16x4 hi = __builtin_bit_cast(s16x4, __builtin_amdgcn_ds_read_tr16_b64_v4i16((LAS v4i16_t*)(ap + 16 * HB)));
            O[vt] = __builtin_amdgcn_mfma_f32_16x16x32_bf16(__builtin_shufflevector(lo, hi, 0, 1, 2, 3, 4, 5, 6, 7), qcf, O[vt], 0, 0, 0); } }
    float ss = sq4(O[0]) + sq4(O[1]); ss = sum_g(ss);
    if (g == 0) red[(I * 2 + vh) * 16 + ti] = ss;
    WG_SYNC_LDS();
    const float rs = frsq((red[(I * 2) * 16 + ti] + red[(I * 2 + 1) * 16 + ti]) * (1.f / 64.f) + EPS);
    const int row = row0 + 16 * I + ti;
#pragma unroll
    for (int vt = 0; vt < 2; ++vt) { const int v0 = 32 * vh + 16 * vt + 4 * g; const f32x4 gg = ldbf4(ZF + (size_t)row * 1536 + ZC_GB + hh * 64 + v0), nn = *(const f32x4*)(hnorm + v0);
        u32x2v w; w.x = pk2(O[vt][0] * rs * nn[0] * siluf_(gg[0]), O[vt][1] * rs * nn[1] * siluf_(gg[1])); w.y = pk2(O[vt][2] * rs * nn[2] * siluf_(gg[2]), O[vt][3] * rs * nn[3] * siluf_(gg[3]));
        *(u32x2v*)(Y + (size_t)row * D + 256 + hh * 64 + v0) = w; }
    lc_store(F, lc); WG_SYNC_LDS();
}

struct HgLocPre { float fp[8], vv[8]; };
__device__ __forceinline__ void hgrn_local_load(const Frame& F, unsigned char* ws, int task, HgLocPre& P) {
    const bf16_t* ZF = (const bf16_t*)(ws + WS_ZF); const int ck = task & 127, hh = (task >> 7) & 3, b = task >> 9, row0 = b * SEQ + ck * 64, d = F.tid & 63, tg = F.tid >> 6;
#pragma unroll
    for (int i = 0; i < 8; ++i) { const bf16_t* zr = ZF + (size_t)(row0 + tg * 8 + i) * 1536 + hh * 64 + d; P.fp[i] = bf2f(zr[ZC_FB]); P.vv[i] = bf2f(zr[ZC_VB]); }
}
__device__ __forceinline__ void hgrn_local_mfma(const Frame& F, unsigned char* ws, const float* lbp, int l, int task, const HgLocPre& P, const LdsCopy& lc) {
    const bf16_t* ZF = (const bf16_t*)(ws + WS_ZF);
    const int ck = task & 127, hh = (task >> 7) & 3, b = task >> 9, row0 = b * SEQ + ck * 64;
    LAS bf16_t* tKe = (LAS bf16_t*)F.lds; LAS bf16_t* tV = tKe + 64 * HB; LAS float* gt = (LAS float*)(tV + 64 * HB);
    const int d = F.tid & 63, tg = F.tid >> 6;
    float fp[8], vv[8];
#pragma unroll
    for (int i = 0; i < 8; ++i) { fp[i] = P.fp[i]; vv[i] = P.vv[i]; }
    const float lb = hgrn_lb(lbp, l, hh * 64 + d);
    float cum8[8], kk8[8], run = 0.f;
#pragma unroll
    for (int i = 0; i < 8; ++i) { const float f = lb + (1.f - lb) * sigmoidf_(fp[i]); run += flog2(f); cum8[i] = run; kk8[i] = 1.f - f; }
    gt[tg * 64 + d] = run;
    WG_SYNC_LDS(); lc_issue(F, lc);
    float pre = 0.f, tot = 0.f;
#pragma unroll
    for (int g = 0; g < 8; ++g) { const float x = gt[g * 64 + d]; if (g < tg) pre += x; tot += x; }
#pragma unroll
    for (int i = 0; i < 8; ++i) { const int t = tg * 8 + i; tKe[t * HB + d] = (bf16_t)f2bf(kk8[i] * fast_exp2(tot - (cum8[i] + pre))); tV[t * HB + d] = (bf16_t)f2bf(vv[i]); }
    if (tg == 0) ((float*)(ws + WS_HDEC))[(size_t)task * 64 + d] = fast_exp2(tot);
    WG_SYNC_LDS();
    const int lane = F.lane, ti = lane & 15, g = lane >> 4, dt = F.wave >> 1;
    f32x4 acc[2] = {{0.f, 0.f, 0.f, 0.f}, {0.f, 0.f, 0.f, 0.f}};
#pragma unroll
    for (int ks = 0; ks < 2; ++ks) { const int roff = (32 * ks + 4 * g + (ti >> 2)) * HB + 4 * (ti & 3);
        const s16x4 a0 = __builtin_bit_cast(s16x4, __builtin_amdgcn_ds_read_tr16_b64_v4i16((LAS v4i16_t*)(tKe + roff + 16 * dt)));
        const s16x4 a1 = __builtin_bit_cast(s16x4, __builtin_amdgcn_ds_read_tr16_b64_v4i16((LAS v4i16_t*)(tKe + roff + 16 * dt + 16 * HB)));
        const bf16x8 af = __builtin_shufflevector(a0, a1, 0, 1, 2, 3, 4, 5, 6, 7);
#pragma unroll
        for (int j = 0; j < 2; ++j) { const int vt = 2 * (F.wave & 1) + j;
            const s16x4 b0 = __builtin_bit_cast(s16x4, __builtin_amdgcn_ds_read_tr16_b64_v4i16((LAS v4i16_t*)(tV + roff + 16 * vt)));
            const s16x4 b1 = __builtin_bit_cast(s16x4, __builtin_amdgcn_ds_read_tr16_b64_v4i16((LAS v4i16_t*)(tV + roff + 16 * vt + 16 * HB)));
            acc[j] = __builtin_amdgcn_mfma_f32_16x16x32_bf16(af, __builtin_shufflevector(b0, b1, 0, 1, 2, 3, 4, 5, 6, 7), acc[j], 0, 0, 0); } }
    float* KV = (float*)(ws + WS_HKV) + (size_t)task * 4096;
#pragma unroll
    for (int j = 0; j < 2; ++j)
#pragma unroll
        for (int r = 0; r < 4; ++r) KV[(16 * dt + 4 * g + r) * 64 + 16 * (2 * (F.wave & 1) + j) + ti] = acc[j][r];
    lc_store(F, lc); WG_SYNC_LDS();
}

constexpr int XCB = 264;
__device__ __forceinline__ void lru_local_mfma(const Frame& F, unsigned char* ws, const LruW& W, int l, int task, float* out_conv) {
    const bf16_t* ZF = (const bf16_t*)(ws + WS_ZF); float* ACUM = (float*)(ws + WS_ACUM); float* HLOC = (float*)(ws + WS_HLOC);
    const int b = task >> 7, ck = task & 127, t0 = ck * 64, row0 = b * SEQ + t0;
    LAS float* xc = (LAS float*)F.lds;
    LAS bf16_t* xcb = (LAS bf16_t*)(F.lds + 65536);
    for (int idx = F.tid; idx < 64 * 64; idx += NTHR) { const int t = idx >> 6, c4 = (idx & 63) * 4;
        f32x4 acc = *(const f32x4*)(W.convb + c4);
#pragma unroll
        for (int tap = 0; tap < 4; ++tap) { const int tt = t0 + t - 3 + tap; if (tt >= 0) acc += *(const f32x4*)(W.convw + tap * 256 + c4) * ldbf4(ZF + (size_t)(b * SEQ + tt) * 1536 + ZC_XA + c4); }
        *(LAS f32x4*)(xc + t * 256 + c4) = acc; u32x2v w; w.x = pk2(acc[0], acc[1]); w.y = pk2(acc[2], acc[3]); *(LAS u32x2v*)(xcb + t * XCB + c4) = w; }
    if (ck == 127 && F.tid < 256) {
#pragma unroll
        for (int q = 0; q < 3; ++q) out_conv[(b * 3 + q) * 256 + F.tid] = bf2f(ZF[(size_t)(row0 + 61 + q) * 1536 + ZC_XA + F.tid]); }
    WG_SYNC();
    const int lane = F.lane, ti = lane & 15, g = lane >> 4, n = F.wave >> 1, jh = F.wave & 1;
    const bf16_t* LWT = (const bf16_t*)(ws + WS_LRUW) + (size_t)(l * 2) * 4 * 4096 + (size_t)n * 4096;
    f32x4 aa[4][2], ax[4][2];
#pragma unroll
    for (int tt = 0; tt < 4; ++tt)
#pragma unroll
        for (int jt = 0; jt < 2; ++jt) { aa[tt][jt] = (f32x4){0.f, 0.f, 0.f, 0.f}; ax[tt][jt] = (f32x4){0.f, 0.f, 0.f, 0.f}; }
#pragma unroll
    for (int ks = 0; ks < 2; ++ks) { bf16x8 wfa[2], wfx[2], xf[4];
#pragma unroll
        for (int jt = 0; jt < 2; ++jt) { const bf16_t* wp = LWT + (size_t)(32 * jh + 16 * jt + ti) * 64 + 32 * ks + 8 * g; wfa[jt] = *(const bf16x8*)wp; wfx[jt] = *(const bf16x8*)(wp + 4 * 4096); }
#pragma unroll
        for (int tt = 0; tt < 4; ++tt) xf[tt] = *(const LAS bf16x8*)(xcb + (16 * tt + ti) * XCB + n * 64 + 32 * ks + 8 * g);
#pragma unroll
        for (int tt = 0; tt < 4; ++tt)
#pragma unroll
            for (int jt = 0; jt < 2; ++jt) { aa[tt][jt] = __builtin_amdgcn_mfma_f32_16x16x32_bf16(xf[tt], wfa[jt], aa[tt][jt], 0, 0, 0); ax[tt][jt] = __builtin_amdgcn_mfma_f32_16x16x32_bf16(xf[tt], wfx[jt], ax[tt][jt], 0, 0, 0); } }
#pragma unroll
    for (int jt = 0; jt < 2; ++jt) { const int c = n * 64 + 32 * jh + 16 * jt + ti; const float ba = W.ba[c], bx = W.bx[c], sp = 0.6931471805599453f * flog2(1.f + fexp(-W.lam[c]));
        float Ac = 1.f, Hc = 0.f;
#pragma unroll
        for (int tt = 0; tt < 4; ++tt) { float Al[4], Hl[4]; float A = 1.f, H = 0.f;
#pragma unroll
            for (int r = 0; r < 4; ++r) { const int t = 16 * tt + 4 * g + r; const float rg = sigmoidf_(aa[tt][jt][r] + ba), ig = sigmoidf_(ax[tt][jt][r] + bx); const float la = -8.0f * rg * sp, av = fexp(la);
                const float u = fsqrt(1.f - fexp(2.f * la)) * (ig * xc[t * 256 + c]); H = av * H + u; A *= av; Al[r] = A; Hl[r] = H; }
            float Ai = A, Hi = H;
            { const float Ap = bperm_(Ai, lane - 16), Hp = bperm_(Hi, lane - 16); if (g >= 1) { Hi = Ai * Hp + Hi; Ai = Ai * Ap; } }
            { const float Ap = bperm_(Ai, lane - 32), Hp = bperm_(Hi, lane - 32); if (g >= 2) { Hi = Ai * Hp + Hi; Ai = Ai * Ap; } }
            float Ae = bperm_(Ai, lane - 16), He = bperm_(Hi, lane - 16); if (g == 0) { Ae = 1.f; He = 0.f; }
            const float Hin = Ae * Hc + He, Ain = Ae * Ac;
#pragma unroll
            for (int r = 0; r < 4; ++r) { const int t = 16 * tt + 4 * g + r; ACUM[(size_t)(row0 + t) * 256 + c] = Al[r] * Ain; HLOC[(size_t)(row0 + t) * 256 + c] = Al[r] * Hin + Hl[r]; }
            const float At = bperm_(Ai, 48 + ti), Ht = bperm_(Hi, 48 + ti); Hc = At * Hc + Ht; Ac = At * Ac; }
        if (g == 0) { ((float*)(ws + WS_CA))[(size_t)task * 256 + c] = Ac; ((float*)(ws + WS_CH))[(size_t)task * 256 + c] = Hc; } }
    WG_SYNC();
}

constexpr int PH_PRO = 0, PH_MEM = 1, PH_L0 = 2, PH_PER_L = 13, PH_FIN = PH_L0 + NL * PH_PER_L, N_PHASES = PH_FIN + 1;

__device__ __forceinline__ const float* ain(const Args& a, int i) { asm volatile("" : "+s"(i)); return (const float*)(const GAS float*)(unsigned long long)a.in[i]; }
#define AIN(i) ain(a, (i))
#define WSL unsigned long long wsi_ = (unsigned long long)ws0; asm volatile("" : "+s"(wsi_)); unsigned char* ws = (unsigned char*)(GAS unsigned char*)wsi_
__device__ __forceinline__ int lc_idx(int G, int l, int cs) { return (G == 256 && cs < 2044) ? (l * 32 + cs / 146) * 146 + cs % 146 : LC_NCHUNK; }
__device__ __forceinline__ int cp_blk(int l, int i) { const int pl = 14 + (i >> 6), q = i & 63; return pl < 32 ? (((l * 32 + pl) << 6) | q) : ((1 << 13) | ((l * 32 + pl - 32) << 6) | q); }
__global__ void __launch_bounds__(NTHR, 2) fwd(Args a) {
    extern __shared__ __attribute__((aligned(16))) unsigned char lds_raw[];
    Frame F0; Frame& F = F0;
    F.lds = (LAS unsigned char*)lds_raw;
    F.tid = 0; F.lane = 0; F.wave = __builtin_amdgcn_readfirstlane(threadIdx.x >> 6);
    F.G = gridDim.x; F.wg = blockIdx.x;
    unsigned char* ws0 = a.ws;
    gu32* ctl = (gu32*)(GAS unsigned char*)(unsigned long long)(ws0 + WS_CTL);
    for (int u = threadIdx.x; u < (LDS_BYTES - LDSCTL_OFF) / 4; u += NTHR) ((LAS unsigned*)(F.lds + LDSCTL_OFF))[u] = 0u;
    __syncthreads();
    XcdBarrier bar = xcd_barrier_post((unsigned*)(ctl + CW_BAR), (volatile LAS unsigned*)(F.lds + LDSCTL_OFF + 64));
#define IN(k) true
#ifdef DBGT
    if (blockIdx.x == 0 && threadIdx.x == 0) *(volatile LAS unsigned long long*)(F0.lds + LDSCTL_OFF + 128) = __builtin_amdgcn_s_memrealtime();
#endif
#if defined(DBGT) && DBGT == 4
#define TT0() unsigned long long tt0_ = __builtin_amdgcn_s_memrealtime(); const unsigned long long ttp_ = tt0_
#define TTA(k, wv) do { const unsigned long long t1_ = __builtin_amdgcn_s_memrealtime(); if (F.lane == 0) { if ((k) == 5) { atomicMax((unsigned*)(ctl + CW_DBG + 96 + 3), (unsigned)(t1_ - ttp_)); atomicAdd((unsigned*)(ctl + CW_DBG + 96 + 4), (unsigned)(t1_ - ttp_) >> 5); } \
        else if ((k) >= 2 && (k) <= 4) atomicMax((unsigned*)(ctl + CW_DBG + 96 + (k) - 2), (unsigned)(t1_ - tt0_)); } tt0_ = t1_; } while (0)
#elif defined(DBGT) && DBGT == 3
#define TT0() unsigned long long tt0_ = __builtin_amdgcn_s_memrealtime()
#define TTA(k, wv) do { const unsigned long long t1_ = __builtin_amdgcn_s_memrealtime(); if (blockIdx.x == 0 && F.wave == (wv) && F.lane == 0) atomicAdd((unsigned*)(ctl + CW_DBG + 96 + (k)), (unsigned)(t1_ - tt0_)); tt0_ = t1_; } while (0)
#else
#define TT0() do { } while (0)
#define TTA(k, wv) do { } while (0)
#endif
#ifdef DBGT
#define STAMP(k) do { if (blockIdx.x == 0 && threadIdx.x == 0) { const unsigned long long t_ = __builtin_amdgcn_s_memrealtime(); const int ty_ = (k) < 2 ? (k) : ((k) == PH_FIN ? 15 : 2 + ((k) - 2) % 13); \
        atomicAdd((unsigned*)(ctl + CW_DBG + 64 + ty_), (unsigned)(t_ - *(volatile LAS unsigned long long*)(F0.lds + LDSCTL_OFF + 128))); *(volatile LAS unsigned long long*)(F0.lds + LDSCTL_OFF + 128) = t_; } } while (0)
#else
#define STAMP(k) do { } while (0)
#endif
#define SEAM(k) do { if (IN(k) && IN((k) + 1)) { XcdBarrier b_ = bar; unsigned long long bi_ = (unsigned long long)bar.bar; asm volatile("" : "+s"(bi_), "+s"(b_.x)); b_.bar = (unsigned*)(GAS unsigned*)bi_; xcd_barrier(b_); STAMP(k); } } while (0)
#define FRESH(Fn) Frame Fn = F0; asm volatile("" : "+s"(Fn.wave), "+s"(Fn.G), "+s"(Fn.wg)); Fn.lane = (int)__builtin_amdgcn_mbcnt_hi(~0u, __builtin_amdgcn_mbcnt_lo(~0u, 0u)); asm volatile("" : "+v"(Fn.lane)); Fn.tid = Fn.wave * 64 + Fn.lane

#ifdef DBG
#define OUTL float* OUTS = (float*)(ws + WS_SHADOW); float* XP = OUTS + O_YP; float* XS = OUTS + O_YS; (void)XP; (void)XS
#else
#define OUTL unsigned long long outi_ = (unsigned long long)a.out; asm volatile("" : "+s"(outi_)); float* OUTS = (float*)(GAS float*)outi_; float* XP = OUTS + O_YP; float* XS = OUTS + O_YS; (void)XP; (void)XS
#endif
    if (IN(PH_PRO)) { FRESH(F); WSL; OUTL; p0_prologue(F, a);
        for (int e = F.wg * NTHR + F.tid; e < MS * D / 4; e += F.G * NTHR) ((f32x4*)XS)[e] = ((const f32x4*)AIN(I_XS))[e]; }
    SEAM(PH_PRO);
    if (IN(PH_MEM)) { FRESH(F); WSL;
        pg8::Gemm g{(const bf16_t*)(ws + WS_MEMB), (const bf16_t*)(ws + WS_WKV), D, D, D, 0, 0, 256 * D};
        pg8::StaticOrder S; S.init(512, 8192, F.G, F.G == 256 ? (F.wg >= 128 ? F.wg - 128 : 4096) : F.wg);
        EpiMem E{a.out + O_PMK, a.out + O_PMV, (bf16_t*)(ws + WS_MEMK), (bf16_t*)(ws + WS_MEMVT), (float*)(ws + WS_KMAX)};
        pg8::gemm_phase<EpiMem, pg8::StaticOrder, false, true>(F.lds, g, S, E, F.wave);
        if (F.G != 256) p1_cache_copy(F, a);
    }
    if (F0.G != 256) SEAM(PH_MEM);
#if defined(DBG) && !defined(DBGT)
    if (0 && IN(PH_MEM) && F.wg == F.G - 1) { FRESH(F); WSL;
        for (int i = 0; i < 16; ++i) { const unsigned hsh = (unsigned)(i * 8 + F.wave) * 2654435761u; const int l = hsh & 3, kv = (hsh >> 2) & 1, b = (hsh >> 3) & 1, m = (hsh >> 4) & 255, n = (hsh >> 12) & 1023;
            const float* A = AIN(I_MEMP) + (size_t)(b * 256 + m) * D; const float* W = AIN(kv ? I_XWV : I_XWK) + (size_t)l * D * D + n;
            const float ref = ndot([&](int k) { return A[k]; }, W, D, D, F.lane);
            const float got = (a.out + (kv ? O_PMV : O_PMK))[((size_t)((l * 2 + b) * 256 + m)) * 1024 + n];
            const float gb = kv ? bf2f(((const bf16_t*)(ws + WS_MEMVT))[((size_t)(l * 2 + b) * 1024 + n) * 256 + m]) : bf2f(((const bf16_t*)(ws + WS_MEMK))[((size_t)((l * 2 + b) * 256 + m)) * 1024 + n]);
            if (F.lane == 0) { atomicAdd((float*)(ctl + CW_DBG + 0), (got - ref) * (got - ref)); atomicAdd((float*)(ctl + CW_DBG + 1), ref * ref);
                               atomicAdd((float*)(ctl + CW_DBG + 2), (gb - ref) * (gb - ref)); atomicAdd((float*)(ctl + CW_DBG + 3), ref * ref); } }
    }
#endif
#pragma unroll 1
    for (int l = 0; l < NL; ++l) {
        const int pb = PH_L0 + l * PH_PER_L;
        if (IN(pb + 0)) { FRESH(F); WSL; OUTL; phase_ffn_up(F, ws, (const bf16_t*)(ws + WS_W) + (size_t)l * LW_SZ + LW_1U, XS); }
        SEAM(pb + 0);
#if defined(DBG) && !defined(DBGT)
        if (l == 0 && IN(pb + 0) && F.wg == F.G - 1) { FRESH(F); WSL; OUTL;
            for (int i = 0; i < 8; ++i) { const unsigned hsh = (unsigned)(i * 8 + F.wave + 1) * 2654435761u; int row = (hsh >> 4) % MT; if (i == 7) row = M + (hsh >> 4) % MS; const int c = (hsh >> 19) % FF;
                const float* x = row < M ? AIN(I_XP) + (size_t)row * D : AIN(I_XS) + (size_t)(row - M) * D; const float* gn = AIN(I_NF1);
                const float ss = ndot([&](int k) { return x[k]; }, x, D, 1, F.lane); const float rs = frsq(ss / D + EPS);
                const float gv = ndot([&](int k) { return x[k] * rs * gn[k]; }, AIN(I_F1G) + c, D, FF, F.lane), uv = ndot([&](int k) { return x[k] * rs * gn[k]; }, AIN(I_F1U) + c, D, FF, F.lane);
                const float ref = gv / (1.f + fexp(-gv)) * uv, got = bf2f(((const bf16_t*)(ws + WS_ACT))[(size_t)row * FF + c]);
                if (F.lane == 0) { atomicAdd((float*)(ctl + CW_DBG + 4), (got - ref) * (got - ref)); atomicAdd((float*)(ctl + CW_DBG + 5), ref * ref); } }
        }
#endif
        if (IN(pb + 1)) { FRESH(F); WSL; OUTL; phase_resid(F, ws, (const bf16_t*)(ws + WS_ACT), FF, (const bf16_t*)(ws + WS_W) + (size_t)l * LW_SZ + LW_1D, l == 0 ? AIN(I_XP) : nullptr, XS, 0.5f); }
        SEAM(pb + 1);
#if defined(DBG) && !defined(DBGT)
        if (l == 0 && IN(pb + 1) && F.wg == F.G - 1) { FRESH(F); WSL; OUTL;
            for (int i = 0; i < 8; ++i) { const unsigned hsh = (unsigned)(i * 8 + F.wave + 77) * 2654435761u; int row = (hsh >> 4) % MT; if (i == 7) row = M + (hsh >> 4) % MS; const int n = (hsh >> 19) % D;
                const float xo = row < M ? AIN(I_XP)[(size_t)row * D + n] : AIN(I_XS)[(size_t)(row - M) * D + n]; const bf16_t* ar = (const bf16_t*)(ws + WS_ACT) + (size_t)row * FF;
                const float ref = xo + 0.5f * ndot([&](int k) { return bf2f(ar[k]); }, AIN(I_F1D) + n, FF, D, F.lane);
                const float* xr = row < M ? XP + (size_t)row * D : XS + (size_t)(row - M) * D; const float got = xr[n];
                const float ss = ndot([&](int k) { return xr[k]; }, xr, D, 1, F.lane);
                float sp = 0.f; if (row < M) { if (F.lane < 16) sp = ((const float*)(ws + WS_SSQ))[(size_t)row * 16 + F.lane]; } else sp = ((const float*)(ws + WS_SSQS))[(size_t)(row - M) * 64 + F.lane]; sp = wave_sum(sp);
                const float xbv = bf2f(((const bf16_t*)(ws + WS_XB))[(size_t)row * D + n]);
                if (F.lane == 0) { atomicAdd((float*)(ctl + CW_DBG + 6), (got - ref) * (got - ref) + (xbv - got) * (xbv - got)); atomicAdd((float*)(ctl + CW_DBG + 7), ref * ref);
                                   atomicAdd((float*)(ctl + CW_DBG + 8), (sp - ss) * (sp - ss)); atomicAdd((float*)(ctl + CW_DBG + 9), ss * ss); } }
        }
#endif
        if (IN(pb + 2)) { FRESH(F); WSL; OUTL; phase_win(F, ws, (const bf16_t*)(ws + WS_W) + (size_t)l * LW_SZ + LW_IN, OUTS + O_PSK + (size_t)l * NB * WINDOW * 512, XS); }
        SEAM(pb + 2);
#if defined(DBG) && !defined(DBGT)
        if (l == 0 && IN(pb + 2) && F.wg == F.G - 1) { FRESH(F); WSL; OUTL;
            for (int i = 0; i < 12; ++i) { const unsigned hsh = (unsigned)(i * 8 + F.wave + 177) * 2654435761u; int row = (hsh >> 4) % M; if (i >= 10) row = M + (hsh >> 4) % MS; if (i == 8 || i == 9) row = (row & 8191) | 6144 | (row & 8192 ? 8192 : 0);
                int n = (hsh >> 19) % DIN; if (i == 8) n = 2048 + n % 512; if (i == 9) n = 2560 + n % 512;
                const float* xr = row < M ? XP + (size_t)row * D : XS + (size_t)(row - M) * D; const float* gn = AIN(I_NMIX);
                const float ss = ndot([&](int k) { return xr[k]; }, xr, D, 1, F.lane); const float rs = frsq(ss / D + EPS);
                const float ref = ndot([&](int k) { return xr[k] * rs * gn[k]; }, AIN(I_WIN) + n, D, DIN, F.lane);
                float got, got2 = ref;
                if (row >= M) got = ((const float*)(ws + WS_ZS))[(size_t)(row - M) * DIN + n];
                else if (n < 1536) got = ((const float*)(ws + WS_ZF))[(size_t)row * 1536 + n];
                else { const int gsel = (n - 1536) / 512, c512 = (n - 1536) % 512, h = c512 >> 6, d = c512 & 63, b = row >> 13, t = row & 8191;
                    const bf16_t* src = (const bf16_t*)(ws + (gsel == 0 ? WS_QA : (gsel == 1 ? WS_KA : WS_VA))); got = bf2f(src[((size_t)(b * 8 + h) * SEQ + t) * 64 + d]);
                    if (gsel >= 1 && t >= SEQ - WINDOW) got2 = (OUTS + (gsel == 1 ? O_PSK : O_PSV))[((size_t)(b * WINDOW + t - (SEQ - WINDOW)) * 8 + h) * 64 + d]; }
                if (F.lane == 0) { atomicAdd((float*)(ctl + CW_DBG + 10), (got - ref) * (got - ref) + (got2 - ref) * (got2 - ref)); atomicAdd((float*)(ctl + CW_DBG + 11), ref * ref); } }
        }
#endif
        if (IN(pb + 3)) { FRESH(F); WSL; OUTL; const LruW LW{AIN(I_CONVW) + l * 1024, AIN(I_CONVB) + l * 256, AIN(I_LWA) + (size_t)l * 16384, AIN(I_LBA) + l * 256, AIN(I_LWX) + (size_t)l * 16384, AIN(I_LBX) + l * 256, AIN(I_LAM) + l * 256, AIN(I_GNA) + l * 256};
            const float* LBP = AIN(I_HLB); const float* HNORM = AIN(I_HNORM) + l * 64; bf16_t* Ybuf = (bf16_t*)(ws + WS_Y); float* ZS = (float*)(ws + WS_ZS); (void)LW; (void)LBP; (void)HNORM; (void)Ybuf; (void)ZS;
            TT0();
            for (int task = F.wg; task < 256; task += F.G) lru_local_mfma(F, ws, LW, l, task, OUTS + O_PLC + (size_t)l * NB * 768);
            TTA(0, 3);
            { HgLocPre Pa, Pb; hgrn_local_load(F, ws, F.wg & 1023, Pa);
#pragma unroll 1
              for (int task = F.wg; task < 1024; task += 2 * F.G) { const int n1 = task + F.G, n2 = task + 2 * F.G;
                  hgrn_local_load(F, ws, n1 < 1024 ? n1 : task, Pb); hgrn_local_mfma(F, ws, LBP, l, task, Pa, lc_chunk(AIN(I_CSK), a.out, lc_idx(F.G, l, F.wg * 8 + (task >> 8))));
                  if (n1 < 1024) { hgrn_local_load(F, ws, n2 < 1024 ? n2 : n1, Pa); hgrn_local_mfma(F, ws, LBP, l, n1, Pb, lc_chunk(AIN(I_CSK), a.out, lc_idx(F.G, l, F.wg * 8 + (n1 >> 8)))); } } }
            TTA(1, 3);
            for (int s = F.G - 1 - F.wg; s < 160; s += F.G) {
                if (s < 32) lru_seq<0>(F, LW, ZS + (size_t)s * 4 * DIN, DIN, 4, AIN(I_SLC) + (size_t)(l * 32 + s) * 768, AIN(I_SLH) + (size_t)(l * 32 + s) * 256, Ybuf + (size_t)(M + s * 4) * D,
                                       OUTS + O_SLH + (size_t)(l * 32 + s) * 256, OUTS + O_SLC + (size_t)(l * 32 + s) * 768, ctl, 0);
                else { const int sb = (s - 32) >> 2, hh = (s - 32) & 3; const size_t so = ((size_t)(l * 32 + sb) * 4 + hh) * 4096;
                    hgrn_seq<0>(F, LBP, HNORM, l, hh, ZS + (size_t)sb * 4 * DIN, DIN, 4, AIN(I_SHG) + so, Ybuf + (size_t)(M + sb * 4) * D, OUTS + O_SHG + so, ctl, 0); }
            }
        }
        SEAM(pb + 3);
        if (IN(pb + 4)) { FRESH(F); WSL; OUTL; const LruW LW{AIN(I_CONVW) + l * 1024, AIN(I_CONVB) + l * 256, AIN(I_LWA) + (size_t)l * 16384, AIN(I_LBA) + l * 256, AIN(I_LWX) + (size_t)l * 16384, AIN(I_LBX) + l * 256, AIN(I_LAM) + l * 256, AIN(I_GNA) + l * 256};
            const float* LBP = AIN(I_HLB); const float* HNORM = AIN(I_HNORM) + l * 64; bf16_t* Ybuf = (bf16_t*)(ws + WS_Y); float* ZS = (float*)(ws + WS_ZS); (void)LW; (void)LBP; (void)HNORM; (void)Ybuf; (void)ZS;
            if (F.tid == 0) *(volatile LAS unsigned*)(F.lds + LDSCTL_OFF + 192) = 0u;
            WG_SYNC();
            TT0();
            if (F.wave < 2) { for (int chain = F.wg * 2 + F.wave; chain < 512; chain += F.G * 2) { const int bh = chain >> 6, dr = chain & 63; float S = 0.f;
                    const float* KV = (const float*)(ws + WS_HKV) + (size_t)bh * 128 * 4096 + dr * 64 + F.lane; const float* DEC = (const float*)(ws + WS_HDEC) + (size_t)bh * 128 * 64 + dr; float* SP = (float*)(ws + WS_HSP) + (size_t)bh * 128 * 4096 + dr * 64 + F.lane;
#pragma unroll 1
                    for (int cb = 0; cb < 128; cb += 16) { float kvv[16], dcv[16];
#pragma unroll
                        for (int i = 0; i < 16; ++i) { kvv[i] = KV[(size_t)(cb + i) * 4096]; dcv[i] = DEC[(cb + i) * 64]; }
#pragma unroll
                        for (int i = 0; i < 16; ++i) { SP[(size_t)(cb + i) * 4096] = S; S = dcv[i] * S + kvv[i]; } }
                    (OUTS + O_PHG)[((size_t)(l * 8 + bh)) * 4096 + dr * 64 + F.lane] = S; } TTA(2, 0); }
            else if (F.wave == 2) { for (int t = F.wg; t < 8; t += F.G) { const int b = t >> 2, ch = (t & 3) * 64 + F.lane; float hc = 0.f;
                    const float* CA = (const float*)(ws + WS_CA) + (size_t)b * 128 * 256 + ch; const float* CH = (const float*)(ws + WS_CH) + (size_t)b * 128 * 256 + ch; float* HIN = (float*)(ws + WS_HIN) + (size_t)b * 128 * 256 + ch;
#pragma unroll 1
                    for (int cb = 0; cb < 128; cb += 16) { float cav[16], chv[16];
#pragma unroll
                        for (int i = 0; i < 16; ++i) { cav[i] = CA[(cb + i) * 256]; chv[i] = CH[(cb + i) * 256]; }
#pragma unroll
                        for (int i = 0; i < 16; ++i) { HIN[(cb + i) * 256] = hc; hc = cav[i] * hc + chv[i]; } }
                    (OUTS + O_PLH)[(l * 2 + b) * 256 + ch] = hc; } }
            { volatile LAS unsigned* qctr = (volatile LAS unsigned*)(F.lds + LDSCTL_OFF + 192);
              const int nunits = (512 - F.wg + F.G - 1) / F.G, nsamp = (1024 - F.wg + F.G - 1) / F.G, ncopy = F.G == 256 ? 7 : 0, ntask = nunits * 4 + nsamp + ncopy;
              for (;;) { Frame Ft = F; asm volatile("" : "+v"(Ft.lane)); Ft.tid = Ft.wave * 64 + Ft.lane;
                  unsigned id = 0; if (Ft.lane == 0) id = atomicAdd((unsigned*)qctr, 1u); id = __builtin_amdgcn_readfirstlane(id); if ((int)id >= ntask) break;
                  if ((int)id >= nsamp + nunits * 4) { cache_copy_block_wave(Ft.lane, AIN(I_CSK), AIN(I_CSV), a.out, cp_blk(l, F.wg + 256 * ((int)id - nsamp - nunits * 4))); }
                  else if ((int)id >= nsamp) { const int id2 = (int)id - nsamp; const int uk = id2 >> 2, r = id2 & 3; int u = F.wg + uk * F.G;
                      if (F.G == 256) u = ((F.wg & 7) + 8 * uk) * 32 + (F.wg >> 3);
                      const int b = u >> 8, h = (u >> 5) & 7, P = u & 31;
                      attn_wave_task4(Ft, ws, b, h, P, r, F.lds + F.wave * ATT_WAVE_LDS); TTA(3, 3); }
                  else { const int sid = F.wg + (int)id * F.G; const int t = sid & 3, h = (sid >> 2) & 7, sb = sid >> 5, row = sb * 4 + t, part = Ft.lane & 3;
                      float q[16], o[16];
#pragma unroll
                      for (int i = 0; i < 16; ++i) q[i] = ZS[(size_t)row * DIN + ZC_QC + h * 64 + part * 16 + i];
                      KVDecode kv{AIN(I_CSK) + (size_t)(l * 32 + sb) * WINDOW * 512, AIN(I_CSV) + (size_t)(l * 32 + sb) * WINDOW * 512, ZS + (size_t)sb * 4 * DIN, h};
                      attn_naive(kv, q, WINDOW + t, h, Ft.lane, o);
                      if (Ft.lane < 4) { float* yc = (float*)(ws + WS_YC) + (size_t)(M + row) * 512 + h * 64 + part * 16;
#pragma unroll
                          for (int i = 0; i < 16; ++i) yc[i] = o[i]; } TTA(4, 3); } }
              if (F.G == 256) for (;;) { Frame Ft = F; asm volatile("" : "+v"(Ft.lane)); unsigned id = 0; if (Ft.lane == 0) id = atomicAdd((unsigned*)(ctl + CW_CPQ + 64 * l), 1u); id = __builtin_amdgcn_readfirstlane(id); if (id >= 1408u) break;
                  cache_copy_block_wave(Ft.lane, AIN(I_CSK), AIN(I_CSV), a.out, cp_blk(l, 1792 + (int)id)); }
              TTA(5, 3); }
            { FRESH(Fe);
            for (int e = Fe.wg * NTHR + Fe.tid; e < MS * 256; e += Fe.G * NTHR) { const int row = e >> 8, c4 = (e & 255) * 4, kvs = c4 >> 9, cc = c4 & 511, sb = row >> 2, t = row & 3;
                *(f32x4*)(a.out + (kvs ? O_SSV : O_SSK) + ((size_t)(l * 32 + sb) * WINDOW + (WINDOW - STOK) + t) * 512 + cc) = *(const f32x4*)(ZS + (size_t)row * DIN + ZC_KC + kvs * 512 + cc); } }
        }
        SEAM(pb + 4);
        if (IN(pb + 5)) { FRESH(F); WSL; OUTL; const LruW LW{AIN(I_CONVW) + l * 1024, AIN(I_CONVB) + l * 256, AIN(I_LWA) + (size_t)l * 16384, AIN(I_LBA) + l * 256, AIN(I_LWX) + (size_t)l * 16384, AIN(I_LBX) + l * 256, AIN(I_LAM) + l * 256, AIN(I_GNA) + l * 256};
            const float* LBP = AIN(I_HLB); const float* HNORM = AIN(I_HNORM) + l * 64; bf16_t* Ybuf = (bf16_t*)(ws + WS_Y); float* ZS = (float*)(ws + WS_ZS); (void)LW; (void)LBP; (void)HNORM; (void)Ybuf; (void)ZS;
            TT0();
            { HgOutPre Pa, Pb; hgrn_out_load(F, ws, F.wg & 1023, Pa);
#pragma unroll 1
              for (int task = F.wg; task < 1024; task += 2 * F.G) { const int n1 = task + F.G, n2 = task + 2 * F.G;
                  hgrn_out_load(F, ws, n1 < 1024 ? n1 : task, Pb); hgrn_out_mfma(F, ws, LBP, HNORM, l, task, Pa, lc_chunk(AIN(I_CSK), a.out, lc_idx(F.G, l, F.wg * 8 + 4 + (task >> 8))));
                  if (n1 < 1024) { hgrn_out_load(F, ws, n2 < 1024 ? n2 : n1, Pa); hgrn_out_mfma(F, ws, LBP, HNORM, l, n1, Pb, lc_chunk(AIN(I_CSK), a.out, lc_idx(F.G, l, F.wg * 8 + 4 + (n1 >> 8)))); } } }
            TTA(6, 3);
            const float* GNC = AIN(I_GNC) + l * 512; const bf16_t* ZF = (const bf16_t*)(ws + WS_ZF);
            { const int NROWW = F.G * NWAVES, gw = F.wg * NWAVES + F.wave, c4 = 4 * F.lane;
              const f32x4 gn = *(const f32x4*)(LW.gna + c4), g0 = *(const f32x4*)(GNC + 8 * F.lane), g1 = *(const f32x4*)(GNC + 8 * F.lane + 4);
#pragma unroll 1
              for (int rb = gw; rb < M; rb += 4 * NROWW) {
                  f32x4 ac[4], hl[4], hi[4], ga[4], y0[4], y1[4];
#pragma unroll
                  for (int i = 0; i < 4; ++i) { const int rr = rb + i * NROWW, row = rr < M ? rr : M - 1; const int b = row >> 13, ck = (row & 8191) >> 6;
                      ac[i] = *(const f32x4*)((const float*)(ws + WS_ACUM) + (size_t)row * 256 + c4); hl[i] = *(const f32x4*)((const float*)(ws + WS_HLOC) + (size_t)row * 256 + c4);
                      hi[i] = *(const f32x4*)((const float*)(ws + WS_HIN) + (size_t)(b * 128 + ck) * 256 + c4); ga[i] = ldbf4(ZF + (size_t)row * 1536 + ZC_GA + c4);
                      const float* yc = (const float*)(ws + WS_YC) + (size_t)row * 512 + 8 * F.lane; y0[i] = *(const f32x4*)yc; y1[i] = *(const f32x4*)(yc + 4); }
#pragma unroll
                  for (int i = 0; i < 4; ++i) { const int row = rb + i * NROWW; f32x4 y; float ss = 0.f;
#pragma unroll
                      for (int e = 0; e < 4; ++e) { y[e] = (ac[i][e] * hi[i][e] + hl[i][e]) * gelu_tanh(ga[i][e]); ss += y[e] * y[e]; }
                      ss = wave_sum(ss); const float rs = frsq(ss * (1.f / 256.f) + EPS);
                      const float s2 = wave_sum(sq4(y0[i]) + sq4(y1[i])); const float r2 = frsq(s2 * (1.f / 512.f) + EPS);
                      if (row < M) { u32x2v w; w.x = pk2(y[0] * rs * gn[0], y[1] * rs * gn[1]); w.y = pk2(y[2] * rs * gn[2], y[3] * rs * gn[3]); *(u32x2v*)(Ybuf + (size_t)row * D + c4) = w;
                          *(u32x4*)(Ybuf + (size_t)row * D + 512 + 8 * F.lane) = pack8(y0[i] * g0 * r2, y1[i] * g1 * r2); } } }
              for (int row = M + gw; row < MT; row += NROWW) { const float* yc = (const float*)(ws + WS_YC) + (size_t)row * 512 + 8 * F.lane; const f32x4 v0 = *(const f32x4*)yc, v1 = *(const f32x4*)(yc + 4);
                  const float ss = wave_sum(sq4(v0) + sq4(v1)); const float rs = frsq(ss * (1.f / 512.f) + EPS);
                  *(u32x4*)(Ybuf + (size_t)row * D + 512 + 8 * F.lane) = pack8(v0 * g0 * rs, v1 * g1 * rs); } }
            TTA(7, 3);
        }
        SEAM(pb + 5);
#if defined(DBG) && !defined(DBGT)
        if (l == 0 && IN(pb + 5)) { FRESH(F); WSL; OUTL; const LruW LW{AIN(I_CONVW) + l * 1024, AIN(I_CONVB) + l * 256, AIN(I_LWA) + (size_t)l * 16384, AIN(I_LBA) + l * 256, AIN(I_LWX) + (size_t)l * 16384, AIN(I_LBX) + l * 256, AIN(I_LAM) + l * 256, AIN(I_GNA) + l * 256};
            const float* LBP = AIN(I_HLB); const float* HNORM = AIN(I_HNORM) + l * 64; bf16_t* Ybuf = (bf16_t*)(ws + WS_Y); float* ZS = (float*)(ws + WS_ZS); (void)LW; (void)LBP; (void)HNORM; (void)Ybuf; (void)ZS;
            if (F.wg == F.G - 1) lru_seq<1>(F, LW, (const float*)(ws + WS_ZF) + (size_t)SEQ * 1536, 1536, 136, nullptr, nullptr, Ybuf + (size_t)SEQ * D, nullptr, nullptr, ctl, 6);
            if (F.wg == F.G - 2) hgrn_seq<1>(F, LBP, HNORM, l, 2, (const float*)(ws + WS_ZF) + (size_t)SEQ * 1536, 1536, 136, nullptr, Ybuf + (size_t)SEQ * D, nullptr, ctl, 7);
            if (F.wg == F.G - 3) { for (int i = 0; i < 6; ++i) { const unsigned hsh = (unsigned)(i * 8 + F.wave + 301) * 2654435761u; const int b = (hsh >> 3) & 1, h = (hsh >> 4) & 7; int pos = (hsh >> 8) % SEQ; if (i == 0) pos = (hsh >> 8) % 100; if (i == 1) pos = 128 + (hsh >> 8) % 1900;
                    const int part = F.lane & 3; float q[16], o[16];
                    const bf16_t* qp = (const bf16_t*)(ws + WS_QA) + ((size_t)(b * 8 + h) * SEQ + pos) * 64 + part * 16;
#pragma unroll
                    for (int e = 0; e < 16; ++e) q[e] = bf2f(qp[e]);
                    KVPrompt kv{(const bf16_t*)(ws + WS_KA) + (size_t)(b * 8 + h) * SEQ * 64, (const bf16_t*)(ws + WS_VA) + (size_t)(b * 8 + h) * SEQ * 64};
                    attn_naive(kv, q, pos, h, F.lane, o);
                    float dn = 0.f, dd = 0.f; if (F.lane < 4) { const float* yc = (const float*)(ws + WS_YC) + (size_t)(b * SEQ + pos) * 512 + h * 64 + part * 16;
#pragma unroll
                        for (int e = 0; e < 16; ++e) { dn += (yc[e] - o[e]) * (yc[e] - o[e]); dd += o[e] * o[e]; } }
                    dbg_acc(ctl, 8, dn, dd, F.lane); } }
        }
#endif
        if (IN(pb + 6)) { FRESH(F); WSL; OUTL; { const int e = F.wg * NTHR + F.tid; float z0 = 0.f; asm volatile("" : "+v"(z0)); if (e < MS * D / 4) ((f32x4*)(ws + WS_QXS))[e] = (f32x4){z0, z0, z0, z0}; }
            phase_resid(F, ws, (const bf16_t*)(ws + WS_Y), D, (const bf16_t*)(ws + WS_W) + (size_t)l * LW_SZ + LW_OUT, nullptr, XS, 1.0f); }
        SEAM(pb + 6);
        if (IN(pb + 7)) { FRESH(F); WSL; OUTL; const bf16_t* LWb = (const bf16_t*)(ws + WS_W) + (size_t)l * LW_SZ;
            bf16_t* XB = (bf16_t*)(ws + WS_XB); bf16_t* QX = (bf16_t*)(ws + WS_QX);
            pg8::Gemm g{XB, LWb + LW_Q, D, D, D, 0, 0, 256 * D}; pg8::StaticOrder S; S.init(M, D, F.G, F.wg);
            EpiQx E{QX, (float*)(ws + WS_QSS), (const float*)(ws + WS_SSQ)};
            pg8::gemm_phase<EpiQx, pg8::StaticOrder, false, true>(F.lds, g, S, E, F.wave);
            int lane = F.lane; asm volatile("" : "+v"(lane));
            for (int t = F.wg; t < 256; t += F.G) { const int n0 = 16 * (t >> 2), k0 = 256 * (t & 3);
                const f32x4 ac = slab_f32a_q(XS + k0, LWb + LW_Q + (size_t)n0 * D + k0, F.wave, lane);
                float* qp = (float*)(ws + WS_QXS) + (size_t)(16 * F.wave + (lane & 15)) * D + n0 + 4 * (lane >> 4);
#pragma unroll
                for (int e = 0; e < 4; ++e) atomicAdd(qp + e, ac[e]); }
        }
        SEAM(pb + 7);
        if (IN(pb + 8)) { FRESH(F); WSL; OUTL;
            pg8::Gemm g{(const bf16_t*)(ws + WS_QX), (const bf16_t*)(ws + WS_MEMK) + (size_t)l * 2 * 256 * 1024, D, D, 256, 256, 256 * 1024, 256}; pg8::StaticOrder S; S.init(M, D, F.G, F.wg);
            EpiS E{(bf16_t*)(ws + WS_PB), (float*)(ws + WS_LS), (const float*)(ws + WS_QSS), (const float*)(ws + WS_KMAX) + l * 64};
            pg8::gemm_phase<EpiS, pg8::StaticOrder, false, true>(F.lds, g, S, E, F.wave);
            asm volatile("s_waitcnt vmcnt(0)" ::: "memory"); __syncthreads();
            { pg8::Gemm g2{(const bf16_t*)(ws + WS_PB), (const bf16_t*)(ws + WS_MEMVT) + (size_t)l * 2 * 1024 * 256, D, 256, 256, 256, 1024 * 256, 256 * 256}; pg8::StaticOrder S2; S2.init(M, D, F.G, F.wg);
              EpiPV E2{(bf16_t*)(ws + WS_OB), (const float*)(ws + WS_LS)};
              pg8::gemm_phase<EpiPV, pg8::StaticOrder, false, true>(F.lds, g2, S2, E2, F.wave); }
            FRESH(F2);
            for (int s = F.G - 1 - F.wg; s < 128; s += F.G) xattn_sample(F2, ws, AIN(I_CMK) + (size_t)l * 32 * 256 * 1024, AIN(I_CMV) + (size_t)l * 32 * 256 * 1024, s >> 2, s & 3, XS);
        }
        SEAM(pb + 9);
#if defined(DBG) && !defined(DBGT)
        if (l == 0 && IN(pb + 9) && F.wg == F.G - 1) { FRESH(F); WSL; OUTL;
            for (int i = 0; i < 6; ++i) { const unsigned hsh = (unsigned)(i * 8 + F.wave + 501) * 2654435761u; int row = (hsh >> 4) % M; if (i == 5) row = M + (hsh >> 4) % MS; const int h = (hsh >> 19) & 3, d = (hsh >> 21) & 255;
                const bf16_t* qr = (const bf16_t*)(ws + WS_QX) + (size_t)row * D + h * 256; float sv[4], mx = -INFINITY;
                for (int e = 0; e < 4; ++e) { const int m = F.lane * 4 + e; float s = 0.f;
                    if (row < M) { const bf16_t* kr = (const bf16_t*)(ws + WS_MEMK) + ((size_t)(l * 2 + (row >> 13)) * 256 + m) * 1024 + h * 256; for (int k = 0; k < 256; ++k) s += bf2f(qr[k]) * bf2f(kr[k]); }
                    else { const float* kr = AIN(I_CMK) + (((size_t)(l * 32 + ((row - M) >> 2)) * 256 + m) * 4 + h) * 256; for (int k = 0; k < 256; ++k) s += bf2f(qr[k]) * kr[k]; }
                    sv[e] = s / 16.f; mx = fmaxf(mx, sv[e]); }
                mx = wave_max(mx); float ps = 0.f, o = 0.f;
                for (int e = 0; e < 4; ++e) { const int m = F.lane * 4 + e; const float p = fexp(sv[e] - mx); ps += p;
                    const float v = row < M ? bf2f(((const bf16_t*)(ws + WS_MEMVT))[((size_t)(l * 2 + (row >> 13)) * 1024 + h * 256 + d) * 256 + m]) : AIN(I_CMV)[(((size_t)(l * 32 + ((row - M) >> 2)) * 256 + m) * 4 + h) * 256 + d];
                    o += p * v; }
                ps = wave_sum(ps); o = wave_sum(o) / ps; const float got = bf2f(((const bf16_t*)(ws + WS_OB))[(size_t)row * D + h * 256 + d]);
                const int n = (hsh >> 9) & 1023; const float* xr = row < M ? XP + (size_t)row * D : XS + (size_t)(row - M) * D; const float* gn = AIN(I_NCROSS);
                const float ss = ndot([&](int k) { return xr[k]; }, xr, D, 1, F.lane); const float rs = frsq(ss / D + EPS);
                const float qref = ndot([&](int k) { return xr[k] * rs * gn[k]; }, AIN(I_XWQ) + n, D, D, F.lane), qgot = bf2f(((const bf16_t*)(ws + WS_QX))[(size_t)row * D + n]);
                if (F.lane == 0) { atomicAdd((float*)(ctl + CW_DBG + 0), (got - o) * (got - o)); atomicAdd((float*)(ctl + CW_DBG + 1), o * o);
                                   atomicAdd((float*)(ctl + CW_DBG + 2), (qgot - qref) * (qgot - qref)); atomicAdd((float*)(ctl + CW_DBG + 3), qref * qref); } }
        }
#endif
        if (IN(pb + 10)) { FRESH(F); WSL; OUTL; phase_resid(F, ws, (const bf16_t*)(ws + WS_OB), D, (const bf16_t*)(ws + WS_W) + (size_t)l * LW_SZ + LW_O, nullptr, XS, 1.0f); }
        SEAM(pb + 10);
        if (IN(pb + 11)) { FRESH(F); WSL; OUTL; phase_ffn_up(F, ws, (const bf16_t*)(ws + WS_W) + (size_t)l * LW_SZ + LW_2U, XS); }
        SEAM(pb + 11);
        if (IN(pb + 12)) { FRESH(F); WSL; OUTL; phase_resid(F, ws, (const bf16_t*)(ws + WS_ACT), FF, (const bf16_t*)(ws + WS_W) + (size_t)l * LW_SZ + LW_2D, nullptr, XS, 0.5f); }
        SEAM(pb + 12);
    }
    if (IN(PH_FIN)) { FRESH(F); WSL; OUTL;
        const float* NF = AIN(I_NFIN);
        for (int row = F.wg * NWAVES + F.wave; row < MT; row += F.G * NWAVES) {
            float* xr = row < M ? XP + (size_t)row * D : XS + (size_t)(row - M) * D;
            f32x4 xv[4]; float ss = 0.f;
            if (row < M) { const u32x2v* hp = (const u32x2v*)((const bf16_t*)(ws + WS_XB) + (size_t)row * D) + F.lane; const u32x2v* lp = (const u32x2v*)((const bf16_t*)(ws + WS_XL) + (size_t)row * D) + F.lane;
#pragma unroll
                for (int jj = 0; jj < 4; ++jj) { const u32x2v hw = hp[64 * jj], lw = RESID_PAIR ? lp[64 * jj] : (u32x2v){0u, 0u};
                    xv[jj][0] = __builtin_bit_cast(float, hw.x << 16) + __builtin_bit_cast(float, lw.x << 16); xv[jj][1] = __builtin_bit_cast(float, hw.x & 0xffff0000u) + __builtin_bit_cast(float, lw.x & 0xffff0000u);
                    xv[jj][2] = __builtin_bit_cast(float, hw.y << 16) + __builtin_bit_cast(float, lw.y << 16); xv[jj][3] = __builtin_bit_cast(float, hw.y & 0xffff0000u) + __builtin_bit_cast(float, lw.y & 0xffff0000u); ss += sq4(xv[jj]); }
            } else {
#pragma unroll
                for (int jj = 0; jj < 4; ++jj) { xv[jj] = *((const f32x4*)xr + F.lane + 64 * jj); ss += sq4(xv[jj]); } }
            ss = wave_sum(ss); const float rs = frsq(ss * (1.0f / D) + EPS);
#pragma unroll
            for (int jj = 0; jj < 4; ++jj) { const f32x4 g = *((const f32x4*)NF + F.lane + 64 * jj); *((f32x4*)xr + F.lane + 64 * jj) = xv[jj] * g * rs; } }
    }
#ifdef DBG
    __syncthreads(); { XcdBarrier b_ = bar; unsigned long long bi_ = (unsigned long long)bar.bar; asm volatile("" : "+s"(bi_), "+s"(b_.x)); b_.bar = (unsigned*)(GAS unsigned*)bi_; xcd_barrier(b_); STAMP(PH_FIN); }
    __syncthreads(); { XcdBarrier b_ = bar; unsigned long long bi_ = (unsigned long long)bar.bar; asm volatile("" : "+s"(bi_), "+s"(b_.x)); b_.bar = (unsigned*)(GAS unsigned*)bi_; xcd_barrier(b_); }
    { FRESH(Fd); dbg_finish(Fd, a, ctl); }
#endif
#undef IN
#undef SEAM
}

extern "C" void kernel_launch(void* const* d_in, const int* in_sizes, int n_in, void* d_out, int out_size, void* d_ws, size_t ws_size, hipStream_t stream) {
    static int grid = 0;
    if (grid == 0) {
        if (n_in != N_IN || (size_t)out_size != O_END || ws_size < WS_TOTAL) { fprintf(stderr, "kernel_launch: unexpected shapes: n_in %d out %d ws %zu (need %zu)\n", n_in, out_size, ws_size, (size_t)WS_TOTAL); grid = -1; return; }
        int dev = 0, cus = 0, per_cu = 0;
        if (hipGetDevice(&dev) != hipSuccess || hipDeviceGetAttribute(&cus, hipDeviceAttributeMultiprocessorCount, dev) != hipSuccess) { grid = -1; return; }
        if (hipFuncSetAttribute((const void*)fwd, hipFuncAttributeMaxDynamicSharedMemorySize, LDS_BYTES) != hipSuccess) { fprintf(stderr, "kernel_launch: hipFuncSetAttribute failed\n"); grid = -1; return; }
        if (hipOccupancyMaxActiveBlocksPerMultiprocessor(&per_cu, (const void*)fwd, NTHR, LDS_BYTES) != hipSuccess || per_cu < 1) { fprintf(stderr, "kernel_launch: occupancy query says %d\n", per_cu); }
        (void)hipGetLastError();
        grid = cus;
    }
    if (grid < 0) return;
    (void)in_sizes;
    if (hipMemsetAsync((char*)d_ws + WS_CTL, 0, CTL_BYTES, stream) != hipSuccess) return;
    Args a{};
    for (int i = 0; i < N_IN; ++i) a.in[i] = (const float*)d_in[i];
    a.out = (float*)d_out; a.ws = (unsigned char*)d_ws; a.ph_lo = 0; a.ph_hi = N_PHASES;
    hipLaunchKernelGGL(fwd, dim3(grid), dim3(NTHR), LDS_BYTES, stream, a);
}
```
